# Optimizing an MI355X kernel written in HIP

```python
import math
import jax, jax.numpy as jnp
from jax import lax
import numpy as np

D_MODEL = 1024
BATCH = 4
SEQ = 8192
DEPTH = 4

CHUNK = 64
Q_BLOCK = 128
N_MEM = 256
EPS = 1e-6
NEG_INF = -1e30

H_A = 8
DH_A = 64
D_LAT = 128
H_IDX = 8
DH_IDX = 64
TOPK_MAX = 256

H_B = 4
DH_B = 64

H_C = 16
H_C_KV = 2
G_C = H_C // H_C_KV
DH_C = 64
WINDOW = 128
WIN_CHUNKS = WINDOW // CHUNK
BAND = (WIN_CHUNKS + 1) * CHUNK

H_X = 4
DH_X = 64

D_FF = 4 * D_MODEL

N_BUCKETS = 32
MAX_DIST = 1024
H_BIAS = H_A + H_B + H_C

N_EVEN = (DEPTH + 1) // 2
N_ODD = DEPTH // 2

EVEN_SIZES = (H_A * DH_A, D_LAT, H_IDX * DH_IDX, DH_IDX, H_IDX, 2 * H_B * DH_B, 2 * H_B * DH_B, 2 * H_B * DH_B)
EVEN_COLS = sum(EVEN_SIZES)
ODD_SIZES = (H_C * DH_C, H_C_KV * DH_C, H_C_KV * DH_C)
ODD_COLS = sum(ODD_SIZES)

kernel_name = "hybrid_dsa_diff_swa_streaming_block"


def _split_points(sizes):
    pts, acc = [], 0
    for s in sizes[:-1]:
        acc += s
        pts.append(acc)
    return pts


def rms_norm(x, g):
    xf = x.astype(jnp.float32)
    y = xf * lax.rsqrt(jnp.mean(xf * xf, axis=-1, keepdims=True) + EPS)
    return (y * g.astype(jnp.float32)).astype(x.dtype)


def t5_bucket(rel):
    nb = N_BUCKETS // 2
    max_exact = nb // 2
    n = jnp.abs(rel)
    nf = jnp.maximum(n, 1).astype(jnp.float32)
    large = max_exact + (jnp.log(nf / max_exact) / math.log(MAX_DIST / max_exact) * (nb - max_exact)).astype(jnp.int32)
    large = jnp.minimum(large, nb - 1)
    return jnp.where(rel > 0, nb, 0) + jnp.where(n < max_exact, n, large)


def chunk_id(pos):
    return pos // CHUNK


def dsa_attention(q_a, c_kv, q_idx, k_idx, w_idx, w_uk, w_uv, table_a):
    B, S = q_a.shape[0], q_a.shape[1]
    topk = min(TOPK_MAX, S // 4)
    n_blk = S // Q_BLOCK
    spos = jnp.arange(S)
    scale = DH_A ** -0.5
    q_lat = jnp.einsum('bshd,hdl->bshl', q_a, w_uk)

    def block(i):
        t0 = i * Q_BLOCK
        tpos = t0 + jnp.arange(Q_BLOCK)
        ql = lax.dynamic_slice_in_dim(q_lat, t0, Q_BLOCK, axis=1)
        qi = lax.dynamic_slice_in_dim(q_idx, t0, Q_BLOCK, axis=1)
        wi = lax.dynamic_slice_in_dim(w_idx, t0, Q_BLOCK, axis=1)
        act = jax.nn.relu(jnp.einsum('bqhd,bsd->bqhs', qi, k_idx).astype(jnp.float32))
        score = jnp.einsum('bqhs,bqh->bqs', act, wi.astype(jnp.float32))
        adm = chunk_id(spos)[None, :] <= chunk_id(tpos)[:, None]
        score = jnp.where(adm[None], score, -jnp.inf)
        _, sel = lax.top_k(score, topk)
        valid = chunk_id(sel) <= chunk_id(tpos)[None, :, None]
        c_sel = jax.vmap(lambda c, ix: c[ix])(c_kv, sel)
        bias = table_a[t5_bucket(sel - tpos[None, :, None])]
        s = jnp.einsum('bqhl,bqkl->bqkh', ql, c_sel).astype(jnp.float32) * scale + bias
        s = jnp.where(valid[..., None], s, NEG_INF)
        p = jax.nn.softmax(s, axis=2)
        return jnp.einsum('bqkh,bqkl->bqhl', p.astype(c_sel.dtype), c_sel)

    o = lax.map(block, jnp.arange(n_blk))
    o = jnp.moveaxis(o, 0, 1).reshape(B, S, H_A, D_LAT)
    o = jnp.einsum('bshl,hld->bshd', o, w_uv)
    return o.reshape(B, S, H_A * DH_A)


def diff_attention(q_b, k_b, v_b, b_lambda, b_subln, table_b, lam_init):
    B, S = q_b.shape[0], q_b.shape[1]
    n_blk = S // Q_BLOCK
    spos = jnp.arange(S)
    scale = DH_B ** -0.5
    lf = b_lambda.astype(jnp.float32)
    lam = jnp.exp(jnp.sum(lf[0] * lf[1])) - jnp.exp(jnp.sum(lf[2] * lf[3])) + lam_init

    def block(i):
        t0 = i * Q_BLOCK
        tpos = t0 + jnp.arange(Q_BLOCK)
        qb = lax.dynamic_slice_in_dim(q_b, t0, Q_BLOCK, axis=1)
        bias = jnp.moveaxis(table_b[t5_bucket(spos[None, :] - tpos[:, None])], -1, 0)
        adm = chunk_id(spos)[None, :] <= chunk_id(tpos)[:, None]
        s = jnp.einsum('bqhmd,bshmd->bhmqs', qb, k_b).astype(jnp.float32) * scale + bias[None, :, None]
        s = jnp.where(adm, s, NEG_INF)
        p = jax.nn.softmax(s, axis=-1)
        a = p[:, :, 0] - lam * p[:, :, 1]
        return jnp.einsum('bhqs,bshe->bqhe', a.astype(v_b.dtype), v_b)

    o = lax.map(block, jnp.arange(n_blk))
    o = jnp.moveaxis(o, 0, 1).reshape(B, S, H_B, 2 * DH_B)
    o = rms_norm(o, b_subln) * (1.0 - lam_init)
    return o.reshape(B, S, H_B * 2 * DH_B)


def even_mixer(h, w_in, a_kv_norm, w_uk, w_uv, b_lambda, b_subln, w_out, table, lam_init):
    B, S, _ = h.shape
    z = h @ w_in
    q_a, c_kv, q_i, k_i, w_i, q_b, k_b, v_b = jnp.split(z, _split_points(EVEN_SIZES), axis=-1)
    c_kv = rms_norm(c_kv, a_kv_norm)
    o_a = dsa_attention(q_a.reshape(B, S, H_A, DH_A), c_kv, q_i.reshape(B, S, H_IDX, DH_IDX), k_i, w_i,
                        w_uk, w_uv, table[:, :H_A])
    o_b = diff_attention(q_b.reshape(B, S, H_B, 2, DH_B), k_b.reshape(B, S, H_B, 2, DH_B),
                         v_b.reshape(B, S, H_B, 2 * DH_B), b_lambda, b_subln, table[:, H_A:H_A + H_B], lam_init)
    return jnp.concatenate([o_a, o_b], axis=-1) @ w_out


def odd_mixer(h, w_in, sinks, w_out, table):
    B, S, _ = h.shape
    nc = S // CHUNK
    q, k, v = jnp.split(h @ w_in, _split_points(ODD_SIZES), axis=-1)
    q = q.reshape(B, nc, CHUNK, H_C_KV, G_C, DH_C)
    k = k.reshape(B, nc, CHUNK, H_C_KV, DH_C)
    v = v.reshape(B, nc, CHUNK, H_C_KV, DH_C)

    def band(t):
        tp = jnp.pad(t, ((0, 0), (WIN_CHUNKS, 0), (0, 0), (0, 0), (0, 0)))
        return jnp.concatenate([tp[:, j:j + nc] for j in range(WIN_CHUNKS + 1)], axis=2)

    kb, vb = band(k), band(v)
    rel = (jnp.arange(BAND)[None, :] - WIN_CHUNKS * CHUNK) - jnp.arange(CHUNK)[:, None]
    bias = jnp.moveaxis(table[:, H_A + H_B:][t5_bucket(rel)], -1, 0).reshape(H_C_KV, G_C, CHUNK, BAND)
    s = jnp.einsum('bcqkgd,bcskd->bckgqs', q, kb).astype(jnp.float32) * (DH_C ** -0.5) + bias
    valid = (jnp.arange(nc)[:, None] - WIN_CHUNKS + jnp.arange(BAND)[None, :] // CHUNK) >= 0
    s = jnp.where(valid[None, :, None, None, None, :], s, NEG_INF)
    sink = jnp.broadcast_to(sinks.astype(jnp.float32).reshape(H_C_KV, G_C)[None, None, :, :, None, None],
                            s.shape[:-1] + (1,))
    p = jax.nn.softmax(jnp.concatenate([s, sink], axis=-1), axis=-1)[..., :-1]
    o = jnp.einsum('bckgqs,bcskd->bcqkgd', p.astype(vb.dtype), vb).reshape(B, S, H_C * DH_C)
    return o @ w_out


def memory_cross_attention(h, mem, wq, wkv, wo, mem_norm):
    B, S, _ = h.shape
    M = mem.shape[1]
    q = (h @ wq).reshape(B, S, H_X, DH_X)
    kv = (rms_norm(mem, mem_norm) @ wkv).reshape(B, M, 2, H_X, DH_X)
    s = jnp.einsum('bshd,bmhd->bhsm', q, kv[:, :, 0]).astype(jnp.float32) * (DH_X ** -0.5)
    p = jax.nn.softmax(s, axis=-1)
    o = jnp.einsum('bhsm,bmhd->bshd', p.astype(kv.dtype), kv[:, :, 1]).reshape(B, S, H_X * DH_X)
    return o @ wo


def sq_relu_mlp(h, w1, w2):
    return jnp.square(jax.nn.relu(h @ w1)) @ w2


def setup_inputs(seed: int = 0) -> dict:
    key = jax.random.key(seed)
    ks = jax.random.split(key, 20)

    def nrm(k, shape, scale):
        return jax.random.normal(k, shape, jnp.float32) * scale

    D = D_MODEL
    return {
        "x": nrm(ks[0], (BATCH, SEQ, D), 1.0),
        "mem": nrm(ks[1], (BATCH, N_MEM, D), 1.0),
        "rel_bias_table": nrm(ks[2], (N_BUCKETS, H_BIAS), 0.3),
        "norm_g": 1.0 + nrm(ks[3], (DEPTH, 6, D), 0.05),
        "ev_w_in": nrm(ks[4], (N_EVEN, D, EVEN_COLS), D ** -0.5),
        "ev_a_kv_norm": 1.0 + nrm(ks[5], (N_EVEN, D_LAT), 0.05),
        "ev_a_w_uk": nrm(ks[6], (N_EVEN, H_A, DH_A, D_LAT), DH_A ** -0.5),
        "ev_a_w_uv": nrm(ks[7], (N_EVEN, H_A, D_LAT, DH_A), D_LAT ** -0.5),
        "ev_b_lambda": nrm(ks[8], (N_EVEN, 4, DH_B), 0.1),
        "ev_b_subln": 1.0 + nrm(ks[9], (N_EVEN, 2 * DH_B), 0.05),
        "ev_w_out": nrm(ks[10], (N_EVEN, H_A * DH_A + 2 * H_B * DH_B, D), D ** -0.5),
        "od_w_in": nrm(ks[11], (N_ODD, D, ODD_COLS), D ** -0.5),
        "od_sinks": nrm(ks[12], (N_ODD, H_C), 0.5),
        "od_w_out": nrm(ks[13], (N_ODD, H_C * DH_C, D), (H_C * DH_C) ** -0.5),
        "xa_wq": nrm(ks[14], (DEPTH, D, H_X * DH_X), D ** -0.5),
        "xa_wkv": nrm(ks[15], (DEPTH, D, 2 * H_X * DH_X), D ** -0.5),
        "xa_wo": nrm(ks[16], (DEPTH, H_X * DH_X, D), (H_X * DH_X) ** -0.5),
        "xa_mem_norm": 1.0 + nrm(ks[17], (DEPTH, D), 0.05),
        "mlp_w1": nrm(ks[18], (DEPTH, D, D_FF), D ** -0.5),
        "mlp_w2": nrm(ks[19], (DEPTH, D_FF, D), D_FF ** -0.5),
    }


def reference(x, mem, rel_bias_table, norm_g, ev_w_in, ev_a_kv_norm, ev_a_w_uk, ev_a_w_uv, ev_b_lambda,
              ev_b_subln, ev_w_out, od_w_in, od_sinks, od_w_out, xa_wq, xa_wkv, xa_wo, xa_mem_norm,
              mlp_w1, mlp_w2):
    for l in range(DEPTH):
        g = norm_g[l]
        h = rms_norm(x, g[0])
        if l % 2 == 0:
            e = l // 2
            lam_init = 0.8 - 0.6 * math.exp(-0.3 * l)
            y = even_mixer(h, ev_w_in[e], ev_a_kv_norm[e], ev_a_w_uk[e], ev_a_w_uv[e], ev_b_lambda[e],
                           ev_b_subln[e], ev_w_out[e], rel_bias_table, lam_init)
        else:
            o = l // 2
            y = odd_mixer(h, od_w_in[o], od_sinks[o], od_w_out[o], rel_bias_table)
        x = x + rms_norm(y, g[1])
        h = rms_norm(x, g[2])
        y = memory_cross_attention(h, mem, xa_wq[l], xa_wkv[l], xa_wo[l], xa_mem_norm[l])
        x = x + rms_norm(y, g[3])
        h = rms_norm(x, g[4])
        y = sq_relu_mlp(h, mlp_w1[l], mlp_w2[l])
        x = x + rms_norm(y, g[5])
    return x
```

```cpp
#include <hip/hip_runtime.h>
#include <cstdio>
#include <cstdint>
namespace pg8 {
#define PG8_LAS __attribute__((address_space(3)))
typedef unsigned short bf16_t;
typedef short bf16x8 __attribute__((ext_vector_type(8)));
typedef float f32x4 __attribute__((ext_vector_type(4)));
typedef unsigned u32x4 __attribute__((ext_vector_type(4)));
constexpr int BM = 256, BK = 64, HALF = 128, HTB = HALF * BK * 2  , STAGE_BYTES = 8 * HTB, NXCD = 8, WGM = 8;

__host__ __device__ __forceinline__ int lds_byte(int r, int c) { const int st = (r >> 4) * 2 + (c >> 5), rr = r & 15, cc = c & 31, ob = rr * 64 + cc * 2; return st * 1024 + (ob ^ (((ob >> 9) & 1) << 5)); }
__host__ __device__ __forceinline__ void stage_rc(int b, int& R, int& C) { const int st = b / 1024, sb = b % 1024, swz = sb ^ (((sb >> 9) & 1) << 5); R = (st >> 1) * 16 + swz / 64; C = (st & 1) * 32 + (swz % 64) / 2; }
__host__ __device__ __forceinline__ int perm32(int rho) { const int n = rho >> 4, i = rho & 15; return 8 * (i >> 2) + 4 * n + (i & 3); }

struct Unit { int pm, pn; };
struct Gemm { const bf16_t* A; const bf16_t* Bt; int M, N, K; };

struct StaticOrder {
    int nM, nN, nwg, G, c;
    __host__ __device__ void init(int M, int N, int G_, int c_) { nM = M / BM; nN = N / BM; nwg = nM * nN; G = G_; c = c_; }
    __host__ __device__ bool next(int i, Unit& u) const {
        const long L = (long)i * G + c; if (L >= nwg) return false;
        int wgid = (int)L; { const int q = nwg / NXCD, r = nwg % NXCD, xcd = wgid % NXCD, off = wgid / NXCD; wgid = (xcd < r ? xcd * (q + 1) : r * (q + 1) + (xcd - r) * q) + off; }
        const int nig = WGM * nN, gid = wgid / nig, fm = gid * WGM, gsz = (nM - fm) < WGM ? (nM - fm) : WGM;
        u.pm = fm + ((wgid % nig) % gsz); u.pn = (wgid % nig) / gsz; return true;
    }
    __device__ __forceinline__ void a_ready(const Unit&) const {}
    __device__ __forceinline__ void done(const Unit&) const {}
};


__device__ __forceinline__ unsigned cvt_pk_bf16(float lo, float hi) { unsigned r; asm volatile("v_cvt_pk_bf16_f32 %0, %1, %2" : "=v"(r) : "v"(lo), "v"(hi)); return r; }
template <int ACT  > struct EpiAct {
    static constexpr bool PERM = true, AFTER_DRAIN = false;
    bf16_t* O; int ldc;
    __device__ __forceinline__ void operator()(const f32x4 (&acc)[2][2][4][2], const Unit& u, int wr, int wc, int fr, int fq) const {
        const int row0 = u.pm * BM + wr * 64 + fr; const int col0 = u.pn * BM + wc * 32 + 8 * fq;
#pragma unroll
        for (int ai = 0; ai < 2; ++ai)
#pragma unroll
            for (int m = 0; m < 4; ++m) { bf16_t* rowp = O + (size_t)(row0 + ai * HALF + m * 16) * ldc + col0;
#pragma unroll
                for (int bj = 0; bj < 2; ++bj) { f32x4 v0 = acc[ai][bj][m][0], v1 = acc[ai][bj][m][1];
                    if (ACT == 2) {
#pragma unroll
                        for (int i = 0; i < 4; ++i) { float a = v0[i] > 0.f ? v0[i] : 0.f; v0[i] = a * a; float b = v1[i] > 0.f ? v1[i] : 0.f; v1[i] = b * b; }
                    }
                    u32x4 w; w.x = cvt_pk_bf16(v0[0], v0[1]); w.y = cvt_pk_bf16(v0[2], v0[3]); w.z = cvt_pk_bf16(v1[0], v1[1]); w.w = cvt_pk_bf16(v1[2], v1[3]);
                    *(u32x4*)(rowp + bj * HALF) = w; } }
    }
};
template <class Epi, class Sched, bool ALIGN_EPI = false, bool SP2 = false>
__device__ __forceinline__ void gemm_phase(PG8_LAS unsigned char* lds, const Gemm g, const Sched& S, const Epi& E) {
    int tid_ = threadIdx.x; asm volatile("" : "+v"(tid_)); const int tid = tid_, wid = __builtin_amdgcn_readfirstlane(tid >> 6), lane = tid & 63, wr = wid >> 2, wc = wid & 3, fr = lane & 15, fq = lane >> 4;
    const int K = g.K, nt = K / BK;
    unsigned voffA[2], voffB[2];
#pragma unroll
    for (int i = 0; i < 2; ++i) { int R, C; stage_rc(tid * 16 + i * 8192, R, C); const int Rb = Epi::PERM ? ((R & ~31) + perm32(R & 31)) : R;
        voffA[i] = (unsigned)(R * K + C) * 2u; voffB[i] = (unsigned)(Rb * K + C) * 2u; }
    const size_t kstep = (size_t)(BK * 2);
    const size_t hstep = (size_t)HALF * K * 2;
    const size_t tstep = 2 * hstep;
    const unsigned ldsw = (unsigned)wid * 1024u;
    const int aoff = lds_byte(wr * 64 + fr, fq * 8), boff = lds_byte(wc * 32 + fr, fq * 8);
#define PG8_SA(b, h) (((b) * 2 + (h)) * HTB)
#define PG8_SB(b, h) ((4 + (b) * 2 + (h)) * HTB)
#define PG8_STAGE(bufoff, gbase, voff) do { _Pragma("unroll") for (int _i = 0; _i < 2; ++_i) \
        __builtin_amdgcn_global_load_lds((const unsigned*)((const char*)(gbase) + (voff)[_i]), (PG8_LAS unsigned*)(lds + (bufoff) + ldsw + _i * 8192), 16, 0, 0); } while (0)
#define PG8_LDA(dst, b, h) do { _Pragma("unroll") for (int m = 0; m < 4; ++m) _Pragma("unroll") for (int k = 0; k < 2; ++k) dst[m][k] = *(const PG8_LAS bf16x8*)(lds + PG8_SA(b, h) + aoff + m * 2048 + k * 1024); } while (0)
#define PG8_LDB(dst, b, h) do { _Pragma("unroll") for (int n = 0; n < 2; ++n) _Pragma("unroll") for (int k = 0; k < 2; ++k) dst[n][k] = *(const PG8_LAS bf16x8*)(lds + PG8_SB(b, h) + boff + n * 2048 + k * 1024); } while (0)
#define PG8_MMA(ai, bj, At, Bt) do { __builtin_amdgcn_s_setprio(1); _Pragma("unroll") for (int m = 0; m < 4; ++m) _Pragma("unroll") for (int n = 0; n < 2; ++n) _Pragma("unroll") for (int k = 0; k < 2; ++k) \
        acc[ai][bj][m][n] = __builtin_amdgcn_mfma_f32_16x16x32_bf16(Bt[n][k], At[m][k], acc[ai][bj][m][n], 0, 0, 0); __builtin_amdgcn_s_setprio(0); } while (0)
#define PG8_WAIT_V(n) asm volatile("s_waitcnt vmcnt(" #n ")" ::: "memory")
#define PG8_WAIT_L(n) asm volatile("s_waitcnt lgkmcnt(" #n ")" ::: "memory")
#define PG8_BAR __builtin_amdgcn_s_barrier()
#define PG8_SCHED __builtin_amdgcn_sched_barrier(0)
    Unit cur, nxt; int ui = 0;
    if (!S.next(0, cur)) return;
    f32x4 acc[2][2][4][2];
#pragma unroll
    for (int a = 0; a < 2; ++a)
#pragma unroll
        for (int b = 0; b < 2; ++b)
#pragma unroll
            for (int m = 0; m < 4; ++m)
#pragma unroll
                for (int n = 0; n < 2; ++n) acc[a][b][m][n] = (f32x4){0.f, 0.f, 0.f, 0.f};
    bf16x8 At[4][2], B0[2][2], B1[2][2];
    const char* cA = (const char*)g.A + (size_t)cur.pm * tstep; const char* cB = (const char*)g.Bt + (size_t)cur.pn * tstep;
    S.a_ready(cur);
    if constexpr (SP2) {
        PG8_STAGE(PG8_SB(0, 0), cB, voffB); PG8_STAGE(PG8_SB(0, 1), cB + hstep, voffB); PG8_STAGE(PG8_SA(0, 0), cA, voffA); PG8_STAGE(PG8_SA(0, 1), cA + hstep, voffA);
        if (wr == 1) PG8_BAR;
        PG8_WAIT_V(2); PG8_BAR;
        PG8_STAGE(PG8_SB(1, 0), cB + kstep, voffB); PG8_STAGE(PG8_SA(1, 0), cA + kstep, voffA); PG8_STAGE(PG8_SB(1, 1), cB + hstep + kstep, voffB);
        PG8_WAIT_V(6); PG8_BAR;
    } else {
        PG8_STAGE(PG8_SB(0, 0), cB, voffB); PG8_STAGE(PG8_SA(0, 0), cA, voffA); PG8_STAGE(PG8_SB(0, 1), cB + hstep, voffB); PG8_STAGE(PG8_SA(0, 1), cA + hstep, voffA);
        if (wr == 1) PG8_BAR;
        PG8_WAIT_V(4); PG8_BAR;
        PG8_STAGE(PG8_SB(1, 0), cB + kstep, voffB); PG8_STAGE(PG8_SA(1, 0), cA + kstep, voffA); PG8_STAGE(PG8_SB(1, 1), cB + hstep + kstep, voffB);
        PG8_WAIT_V(6); PG8_BAR;
    }
    for (;;) {
        const bool has_next = S.next(ui + 1, nxt);
        const char* nA = has_next ? (const char*)g.A + (size_t)nxt.pm * tstep : cA; const char* nB = has_next ? (const char*)g.Bt + (size_t)nxt.pn * tstep : cB;
        for (int t = 0; t < nt; t += 2) {
            const bool last = (t == nt - 2);
            const char* a1 = cA + (size_t)(t + 1) * kstep;
            const char* a2 = last ? nA : cA + (size_t)(t + 2) * kstep; const char* b2 = last ? nB : cB + (size_t)(t + 2) * kstep;
            const char* a3 = a2 + kstep; const char* b3 = b2 + kstep;
            if (last && has_next) S.a_ready(nxt);
            if constexpr (SP2) {
            PG8_LDB(B0, 0, 0); PG8_LDB(B1, 0, 1); PG8_SCHED; PG8_LDA(At, 0, 0); PG8_STAGE(PG8_SA(1, 1), a1 + hstep, voffA);
            PG8_WAIT_V(8); PG8_WAIT_L(0); PG8_BAR; PG8_MMA(0, 0, At, B0); PG8_MMA(0, 1, At, B1); PG8_BAR; PG8_SCHED;
            PG8_LDA(At, 0, 1); PG8_STAGE(PG8_SB(0, 0), b2, voffB); PG8_STAGE(PG8_SB(0, 1), b2 + hstep, voffB); PG8_STAGE(PG8_SA(0, 0), a2, voffA);
            PG8_WAIT_V(8); PG8_WAIT_L(0); PG8_BAR; PG8_MMA(1, 0, At, B0); PG8_MMA(1, 1, At, B1); PG8_BAR; PG8_SCHED;
            PG8_LDB(B0, 1, 0); PG8_LDB(B1, 1, 1); PG8_SCHED; PG8_LDA(At, 1, 0); PG8_STAGE(PG8_SA(0, 1), a2 + hstep, voffA);
            PG8_WAIT_V(8); PG8_WAIT_L(0); PG8_BAR; PG8_MMA(0, 0, At, B0); PG8_MMA(0, 1, At, B1); PG8_BAR; PG8_SCHED;
            PG8_LDA(At, 1, 1); PG8_STAGE(PG8_SB(1, 0), b3, voffB); PG8_STAGE(PG8_SB(1, 1), b3 + hstep, voffB); PG8_STAGE(PG8_SA(1, 0), a3, voffA);
            PG8_WAIT_V(8); PG8_WAIT_L(0); PG8_BAR; PG8_MMA(1, 0, At, B0); PG8_MMA(1, 1, At, B1); PG8_BAR; PG8_SCHED;
            } else {
            PG8_LDB(B0, 0, 0); PG8_SCHED; PG8_LDA(At, 0, 0); PG8_STAGE(PG8_SA(1, 1), a1 + hstep, voffA);
            PG8_WAIT_L(8); PG8_BAR; PG8_WAIT_L(0); PG8_MMA(0, 0, At, B0); PG8_BAR; PG8_SCHED;
            PG8_LDB(B1, 0, 1); PG8_STAGE(PG8_SB(0, 0), b2, voffB);
            PG8_BAR; PG8_WAIT_L(0); PG8_MMA(0, 1, At, B1); PG8_BAR;
            PG8_LDA(At, 0, 1); PG8_STAGE(PG8_SA(0, 0), a2, voffA);
            PG8_BAR; PG8_WAIT_L(0); PG8_MMA(1, 0, At, B0); PG8_BAR; PG8_SCHED;
            PG8_STAGE(PG8_SB(0, 1), b2 + hstep, voffB);
            PG8_WAIT_V(6); PG8_BAR; PG8_MMA(1, 1, At, B1); PG8_BAR;
            PG8_LDB(B0, 1, 0); PG8_SCHED; PG8_LDA(At, 1, 0); PG8_STAGE(PG8_SA(0, 1), a2 + hstep, voffA);
            PG8_WAIT_L(8); PG8_BAR; PG8_WAIT_L(0); PG8_MMA(0, 0, At, B0); PG8_BAR; PG8_SCHED;
            PG8_LDB(B1, 1, 1); PG8_STAGE(PG8_SB(1, 0), b3, voffB);
            PG8_BAR; PG8_WAIT_L(0); PG8_MMA(0, 1, At, B1); PG8_BAR;
            PG8_LDA(At, 1, 1); PG8_STAGE(PG8_SA(1, 0), a3, voffA);
            PG8_BAR; PG8_WAIT_L(0); PG8_MMA(1, 0, At, B0); PG8_BAR; PG8_SCHED;
            PG8_STAGE(PG8_SB(1, 1), b3 + hstep, voffB);
            PG8_WAIT_V(6); PG8_BAR; PG8_MMA(1, 1, At, B1); PG8_BAR;
            }
        }
        if constexpr (ALIGN_EPI) { if (wr == 0) PG8_BAR; }
        if constexpr (!Epi::AFTER_DRAIN) { E(acc, cur, wr, wc, fr, fq); S.done(cur); }
        if (!has_next) break;
#pragma unroll
        for (int a = 0; a < 2; ++a)
#pragma unroll
            for (int b = 0; b < 2; ++b)
#pragma unroll
                for (int m = 0; m < 4; ++m)
#pragma unroll
                    for (int n = 0; n < 2; ++n) acc[a][b][m][n] = (f32x4){0.f, 0.f, 0.f, 0.f};
        cur = nxt; cA = nA; cB = nB; ++ui;
        if constexpr (ALIGN_EPI) { if (wr == 1) PG8_BAR; }
    }
    PG8_WAIT_V(0);
    if constexpr (!ALIGN_EPI) { if (wr == 0) PG8_BAR; }
    PG8_BAR;
    if constexpr (Epi::AFTER_DRAIN) { E.fused(acc, cur, wr, wc, fr, fq, lds, wid, lane); S.done(cur); }
#undef PG8_SA
#undef PG8_SB
#undef PG8_STAGE
#undef PG8_LDA
#undef PG8_LDB
#undef PG8_MMA
#undef PG8_WAIT_V
#undef PG8_WAIT_L
#undef PG8_BAR
#undef PG8_SCHED
}
}

constexpr int NWAVES = 8;
constexpr int NB = 4, SEQ = 8192, D = 1024, M = NB * SEQ, FF = 4096, NMEM = 256;
constexpr int ZE = 3328, ZO = 1280;
constexpr int ZQL = 0, ZCKV = 1024, ZQI = 1152, ZKI = 1664, ZWI = 1728, ZQB = 1792, ZKB = 2304, ZVB = 2816;
constexpr int OQ = 0, OKK = 1024, OVV = 1152;
constexpr int EVC = 2760;
constexpr int HCE = 1536, HCO = 1024;
constexpr float EPS = 1e-6f;
constexpr float LOG2E = 1.4426950408889634f;

constexpr size_t MiB = 1u << 20;
constexpr size_t WS_CTL = 0, CTL_ZERO_BYTES = 1 * MiB;
constexpr size_t WS_WGT = 1 * MiB;
constexpr size_t WO_WIN = 0, WO_WOUT = 6 * MiB + MiB / 2, WO_WQ = 9 * MiB + MiB / 2, WO_WKV = 10 * MiB, WO_WO = 11 * MiB, WO_W1 = 11 * MiB + MiB / 2, WO_W2 = 19 * MiB + MiB / 2;
constexpr size_t WS_MEMN = 33 * MiB, WS_KVM = 35 * MiB, WS_CKVN = 36 * MiB, WS_QX = 44 * MiB, WS_OX = 60 * MiB, WS_HC = 76 * MiB, WS_ZS = 172 * MiB;
constexpr size_t WS_Z = WS_ZS, WS_SCR = WS_ZS + 208 * MiB, WS_U = WS_ZS, WS_Y = WS_ZS + 272 * MiB, WS_END = WS_ZS + 336 * MiB;
static_assert(WS_END == 508 * MiB, "ws map");
constexpr int CW_BAR = 4096;

constexpr int RING_OFF = 0, RING_BYTES = 131072;
constexpr int LDSCTL_OFF = RING_BYTES, MISC_OFF = LDSCTL_OFF + 320;
constexpr int LDS_BYTES = 147456;

#define GAS __attribute__((address_space(1)))
#define LAS __attribute__((address_space(3)))
typedef unsigned short bf16;
typedef unsigned v4u __attribute__((ext_vector_type(4)));
typedef unsigned v2u __attribute__((ext_vector_type(2)));
typedef float f32x4 __attribute__((ext_vector_type(4)));
typedef GAS unsigned gu32;
#define RLX_AGENT __ATOMIC_RELAXED, __HIP_MEMORY_SCOPE_AGENT
#define LDS_WAIT() asm volatile("s_waitcnt lgkmcnt(0)" ::: "memory")
#define VM_WAIT() asm volatile("s_waitcnt vmcnt(0)" ::: "memory")
__device__ __forceinline__ unsigned f2bf(float f) { unsigned u = __builtin_bit_cast(unsigned, f); return (u + 0x7fffu + ((u >> 16) & 1u)) >> 16; }
__device__ __forceinline__ unsigned pk2(float lo, float hi) { return f2bf(lo) | (f2bf(hi) << 16); }
__device__ __forceinline__ float bflo(unsigned w) { return __builtin_bit_cast(float, w << 16); }
__device__ __forceinline__ float bfhi(unsigned w) { return __builtin_bit_cast(float, w & 0xffff0000u); }
__device__ __forceinline__ float bf2f(unsigned short u) { return __builtin_bit_cast(float, (unsigned)u << 16); }
__device__ __forceinline__ float wave_sum(float v) {
#pragma unroll
    for (int o = 1; o < 64; o <<= 1) v += __shfl_xor(v, o);
    return v;
}
__device__ __forceinline__ float wave_max(float v) {
#pragma unroll
    for (int o = 1; o < 64; o <<= 1) v = fmaxf(v, __shfl_xor(v, o));
    return v;
}
__device__ __forceinline__ int t5_bucket(int rel) {
    const int n = rel < 0 ? -rel : rel;
    const int b = n < 8 ? n : 8 + (n >= 15) + (n >= 27) + (n >= 50) + (n >= 91) + (n >= 166) + (n >= 305) + (n >= 559);
    return b + (rel > 0 ? 16 : 0);
}
#define XB_TMO      128
#define XB_XCNT(j)  (256  + 64 * (j))
#define XB_XSUB(j)  (1280 + 64 * (j))
#define XB_XGEN(j)  (2304 + 64 * (j))
#define XB_TOP      3328
#define XB_TOPGEN   3392
#define XCD_BAR_WORDS 3456
#define XB_SPIN_CAP (1u << 25)

__device__ __forceinline__ unsigned xb_ld(unsigned* p)              { return __hip_atomic_load(p, __ATOMIC_RELAXED, __HIP_MEMORY_SCOPE_AGENT); }
__device__ __forceinline__ unsigned xb_add(unsigned* p, unsigned v) { return __hip_atomic_fetch_add(p, v, __ATOMIC_RELAXED, __HIP_MEMORY_SCOPE_AGENT); }
__device__ __forceinline__ unsigned xb_xcc_id() { return (unsigned)__builtin_amdgcn_s_getreg((3 << 11) | 20) & 0xFu; }
#define XB_SPIN(cond, bar) do { unsigned _sp = 0; while (cond) { __builtin_amdgcn_s_sleep(1); \
    if ((++_sp & 255u) == 0u) { if (xb_ld(&(bar)[XB_TMO])) break; if (_sp > XB_SPIN_CAP) { atomicAdd(&(bar)[XB_TMO], 1u); break; } } } } while (0)

struct XcdBarrier {
    unsigned* bar; unsigned x;
    volatile LAS unsigned* st;
};

__device__ __forceinline__ XcdBarrier xcd_barrier_post(unsigned* bar, volatile LAS unsigned* st) {
    XcdBarrier b; b.bar = bar; b.x = xb_xcc_id(); b.st = st;
    if (threadIdx.x == 0) (void)xb_add(&bar[XB_XCNT(b.x)], 1u);
    return b;
}
__device__ __forceinline__ void xcd_barrier_complete(unsigned* bar, unsigned x, unsigned& nloc, unsigned& nx) {
    const unsigned G = gridDim.x * gridDim.y * gridDim.z;
    unsigned sum, cnt, mine, sp = 0u;
    for (;;) {
        sum = 0u; cnt = 0u; mine = 0u;
#pragma unroll
        for (unsigned j = 0; j < 16; ++j) { const unsigned c = xb_ld(&bar[XB_XCNT(j)]); sum += c; cnt += (c > 0u) ? 1u : 0u; mine = (j == x) ? c : mine; }
        if (sum == G) break;
        __builtin_amdgcn_s_sleep(1);
        if ((++sp & 255u) == 0u) { if (xb_ld(&bar[XB_TMO])) break; if (sp > XB_SPIN_CAP) { atomicAdd(&bar[XB_TMO], 1u); break; } }
    }
    nloc = mine > 0u ? mine : 1u; nx = cnt > 0u ? cnt : 1u;
}

__device__ __forceinline__ void xcd_barrier(const XcdBarrier& b) {
    asm volatile("s_waitcnt vmcnt(0)" ::: "memory");
    __syncthreads();
    if (threadIdx.x == 0) {
        unsigned* bar = b.bar;
        __builtin_amdgcn_s_waitcnt(0);
        unsigned nloc = b.st[0], nx = b.st[1];
        if (nloc == 0u) { xcd_barrier_complete(bar, b.x, nloc, nx); b.st[0] = nloc; b.st[1] = nx; }
        const unsigned old = xb_add(&bar[XB_XSUB(b.x)], 1u);
        const unsigned gen = old / nloc;
        if (old + 1u == (gen + 1u) * nloc) {
            __builtin_amdgcn_fence(__ATOMIC_RELEASE, "agent");
            asm volatile("s_waitcnt vmcnt(0)" ::: "memory");
            const unsigned og = xb_add(&bar[XB_TOP], 1u);
            const unsigned tg = og / nx;
            if (og + 1u == (tg + 1u) * nx) xb_add(&bar[XB_TOPGEN], 1u);
            else XB_SPIN(xb_ld(&bar[XB_TOPGEN]) == tg, bar);
            __builtin_amdgcn_fence(__ATOMIC_ACQUIRE, "agent");
            xb_add(&bar[XB_XGEN(b.x)], 1u);
            asm volatile("s_waitcnt vmcnt(0)" ::: "memory");
        } else {
            XB_SPIN(xb_ld(&bar[XB_XGEN(b.x)]) == gen, bar);
            __builtin_amdgcn_fence(__ATOMIC_ACQUIRE, "agent");
            asm volatile("s_waitcnt vmcnt(0)" ::: "memory");
        }
    }
    __syncthreads();
}

struct Frame {
    LAS unsigned char* lds;
    volatile LAS unsigned* MISC;
    gu32* ctl;
    int tid, lane, wave, vcu, G;
    const float* in[20];
    float* out;
    unsigned char* ws;
};
__device__ __forceinline__ bool refresh(Frame& F) { int t_ = threadIdx.x; asm volatile("" : "+v"(t_)); F.tid = t_; F.lane = t_ & 63; return true; }
enum { I_X = 0, I_MEM, I_TAB, I_NG, I_EWIN, I_EKVN, I_EUK, I_EUV, I_ELAM, I_ESUB, I_EWOUT, I_OWIN, I_OSINK, I_OWOUT, I_XWQ, I_XWKV, I_XWO, I_XMN, I_W1, I_W2 };

__device__ __forceinline__ void tr_item(const float* src, int spitch, int scol0, bf16* dst, int dpitch, int drow0, int dcol0, int nblk, LAS float* scr, int item, int lane) {
    const int kb = item / nblk, nb = item % nblk, k0 = 64 * kb, n0 = 32 * nb;
#pragma unroll 8
    for (int i = 0; i < 32; ++i) { const int kk = 2 * i + (lane >> 5); scr[kk * 33 + (lane & 31)] = ((const GAS float*)src)[(size_t)(k0 + kk) * spitch + scol0 + n0 + (lane & 31)]; }
    LDS_WAIT(); asm volatile("" ::: "memory");
    const int c = lane & 7;
#pragma unroll
    for (int j = 0; j < 4; ++j) { const int n = (lane >> 3) + 8 * j; const LAS float* s = scr + (8 * c) * 33 + n;
        v4u o; o.x = pk2(s[0 * 33], s[1 * 33]); o.y = pk2(s[2 * 33], s[3 * 33]); o.z = pk2(s[4 * 33], s[5 * 33]); o.w = pk2(s[6 * 33], s[7 * 33]);
        *(GAS v4u*)(dst + (size_t)(drow0 + n0 + n) * dpitch + dcol0 + k0 + 8 * c) = o; }
    LDS_WAIT(); asm volatile("" ::: "memory");
}
__device__ __forceinline__ void fuse_qlat_item(const float* win, const float* wuk, bf16* dst, int item, int lane) {
    const int h = item >> 6, k0 = (item & 63) * 16;
    float a0[16], a1[16];
#pragma unroll
    for (int k = 0; k < 16; ++k) { a0[k] = 0.f; a1[k] = 0.f; }
    for (int d = 0; d < 64; ++d) {
        const float u0 = ((const GAS float*)wuk)[(size_t)(h * 64 + d) * 128 + 2 * lane], u1 = ((const GAS float*)wuk)[(size_t)(h * 64 + d) * 128 + 2 * lane + 1];
#pragma unroll
        for (int k = 0; k < 16; ++k) { const float w = ((const GAS float*)win)[(size_t)(k0 + k) * EVC + h * 64 + d]; a0[k] += w * u0; a1[k] += w * u1; }
    }
    v4u o0, o1, p0, p1;
    o0.x = pk2(a0[0], a0[1]); o0.y = pk2(a0[2], a0[3]); o0.z = pk2(a0[4], a0[5]); o0.w = pk2(a0[6], a0[7]);
    o1.x = pk2(a0[8], a0[9]); o1.y = pk2(a0[10], a0[11]); o1.z = pk2(a0[12], a0[13]); o1.w = pk2(a0[14], a0[15]);
    p0.x = pk2(a1[0], a1[1]); p0.y = pk2(a1[2], a1[3]); p0.z = pk2(a1[4], a1[5]); p0.w = pk2(a1[6], a1[7]);
    p1.x = pk2(a1[8], a1[9]); p1.y = pk2(a1[10], a1[11]); p1.z = pk2(a1[12], a1[13]); p1.w = pk2(a1[14], a1[15]);
    GAS v4u* r0 = (GAS v4u*)(dst + (size_t)(h * 128 + 2 * lane) * 1024 + k0); GAS v4u* r1 = (GAS v4u*)(dst + (size_t)(h * 128 + 2 * lane + 1) * 1024 + k0);
    r0[0] = o0; r0[1] = o1; r1[0] = p0; r1[1] = p1;
}
__device__ __forceinline__ void fuse_ov_item(const float* wuv, const float* wout, bf16* dst, int item, int lane) {
    const int h = item >> 6, n0 = (item & 63) * 16;
    float a0[16], a1[16];
#pragma unroll
    for (int k = 0; k < 16; ++k) { a0[k] = 0.f; a1[k] = 0.f; }
    for (int d = 0; d < 64; ++d) {
        const float u0 = ((const GAS float*)wuv)[(size_t)(h * 128 + 2 * lane) * 64 + d], u1 = ((const GAS float*)wuv)[(size_t)(h * 128 + 2 * lane + 1) * 64 + d];
#pragma unroll
        for (int k = 0; k < 16; ++k) { const float w = ((const GAS float*)wout)[(size_t)(h * 64 + d) * 1024 + n0 + k]; a0[k] += w * u0; a1[k] += w * u1; }
    }
#pragma unroll
    for (int k = 0; k < 16; ++k) *(GAS unsigned*)(dst + (size_t)(n0 + k) * HCE + h * 128 + 2 * lane) = pk2(a0[k], a1[k]);
}
__device__ __forceinline__ void widx_item(const float* win, bf16* dst, int item, int lane) {
    const int k = item * 64 + lane;
    for (int n = 0; n < 64; ++n) { const float v = n < 8 ? ((const GAS float*)win)[(size_t)k * EVC + 1216 + n] : 0.f; ((GAS bf16*)dst)[(size_t)(ZWI + n) * 1024 + k] = (bf16)f2bf(v); }
}

__device__ __forceinline__ void convert_weights(Frame& F, int l) {
    LAS float* scr = (LAS float*)(F.lds + RING_OFF + F.wave * 16384);
    const int gw = F.vcu * NWAVES + F.wave, NGW = F.G * NWAVES;
    bf16* WIN = (bf16*)(F.ws + WS_WGT + WO_WIN); bf16* WOUT = (bf16*)(F.ws + WS_WGT + WO_WOUT); bf16* WQ = (bf16*)(F.ws + WS_WGT + WO_WQ); bf16* WKV = (bf16*)(F.ws + WS_WGT + WO_WKV);
    bf16* WO = (bf16*)(F.ws + WS_WGT + WO_WO); bf16* W1 = (bf16*)(F.ws + WS_WGT + WO_W1); bf16* W2 = (bf16*)(F.ws + WS_WGT + WO_W2);
    const float* wq = F.in[I_XWQ] + (size_t)l * 1024 * 256; const float* wkv = F.in[I_XWKV] + (size_t)l * 1024 * 512; const float* wo = F.in[I_XWO] + (size_t)l * 256 * 1024;
    const float* w1 = F.in[I_W1] + (size_t)l * 1024 * 4096; const float* w2 = F.in[I_W2] + (size_t)l * 4096 * 1024;
    constexpr int N_Q = 16 * 8, N_KV = 16 * 16, N_O = 4 * 32, N_1 = 16 * 128, N_2 = 64 * 32;
    if ((l & 1) == 0) {
        const int e = l >> 1;
        const float* win = F.in[I_EWIN] + (size_t)e * 1024 * EVC; const float* wout = F.in[I_EWOUT] + (size_t)e * 1024 * 1024;
        const float* wuk = F.in[I_EUK] + (size_t)e * 8 * 64 * 128; const float* wuv = F.in[I_EUV] + (size_t)e * 8 * 128 * 64;
        constexpr int A0 = 512, A1 = 16 * 4, A2 = 16 * 16, A3 = 16 * 2, A4 = 16 * 48, A5 = 16, A6 = 512, A7 = 8 * 32;
        constexpr int TOT = A0 + A1 + A2 + A3 + A4 + A5 + A6 + A7 + N_Q + N_KV + N_O + N_1 + N_2;
        for (int it = gw; it < TOT; it += NGW) {
            int r = it;
            if (r < A0) { fuse_qlat_item(win, wuk, WIN, r, F.lane); continue; } r -= A0;
            if (r < A1) { tr_item(win, EVC, 512, WIN, 1024, ZCKV, 0, 4, scr, r, F.lane); continue; } r -= A1;
            if (r < A2) { tr_item(win, EVC, 640, WIN, 1024, ZQI, 0, 16, scr, r, F.lane); continue; } r -= A2;
            if (r < A3) { tr_item(win, EVC, 1152, WIN, 1024, ZKI, 0, 2, scr, r, F.lane); continue; } r -= A3;
            if (r < A4) { tr_item(win, EVC, 1224, WIN, 1024, ZQB, 0, 48, scr, r, F.lane); continue; } r -= A4;
            if (r < A5) { widx_item(win, WIN, r, F.lane); continue; } r -= A5;
            if (r < A6) { fuse_ov_item(wuv, wout, WOUT, r, F.lane); continue; } r -= A6;
            if (r < A7) { tr_item(wout + (size_t)512 * 1024, 1024, 0, WOUT, HCE, 0, 1024, 32, scr, r, F.lane); continue; } r -= A7;
            if (r < N_Q) { tr_item(wq, 256, 0, WQ, 1024, 0, 0, 8, scr, r, F.lane); continue; } r -= N_Q;
            if (r < N_KV) { tr_item(wkv, 512, 0, WKV, 1024, 0, 0, 16, scr, r, F.lane); continue; } r -= N_KV;
            if (r < N_O) { tr_item(wo, 1024, 0, WO, 256, 0, 0, 32, scr, r, F.lane); continue; } r -= N_O;
            if (r < N_1) { tr_item(w1, 4096, 0, W1, 1024, 0, 0, 128, scr, r, F.lane); continue; } r -= N_1;
            tr_item(w2, 1024, 0, W2, 4096, 0, 0, 32, scr, r, F.lane);
        }
    } else {
        const int o = l >> 1;
        const float* win = F.in[I_OWIN] + (size_t)o * 1024 * ZO; const float* wout = F.in[I_OWOUT] + (size_t)o * 1024 * 1024;
        constexpr int B0 = 16 * 40, B1 = 16 * 32;
        constexpr int TOT = B0 + B1 + N_Q + N_KV + N_O + N_1 + N_2;
        for (int it = gw; it < TOT; it += NGW) {
            int r = it;
            if (r < B0) { tr_item(win, ZO, 0, WIN, 1024, 0, 0, 40, scr, r, F.lane); continue; } r -= B0;
            if (r < B1) { tr_item(wout, 1024, 0, WOUT, 1024, 0, 0, 32, scr, r, F.lane); continue; } r -= B1;
            if (r < N_Q) { tr_item(wq, 256, 0, WQ, 1024, 0, 0, 8, scr, r, F.lane); continue; } r -= N_Q;
            if (r < N_KV) { tr_item(wkv, 512, 0, WKV, 1024, 0, 0, 16, scr, r, F.lane); continue; } r -= N_KV;
            if (r < N_O) { tr_item(wo, 1024, 0, WO, 256, 0, 0, 32, scr, r, F.lane); continue; } r -= N_O;
            if (r < N_1) { tr_item(w1, 4096, 0, W1, 1024, 0, 0, 128, scr, r, F.lane); continue; } r -= N_1;
            tr_item(w2, 1024, 0, W2, 4096, 0, 0, 32, scr, r, F.lane);
        }
    }
}

__device__ __forceinline__ void row_first(int lane, const float* xin, float* xout, const float* g, bf16* h) {
    const GAS f32x4* xr = (const GAS f32x4*)xin + lane; f32x4 v[4]; float ss = 0.f;
#pragma unroll
    for (int j = 0; j < 4; ++j) { v[j] = xr[64 * j]; ss += (v[j].x * v[j].x + v[j].y * v[j].y) + (v[j].z * v[j].z + v[j].w * v[j].w); }
    const float r = 1.f / sqrtf(wave_sum(ss) * (1.f / 1024.f) + EPS);
    const GAS f32x4* gr = (const GAS f32x4*)g + lane; GAS v2u* ho = (GAS v2u*)h + lane;
#pragma unroll
    for (int j = 0; j < 4; ++j) {
        if (xout) ((GAS f32x4*)xout + lane)[64 * j] = v[j];
        const f32x4 gg = gr[64 * j]; v2u o; o.x = pk2(v[j].x * r * gg.x, v[j].y * r * gg.y); o.y = pk2(v[j].z * r * gg.z, v[j].w * r * gg.w); ho[64 * j] = o; }
}
__device__ __forceinline__ void row_mid(int lane, const bf16* y, float* x, const float* ga, const float* gb, bf16* h) {
    const GAS v2u* yr = (const GAS v2u*)y + lane; GAS f32x4* xr = (GAS f32x4*)x + lane; f32x4 yv[4], xv[4]; float ss = 0.f;
#pragma unroll
    for (int j = 0; j < 4; ++j) { const v2u w = yr[64 * j]; yv[j] = (f32x4){bflo(w.x), bfhi(w.x), bflo(w.y), bfhi(w.y)}; xv[j] = xr[64 * j];
        ss += (yv[j].x * yv[j].x + yv[j].y * yv[j].y) + (yv[j].z * yv[j].z + yv[j].w * yv[j].w); }
    const float r1 = 1.f / sqrtf(wave_sum(ss) * (1.f / 1024.f) + EPS);
    const GAS f32x4* gar = (const GAS f32x4*)ga + lane; float s2 = 0.f;
#pragma unroll
    for (int j = 0; j < 4; ++j) { const f32x4 gg = gar[64 * j]; xv[j].x += yv[j].x * r1 * gg.x; xv[j].y += yv[j].y * r1 * gg.y; xv[j].z += yv[j].z * r1 * gg.z; xv[j].w += yv[j].w * r1 * gg.w;
        xr[64 * j] = xv[j]; s2 += (xv[j].x * xv[j].x + xv[j].y * xv[j].y) + (xv[j].z * xv[j].z + xv[j].w * xv[j].w); }
    if (gb) {
        const float r2 = 1.f / sqrtf(wave_sum(s2) * (1.f / 1024.f) + EPS);
        const GAS f32x4* gbr = (const GAS f32x4*)gb + lane; GAS v2u* ho = (GAS v2u*)h + lane;
#pragma unroll
        for (int j = 0; j < 4; ++j) { const f32x4 gg = gbr[64 * j]; v2u o; o.x = pk2(xv[j].x * r2 * gg.x, xv[j].y * r2 * gg.y); o.y = pk2(xv[j].z * r2 * gg.z, xv[j].w * r2 * gg.w); ho[64 * j] = o; }
    }
}
__device__ __forceinline__ void thin_first(Frame& F, const float* g) {
    const int gw = F.vcu * NWAVES + F.wave, NGW = F.G * NWAVES; bf16* h = (bf16*)(F.ws + WS_HC);
    for (int m = gw; m < M; m += NGW) row_first(F.lane, F.in[I_X] + (size_t)m * D, F.out + (size_t)m * D, g, h + (size_t)m * D);
}
__device__ __forceinline__ void thin_mid(Frame& F, const float* ga, const float* gb) {
    const int gw = F.vcu * NWAVES + F.wave, NGW = F.G * NWAVES; bf16* h = (bf16*)(F.ws + WS_HC); const bf16* y = (const bf16*)(F.ws + WS_Y);
    for (int m = gw; m < M; m += NGW) row_mid(F.lane, y + (size_t)m * D, F.out + (size_t)m * D, ga, gb, h + (size_t)m * D);
}
__device__ __forceinline__ void thin_memn(Frame& F, const float* g) {
    const int gw = F.vcu * NWAVES + F.wave, NGW = F.G * NWAVES; bf16* mn = (bf16*)(F.ws + WS_MEMN);
    for (int m = NGW - 1 - gw; m < NB * NMEM; m += NGW) row_first(F.lane, F.in[I_MEM] + (size_t)m * D, nullptr, g, mn + (size_t)m * D);
}
__device__ __forceinline__ void thin_ckvn(Frame& F, const float* akvn) {
    const int gw = F.vcu * NWAVES + F.wave, NGW = F.G * NWAVES; const bf16* z = (const bf16*)(F.ws + WS_Z); bf16* ck = (bf16*)(F.ws + WS_CKVN);
    const float g0 = ((const GAS float*)akvn)[2 * F.lane], g1 = ((const GAS float*)akvn)[2 * F.lane + 1];
    for (int m = gw; m < M; m += NGW) {
        const unsigned w = *((const GAS unsigned*)(z + (size_t)m * ZE + ZCKV) + F.lane); const float a = bflo(w), b = bfhi(w);
        const float r = 1.f / sqrtf(wave_sum(a * a + b * b) * (1.f / 128.f) + EPS);
        *((GAS unsigned*)(ck + (size_t)m * 128) + F.lane) = pk2(a * r * g0, b * r * g1);
    }
}

#define UNPK8(dst, off, VV) do { dst[(off) + 0] = bflo((VV).x); dst[(off) + 1] = bfhi((VV).x); dst[(off) + 2] = bflo((VV).y); dst[(off) + 3] = bfhi((VV).y); \
    dst[(off) + 4] = bflo((VV).z); dst[(off) + 5] = bfhi((VV).z); dst[(off) + 6] = bflo((VV).w); dst[(off) + 7] = bfhi((VV).w); } while (0)
#define DOT8(q, off, VV) ((q[(off) + 0] * bflo((VV).x) + q[(off) + 1] * bfhi((VV).x)) + (q[(off) + 2] * bflo((VV).y) + q[(off) + 3] * bfhi((VV).y)) + \
    (q[(off) + 4] * bflo((VV).z) + q[(off) + 5] * bfhi((VV).z)) + (q[(off) + 6] * bflo((VV).w) + q[(off) + 7] * bfhi((VV).w)))
#define AXPY8(acc, off, al, p, VV) do { acc[(off) + 0] = acc[(off) + 0] * (al) + (p) * bflo((VV).x); acc[(off) + 1] = acc[(off) + 1] * (al) + (p) * bfhi((VV).x); \
    acc[(off) + 2] = acc[(off) + 2] * (al) + (p) * bflo((VV).y); acc[(off) + 3] = acc[(off) + 3] * (al) + (p) * bfhi((VV).y); \
    acc[(off) + 4] = acc[(off) + 4] * (al) + (p) * bflo((VV).z); acc[(off) + 5] = acc[(off) + 5] * (al) + (p) * bfhi((VV).z); \
    acc[(off) + 6] = acc[(off) + 6] * (al) + (p) * bflo((VV).w); acc[(off) + 7] = acc[(off) + 7] * (al) + (p) * bfhi((VV).w); } while (0)

__device__ __forceinline__ void xattn_naive(Frame& F) {
    LAS v4u* Ks = (LAS v4u*)(F.lds); LAS v4u* Vs = (LAS v4u*)(F.lds + 32768);
    const bf16* kvm = (const bf16*)(F.ws + WS_KVM); const bf16* qx = (const bf16*)(F.ws + WS_QX); bf16* ox = (bf16*)(F.ws + WS_OX);
    for (int u = F.vcu; u < 256; u += F.G) {
        const int b = u >> 6, h = (u >> 4) & 3, blk = u & 15;
        __syncthreads();
        for (int i = F.tid; i < 2048; i += 512) { const int key = i >> 3, c = i & 7;
            const GAS v4u* src = (const GAS v4u*)(kvm + (size_t)(b * NMEM + key) * 512 + h * 64) + c; Ks[i] = src[0]; Vs[i] = src[32]; }
        __syncthreads();
        const size_t token = (size_t)b * SEQ + blk * 512 + F.tid;
        float q[64], acc[64];
        { const GAS v4u* qp = (const GAS v4u*)(qx + token * 256 + h * 64);
#pragma unroll
          for (int c = 0; c < 8; ++c) { const v4u w = qp[c]; UNPK8(q, 8 * c, w); } }
#pragma unroll
        for (int d = 0; d < 64; ++d) acc[d] = 0.f;
        float m = -1e30f, l = 0.f;
        for (int key = 0; key < NMEM; ++key) {
            float s = 0.f;
#pragma unroll
            for (int c = 0; c < 8; ++c) { const v4u w = Ks[key * 8 + c]; s += DOT8(q, 8 * c, w); }
            s *= 0.125f;
            const float mn = fmaxf(m, s), al = __expf(m - mn), p = __expf(s - mn); l = l * al + p; m = mn;
#pragma unroll
            for (int c = 0; c < 8; ++c) { const v4u w = Vs[key * 8 + c]; AXPY8(acc, 8 * c, al, p, w); }
        }
        const float inv = 1.f / l;
        GAS v4u* op = (GAS v4u*)(ox + token * 256 + h * 64);
#pragma unroll
        for (int c = 0; c < 8; ++c) { v4u o; o.x = pk2(acc[8 * c] * inv, acc[8 * c + 1] * inv); o.y = pk2(acc[8 * c + 2] * inv, acc[8 * c + 3] * inv);
            o.z = pk2(acc[8 * c + 4] * inv, acc[8 * c + 5] * inv); o.w = pk2(acc[8 * c + 6] * inv, acc[8 * c + 7] * inv); op[c] = o; }
    }
}

__device__ __forceinline__ void swa_naive(Frame& F, int o) {
    LAS v4u* Ks = (LAS v4u*)(F.lds); LAS v4u* Vs = (LAS v4u*)(F.lds + 24576); LAS float* lut = (LAS float*)(F.lds + 49152);
    const bf16* z = (const bf16*)(F.ws + WS_Z); bf16* hc = (bf16*)(F.ws + WS_HC);
    const float* tab = F.in[I_TAB]; const float* sinks = F.in[I_OSINK] + o * 16;
    for (int u = F.vcu; u < NB * 128 * 2; u += F.G) {
        const int b = u >> 8, c = (u >> 1) & 127, kvh = u & 1;
        __syncthreads();
        const int jmin = c >= 2 ? 0 : (2 - c) * 64;
        for (int i = F.tid; i < 192 * 8; i += 512) { const int j = i >> 3, cc = i & 7;
            if (j >= jmin) { const size_t kt = (size_t)b * SEQ + (c - 2) * 64 + j;
                Ks[i] = *((const GAS v4u*)(z + kt * ZO + OKK + kvh * 64) + cc); Vs[i] = *((const GAS v4u*)(z + kt * ZO + OVV + kvh * 64) + cc); } }
        for (int i = F.tid; i < 8 * 256; i += 512) { const int g = i >> 8, r = i & 255; lut[i] = r < 255 ? ((const GAS float*)tab)[t5_bucket(r - 191) * 28 + 12 + kvh * 8 + g] : 0.f; }
        __syncthreads();
        const int g = F.wave, head = kvh * 8 + g, qi = F.lane;
        const size_t token = (size_t)b * SEQ + c * 64 + qi;
        float q[64], acc[64];
        { const GAS v4u* qp = (const GAS v4u*)(z + token * ZO + OQ + head * 64);
#pragma unroll
          for (int cc = 0; cc < 8; ++cc) { const v4u w = qp[cc]; UNPK8(q, 8 * cc, w); } }
#pragma unroll
        for (int d = 0; d < 64; ++d) acc[d] = 0.f;
        float m = ((const GAS float*)sinks)[head], l = 1.f;
        for (int j = jmin; j < 192; ++j) {
            float s = 0.f;
#pragma unroll
            for (int cc = 0; cc < 8; ++cc) { const v4u w = Ks[j * 8 + cc]; s += DOT8(q, 8 * cc, w); }
            s = s * 0.125f + lut[g * 256 + j + 63 - qi];
            const float mn = fmaxf(m, s), al = __expf(m - mn), p = __expf(s - mn); l = l * al + p; m = mn;
#pragma unroll
            for (int cc = 0; cc < 8; ++cc) { const v4u w = Vs[j * 8 + cc]; AXPY8(acc, 8 * cc, al, p, w); }
        }
        const float inv = 1.f / l;
        GAS v4u* op = (GAS v4u*)(hc + token * HCO + head * 64);
#pragma unroll
        for (int cc = 0; cc < 8; ++cc) { v4u ov; ov.x = pk2(acc[8 * cc] * inv, acc[8 * cc + 1] * inv); ov.y = pk2(acc[8 * cc + 2] * inv, acc[8 * cc + 3] * inv);
            ov.z = pk2(acc[8 * cc + 4] * inv, acc[8 * cc + 5] * inv); ov.w = pk2(acc[8 * cc + 6] * inv, acc[8 * cc + 7] * inv); op[cc] = ov; }
    }
}

constexpr int DLUT = 832, DLUT_OFF = 767;
__device__ __forceinline__ void diff_naive(Frame& F, int e, float lam_init) {
    LAS v4u* Ks = (LAS v4u*)(F.lds); LAS v4u* Vs = (LAS v4u*)(F.lds + 16384); LAS float* lut = (LAS float*)(F.lds + 32768); LAS float* xb = (LAS float*)(F.lds + 36864);
    LAS float* xs = (LAS float*)(F.lds + 36864 + 256 * 65 * 4);
    const bf16* z = (const bf16*)(F.ws + WS_Z); bf16* hc = (bf16*)(F.ws + WS_HC);
    const float* tab = F.in[I_TAB]; const float* lamv = F.in[I_ELAM] + e * 256; const float* subln = F.in[I_ESUB] + e * 128;
    float lam;
    { const float a = ((const GAS float*)lamv)[F.lane] * ((const GAS float*)lamv)[64 + F.lane], b2 = ((const GAS float*)lamv)[128 + F.lane] * ((const GAS float*)lamv)[192 + F.lane];
      lam = __expf(wave_sum(a)) - __expf(wave_sum(b2)) + lam_init; }
    for (int u = F.vcu; u < NB * 4 * 64; u += F.G) {
        const int b = u >> 8, h = (u >> 6) & 3, qb = u & 63;
        const int mm = F.tid >> 8, half = (F.tid >> 7) & 1, qi = F.tid & 127, t = qb * 128 + qi, ct = t >> 6;
        const size_t token = (size_t)b * SEQ + t;
        __syncthreads();
        for (int i = F.tid; i < DLUT; i += 512) lut[i] = ((const GAS float*)tab)[t5_bucket(i - DLUT_OFF) * 28 + 8 + h];
        float acc[64]; v4u qpk[8];
        { const GAS v4u* qp = (const GAS v4u*)(z + token * ZE + ZQB + h * 128 + mm * 64);
#pragma unroll
          for (int c = 0; c < 8; ++c) qpk[c] = qp[c]; }
#pragma unroll
        for (int d = 0; d < 64; ++d) acc[d] = 0.f;
        float m = -1e30f, l = 0.f;
        const int ntile = 2 * qb + 2;
        for (int tile = 0; tile < ntile; ++tile) {
            __syncthreads();
            for (int i = F.tid; i < 1024; i += 512) { const int key = i >> 4, c = i & 15; const size_t kt = (size_t)b * SEQ + tile * 64 + key;
                Ks[i] = *((const GAS v4u*)(z + kt * ZE + ZKB + h * 128) + c); Vs[i] = *((const GAS v4u*)(z + kt * ZE + ZVB + h * 128) + c); }
            __syncthreads();
            if (tile <= ct) {
                for (int key = 0; key < 64; ++key) {
                    float s = 0.f;
#pragma unroll
                    for (int c = 0; c < 8; ++c) { const v4u w = Ks[key * 16 + mm * 8 + c]; float qq[8]; UNPK8(qq, 0, qpk[c]); s += DOT8(qq, 0, w); }
                    int rel = tile * 64 + key - t; rel = rel < -DLUT_OFF ? -DLUT_OFF : rel;
                    s = s * 0.125f + lut[rel + DLUT_OFF];
                    const float mn = fmaxf(m, s), al = __expf(m - mn), p = __expf(s - mn); l = l * al + p; m = mn;
#pragma unroll
                    for (int c = 0; c < 8; ++c) { const v4u w = Vs[key * 16 + half * 8 + c]; AXPY8(acc, 8 * c, al, p, w); }
                }
            }
        }
        const float inv = 1.f / l;
#pragma unroll
        for (int d = 0; d < 64; ++d) acc[d] *= inv;
        __syncthreads();
        if (mm == 1) {
#pragma unroll
            for (int d = 0; d < 64; ++d) xb[(half * 128 + qi) * 65 + d] = acc[d]; }
        __syncthreads();
        float ss = 0.f;
        if (mm == 0) {
#pragma unroll
            for (int d = 0; d < 64; ++d) { acc[d] -= lam * xb[(half * 128 + qi) * 65 + d]; ss += acc[d] * acc[d]; }
            xs[half * 128 + qi] = ss; }
        __syncthreads();
        if (mm == 0) {
            ss += xs[(half ^ 1) * 128 + qi];
            const float rr = (1.f / sqrtf(ss * (1.f / 128.f) + EPS)) * (1.f - lam_init);
            GAS v4u* op = (GAS v4u*)(hc + token * HCE + 1024 + h * 128 + half * 64);
#pragma unroll
            for (int c = 0; c < 8; ++c) { const GAS f32x4* sg = (const GAS f32x4*)(subln + half * 64 + 8 * c); const f32x4 g0 = sg[0], g1 = sg[1]; v4u ov;
                ov.x = pk2(acc[8 * c] * rr * g0.x, acc[8 * c + 1] * rr * g0.y); ov.y = pk2(acc[8 * c + 2] * rr * g0.z, acc[8 * c + 3] * rr * g0.w);
                ov.z = pk2(acc[8 * c + 4] * rr * g1.x, acc[8 * c + 5] * rr * g1.y); ov.w = pk2(acc[8 * c + 6] * rr * g1.z, acc[8 * c + 7] * rr * g1.w); op[c] = ov; }
        }
    }
}

constexpr int TOPK = 256, CANDMAX = 512;
constexpr int DL_SEL = 0;
constexpr int DL_CNT = 16384;
constexpr int DL_W = 16640;
constexpr int DL_QI = DL_W;
constexpr int DL_WI = DL_W + 32768;
constexpr int DL_HIST = DL_W;
constexpr int DL_CAND = DL_W + 65536;
constexpr int DL_QL = DL_W;
constexpr int DL_P = DL_W + 32768;
static_assert(DL_CAND + 32768 <= RING_BYTES && DL_P + 65536 <= RING_BYTES, "DSA LDS map");

__device__ __forceinline__ unsigned fkey(float f) { const unsigned u = __builtin_bit_cast(unsigned, f); return (u & 0x80000000u) ? ~u : (u | 0x80000000u); }

__device__ __forceinline__ void indexer_naive(Frame& F, int b, int t0, int N, float* scr) {
    LAS float* qi = (LAS float*)(F.lds + DL_QI); LAS float* wi = (LAS float*)(F.lds + DL_WI);
    const bf16* z = (const bf16*)(F.ws + WS_Z);
    for (int i = F.tid; i < 16 * 64; i += 512) { const int q = i >> 6, c = i & 63;
        const v4u w = *((const GAS v4u*)(z + ((size_t)b * SEQ + t0 + q) * ZE + ZQI) + c); float v[8]; UNPK8(v, 0, w);
#pragma unroll
        for (int k = 0; k < 8; ++k) qi[q * 512 + c * 8 + k] = v[k]; }
    if (F.tid < 128) { const int q = F.tid >> 3, hh = F.tid & 7; wi[F.tid] = bf2f(((const GAS bf16*)z)[((size_t)b * SEQ + t0 + q) * ZE + ZWI + hh]); }
    __syncthreads();
    for (int s = F.tid; s < N; s += 512) {
        float k[64];
        { const GAS v4u* kp = (const GAS v4u*)(z + ((size_t)b * SEQ + s) * ZE + ZKI);
#pragma unroll
          for (int c = 0; c < 8; ++c) { const v4u w = kp[c]; UNPK8(k, 8 * c, w); } }
        for (int q = 0; q < 16; ++q) {
            float acc = 0.f;
#pragma unroll
            for (int hh = 0; hh < 8; ++hh) {
                const LAS f32x4* qp = (const LAS f32x4*)(qi + q * 512 + hh * 64); float dsum = 0.f;
#pragma unroll
                for (int c = 0; c < 16; ++c) { const f32x4 qq = qp[c]; dsum += (qq.x * k[4 * c] + qq.y * k[4 * c + 1]) + (qq.z * k[4 * c + 2] + qq.w * k[4 * c + 3]); }
                acc = fmaf(wi[q * 8 + hh], fmaxf(dsum, 0.f), acc);
            }
            ((GAS float*)scr)[(size_t)q * SEQ + s] = acc;
        }
    }
}

__device__ __forceinline__ int find_bin(LAS unsigned* hist, int lane, unsigned target, unsigned& above) {
    unsigned ls = 0;
#pragma unroll 8
    for (int j = 0; j < 32; ++j) ls += hist[32 * lane + j];
    unsigned suf = ls;
#pragma unroll
    for (int o = 1; o < 64; o <<= 1) { const unsigned t = __shfl_down(suf, o); if (lane + o < 64) suf += t; }
    const unsigned long long mk = __ballot(suf >= target);
    const int L = 63 - __builtin_clzll(mk);
    unsigned cum = __shfl(suf, L) - __shfl(ls, L);
    int bsel = 32 * L;
    for (int j = 31; j >= 0; --j) { const unsigned c = hist[32 * L + j]; if (cum + c >= target) { bsel = 32 * L + j; break; } cum += c; }
    above = cum; return bsel;
}

__device__ __forceinline__ int select_topk(const float* row, int N, LAS int* sel, LAS unsigned* hist, LAS unsigned long long* cand, int lane) {
    if (N <= TOPK) { for (int i = lane; i < N; i += 64) sel[i] = i; LDS_WAIT(); return N; }
    const GAS float* r = (const GAS float*)row;
    const unsigned long long lt = (1ull << lane) - 1ull;
    for (int i = lane; i < 2048; i += 64) hist[i] = 0u;
    LDS_WAIT();
    for (int i = lane; i < N; i += 64) { const unsigned u = fkey(r[i]); __hip_atomic_fetch_add(hist + (u >> 21), 1u, __ATOMIC_RELAXED, __HIP_MEMORY_SCOPE_WORKGROUP); }
    LDS_WAIT();
    unsigned above; const unsigned b0 = (unsigned)find_bin(hist, lane, TOPK, above);
    unsigned need = TOPK - above;
    unsigned nsel = 0, nc = 0;
    for (int i0 = 0; i0 < N; i0 += 64) { const int i = i0 + lane; const unsigned u = fkey(r[i]); const unsigned bin = u >> 21;
        const bool ab = bin > b0, eq = bin == b0; const unsigned long long ma = __ballot(ab), me = __ballot(eq);
        { const unsigned pa = nsel + __builtin_popcountll(ma & lt); if (ab && pa < TOPK) sel[pa] = i; }
        const unsigned pe = nc + __builtin_popcountll(me & lt);
        if (eq && pe < CANDMAX) cand[pe] = ((unsigned long long)u << 32) | (unsigned)i;
        nsel += __builtin_popcountll(ma); nc += __builtin_popcountll(me); }
    LDS_WAIT();
    if (nc <= CANDMAX) {
        for (unsigned ci = lane; ci < nc; ci += 64) { const unsigned long long me = cand[ci]; const unsigned ui = (unsigned)(me >> 32), ii = (unsigned)me; unsigned rank = 0;
            for (unsigned j = 0; j < nc; ++j) { const unsigned long long o = cand[j]; const unsigned uj = (unsigned)(o >> 32), ij = (unsigned)o; rank += (uj > ui || (uj == ui && ij < ii)) ? 1u : 0u; }
            if (rank < need && above + rank < TOPK) sel[above + rank] = (int)ii; }
    } else {
        for (int i = lane; i < 2048; i += 64) hist[i] = 0u;
        LDS_WAIT();
        for (int i = lane; i < N; i += 64) { const unsigned u = fkey(r[i]); if ((u >> 21) == b0) __hip_atomic_fetch_add(hist + ((u >> 10) & 0x7ffu), 1u, __ATOMIC_RELAXED, __HIP_MEMORY_SCOPE_WORKGROUP); }
        LDS_WAIT();
        unsigned ab1; const unsigned b1 = (unsigned)find_bin(hist, lane, need, ab1); const unsigned need1 = need - ab1;
        const unsigned pre = (b0 << 11) | b1;
        for (int i = lane; i < 2048; i += 64) hist[i] = 0u;
        LDS_WAIT();
        for (int i = lane; i < N; i += 64) { const unsigned u = fkey(r[i]); if ((u >> 10) == pre) __hip_atomic_fetch_add(hist + (u & 0x3ffu), 1u, __ATOMIC_RELAXED, __HIP_MEMORY_SCOPE_WORKGROUP); }
        LDS_WAIT();
        unsigned ab2; const unsigned b2 = (unsigned)find_bin(hist, lane, need1, ab2); const unsigned need2 = need1 - ab2;
        const unsigned ustar = (pre << 10) | b2;
        unsigned pos = above, neq = 0;
        for (int i0 = 0; i0 < N; i0 += 64) { const int i = i0 + lane; const unsigned u = fkey(r[i]); const bool inb = (u >> 21) == b0;
            const bool gt = inb && u > ustar, eq = inb && u == ustar; const unsigned long long mg = __ballot(gt), me = __ballot(eq);
            const unsigned re = neq + __builtin_popcountll(me & lt);
            const bool take_eq = eq && re < need2; const unsigned long long mt = __ballot(take_eq);
            const unsigned long long mall = mg | mt;
            { const unsigned pp = pos + __builtin_popcountll(mall & lt); if ((gt || take_eq) && pp < TOPK) sel[pp] = i; }
            pos += __builtin_popcountll(mall); neq += __builtin_popcountll(me); }
    }
    LDS_WAIT();
    return TOPK;
}

__device__ __forceinline__ void sparse_naive(Frame& F, int b, int t, const LAS int* sel, int cnt, LAS float* qlw, LAS float* Pw, int lane) {
    const bf16* z = (const bf16*)(F.ws + WS_Z); const bf16* ck = (const bf16*)(F.ws + WS_CKVN) + (size_t)b * SEQ * 128; bf16* hc = (bf16*)(F.ws + WS_HC);
    const float* tab = F.in[I_TAB];
    const size_t token = (size_t)b * SEQ + t;
    { const GAS v4u* qp = (const GAS v4u*)(z + token * ZE + ZQL) + 2 * lane; const v4u w0 = qp[0], w1 = qp[1]; float v[16]; UNPK8(v, 0, w0); UNPK8(v, 8, w1);
#pragma unroll
      for (int k = 0; k < 16; ++k) qlw[16 * lane + k] = v[k]; }
    LDS_WAIT();
    float s[4][8];
#pragma unroll
    for (int kk = 0; kk < 4; ++kk) {
        const int j = lane + 64 * kk; const bool valid = j < cnt; const int key = valid ? sel[j] : 0;
        float acc[8];
#pragma unroll
        for (int hh = 0; hh < 8; ++hh) acc[hh] = 0.f;
        const GAS v4u* cp = (const GAS v4u*)(ck + (size_t)key * 128);
        for (int ch = 0; ch < 16; ++ch) { const v4u w = cp[ch]; float c8[8]; UNPK8(c8, 0, w);
#pragma unroll
            for (int hh = 0; hh < 8; ++hh) { const LAS f32x4* qq = (const LAS f32x4*)(qlw + hh * 128 + ch * 8); const f32x4 a = qq[0], bq = qq[1];
                acc[hh] += (a.x * c8[0] + a.y * c8[1]) + (a.z * c8[2] + a.w * c8[3]) + (bq.x * c8[4] + bq.y * c8[5]) + (bq.z * c8[6] + bq.w * c8[7]); } }
        const int bk = t5_bucket(key - t);
#pragma unroll
        for (int hh = 0; hh < 8; ++hh) s[kk][hh] = valid ? acc[hh] * 0.125f + ((const GAS float*)tab)[bk * 28 + hh] : -1e30f;
    }
#pragma unroll
    for (int hh = 0; hh < 8; ++hh) {
        const float mx = wave_max(fmaxf(fmaxf(s[0][hh], s[1][hh]), fmaxf(s[2][hh], s[3][hh])));
        float p[4], sum = 0.f;
#pragma unroll
        for (int kk = 0; kk < 4; ++kk) { p[kk] = __expf(s[kk][hh] - mx); sum += p[kk]; }
        const float inv = 1.f / wave_sum(sum);
#pragma unroll
        for (int kk = 0; kk < 4; ++kk) Pw[(lane + 64 * kk) * 8 + hh] = p[kk] * inv;
    }
    LDS_WAIT();
    float o0[8], o1[8];
#pragma unroll
    for (int hh = 0; hh < 8; ++hh) { o0[hh] = 0.f; o1[hh] = 0.f; }
    for (int j = 0; j < cnt; ++j) {
        const int key = sel[j]; const unsigned w = *((const GAS unsigned*)(ck + (size_t)key * 128) + lane); const float c0 = bflo(w), c1 = bfhi(w);
        const LAS f32x4* pp = (const LAS f32x4*)(Pw + j * 8); const f32x4 pa = pp[0], pb = pp[1];
        o0[0] += pa.x * c0; o1[0] += pa.x * c1; o0[1] += pa.y * c0; o1[1] += pa.y * c1; o0[2] += pa.z * c0; o1[2] += pa.z * c1; o0[3] += pa.w * c0; o1[3] += pa.w * c1;
        o0[4] += pb.x * c0; o1[4] += pb.x * c1; o0[5] += pb.y * c0; o1[5] += pb.y * c1; o0[6] += pb.z * c0; o1[6] += pb.z * c1; o0[7] += pb.w * c0; o1[7] += pb.w * c1;
    }
#pragma unroll
    for (int hh = 0; hh < 8; ++hh) *((GAS unsigned*)(hc + token * HCE + hh * 128) + lane) = pk2(o0[hh], o1[hh]);
    LDS_WAIT();
}

__device__ __forceinline__ void dsa_phase(Frame& F) {
    float* scr = (float*)(F.ws + WS_SCR) + (size_t)blockIdx.x * 16 * SEQ;
    LAS int* selA = (LAS int*)(F.lds + DL_SEL); LAS int* cntA = (LAS int*)(F.lds + DL_CNT);
    const int NU = NB * 128 * 4;
    for (int ui = F.vcu; ui < NU; ui += F.G) {
        const int rr = ui / F.G, v = ui % F.G;
        const int b = (v * NB) / F.G, j = v % (F.G / NB);
        const int half = rr >> 2, sub = rr & 3;
        const int c = (F.G / NB == 64) ? (half == 0 ? j : 127 - j) : 0;
        const int t0 = c * 64 + sub * 16, N = 64 * (c + 1);
        __syncthreads();
        indexer_naive(F, b, t0, N, scr);
        VM_WAIT(); __syncthreads();
#pragma unroll 1
        for (int r2 = 0; r2 < 2; ++r2) { const int q = F.wave + 8 * r2;
            const int cnt = select_topk(scr + (size_t)q * SEQ, N, selA + q * 256, (LAS unsigned*)(F.lds + DL_HIST) + F.wave * 2048, (LAS unsigned long long*)(F.lds + DL_CAND) + F.wave * 512, F.lane);
            if (F.lane == 0) cntA[q] = cnt; }
        __syncthreads();
#pragma unroll 1
        for (int r2 = 0; r2 < 2; ++r2) { const int q = F.wave + 8 * r2;
            sparse_naive(F, b, t0 + q, selA + q * 256, cntA[q], (LAS float*)(F.lds + DL_QL) + F.wave * 1024, (LAS float*)(F.lds + DL_P) + F.wave * 2048, F.lane); }
    }
}

#ifndef MK_MULTI
#define MK_MULTI 0
#endif
constexpr int N_PHASES = 1 + 2 * (4 + 8) + 2 * (3 + 8);
struct Args { const float* in[20]; float* out; unsigned char* ws; int ph_lo, ph_hi; };
static_assert(sizeof(Args) == 22 * 8 + 8, "Args has no padding");

#define GEMM_CALL(ACTV, Aptr, Bptr, Mv, Nv, Kv, Optr, LDC, CID) do { \
    pg8::Gemm g_{(const pg8::bf16_t*)(Aptr), (const pg8::bf16_t*)(Bptr), (Mv), (Nv), (Kv)}; pg8::StaticOrder S_; S_.init((Mv), (Nv), F.G, (CID)); \
    pg8::EpiAct<ACTV> E_{(pg8::bf16_t*)(Optr), (LDC)}; \
    pg8::gemm_phase<pg8::EpiAct<ACTV>, pg8::StaticOrder, true, true>(F.lds + RING_OFF, g_, S_, E_); } while (0)

__global__ void __launch_bounds__(NWAVES * 64, 2) mk_fwd(Args args) {
    extern __shared__ __attribute__((aligned(16))) unsigned char lds[];
    Frame F;
    F.lds = (LAS unsigned char*)lds;
    F.MISC = (volatile LAS unsigned*)(F.lds + MISC_OFF);
    F.tid = threadIdx.x; F.lane = F.tid & 63; F.wave = __builtin_amdgcn_readfirstlane(F.tid >> 6);
    F.G = gridDim.x; { const int bx = blockIdx.x; F.vcu = (F.G % 8 == 0) ? (bx % 8) * (F.G / 8) + bx / 8 : bx; }
    unsigned char* ws = args.ws; F.ws = ws; F.out = args.out;
    F.ctl = (gu32*)(ws + WS_CTL);
#pragma unroll
    for (int i = 0; i < 20; ++i) F.in[i] = args.in[i];
    for (int u = F.tid; u < (LDS_BYTES - LDSCTL_OFF) / 4; u += NWAVES * 64) ((LAS unsigned*)(F.lds + LDSCTL_OFF))[u] = 0u;
    __syncthreads();
#if MK_MULTI
    XcdBarrier bar; bar.bar = (unsigned*)(F.ctl + CW_BAR); bar.x = 0; bar.st = nullptr;
#else
    XcdBarrier bar = xcd_barrier_post((unsigned*)(F.ctl + CW_BAR), F.MISC + 8);
#endif
    const int lo = args.ph_lo, hi = args.ph_hi;
    int pid = 0;
#define PH_ON (pid >= lo && pid < hi && refresh(F))
#if MK_MULTI
#define PH_END do { ++pid; } while (0)
#else
#define PH_END do { if (pid >= lo && pid + 1 < hi) xcd_barrier(bar); ++pid; } while (0)
#endif
    bf16* const WIN = (bf16*)(ws + WS_WGT + WO_WIN); bf16* const WOUT = (bf16*)(ws + WS_WGT + WO_WOUT); bf16* const WQ = (bf16*)(ws + WS_WGT + WO_WQ); bf16* const WKV = (bf16*)(ws + WS_WGT + WO_WKV);
    bf16* const WO = (bf16*)(ws + WS_WGT + WO_WO); bf16* const W1 = (bf16*)(ws + WS_WGT + WO_W1); bf16* const W2 = (bf16*)(ws + WS_WGT + WO_W2);
    bf16* const HC = (bf16*)(ws + WS_HC); bf16* const Z = (bf16*)(ws + WS_Z); bf16* const Y = (bf16*)(ws + WS_Y); bf16* const U = (bf16*)(ws + WS_U);
    bf16* const QX = (bf16*)(ws + WS_QX); bf16* const OX = (bf16*)(ws + WS_OX); bf16* const MEMN = (bf16*)(ws + WS_MEMN); bf16* const KVM = (bf16*)(ws + WS_KVM);
    const float* const NG = F.in[I_NG];

    if (PH_ON) { convert_weights(F, 0); thin_first(F, NG); }
    PH_END;

#pragma unroll 1
    for (int l = 0; l < 4; ++l) {
        const float* g = NG + (size_t)l * 6 * D;
        if ((l & 1) == 0) {
            const int e = l >> 1; const float lam_init = e == 0 ? 0.20000000000000007f : 0.4707130183435842f;
            if (PH_ON) { GEMM_CALL(0, HC, WIN, M, ZE, D, Z, ZE, (int)blockIdx.x); }
            PH_END;
            if (PH_ON) { thin_ckvn(F, F.in[I_EKVN] + e * 128); }
            PH_END;
            if (PH_ON) { diff_naive(F, e, lam_init); dsa_phase(F); }
            PH_END;
            if (PH_ON) { GEMM_CALL(0, HC, WOUT, M, D, HCE, Y, D, (int)blockIdx.x); }
            PH_END;
        } else {
            const int o = l >> 1;
            if (PH_ON) { GEMM_CALL(0, HC, WIN, M, ZO, D, Z, ZO, (int)blockIdx.x); }
            PH_END;
            if (PH_ON) { swa_naive(F, o); }
            PH_END;
            if (PH_ON) { GEMM_CALL(0, HC, WOUT, M, D, HCO, Y, D, (int)blockIdx.x); }
            PH_END;
        }
        if (PH_ON) { thin_mid(F, g + 1 * D, g + 2 * D); thin_memn(F, F.in[I_XMN] + (size_t)l * D); }
        PH_END;
        if (PH_ON) { GEMM_CALL(0, HC, WQ, M, 256, D, QX, 256, (int)blockIdx.x); GEMM_CALL(0, MEMN, WKV, NB * NMEM, 512, D, KVM, 512, (int)((blockIdx.x + 128) % F.G)); }
        PH_END;
        if (PH_ON) { xattn_naive(F); }
        PH_END;
        if (PH_ON) { GEMM_CALL(0, OX, WO, M, D, 256, Y, D, (int)blockIdx.x); }
        PH_END;
        if (PH_ON) { thin_mid(F, g + 3 * D, g + 4 * D); }
        PH_END;
        if (PH_ON) { GEMM_CALL(2, HC, W1, M, FF, D, U, FF, (int)blockIdx.x); }
        PH_END;
        if (PH_ON) { GEMM_CALL(0, U, W2, M, D, FF, Y, D, (int)blockIdx.x); }
        PH_END;
        if (PH_ON) { thin_mid(F, g + 5 * D, l < 3 ? g + 6 * D : nullptr); if (l < 3) convert_weights(F, l + 1); }
        PH_END;
    }
}

extern "C" void kernel_launch(void* const* d_in, const int* in_sizes, int n_in, void* d_out, int out_size, void* d_ws, size_t ws_size, hipStream_t stream) {
    static int grid = 0;
    if (grid == 0) {
        if (n_in != 20 || out_size != M * D || ws_size < WS_END) { fprintf(stderr, "kernel_launch: unexpected shapes: n_in %d out %d ws %zu (need %zu)\n", n_in, out_size, ws_size, (size_t)WS_END); grid = -1; return; }
        int dev = 0, cus = 0, per_cu = 0;
        if (hipGetDevice(&dev) != hipSuccess || hipDeviceGetAttribute(&cus, hipDeviceAttributeMultiprocessorCount, dev) != hipSuccess) { grid = -1; return; }
        if (hipFuncSetAttribute((const void*)mk_fwd, hipFuncAttributeMaxDynamicSharedMemorySize, LDS_BYTES) != hipSuccess) { fprintf(stderr, "kernel_launch: hipFuncSetAttribute failed\n"); grid = -1; return; }
        if (hipOccupancyMaxActiveBlocksPerMultiprocessor(&per_cu, (const void*)mk_fwd, NWAVES * 64, LDS_BYTES) != hipSuccess || per_cu < 1)
            fprintf(stderr, "kernel_launch: note: occupancy query reports %d workgroups per CU\n", per_cu);
        (void)hipGetLastError();
        grid = cus;
        if (grid != 256) { fprintf(stderr, "kernel_launch: built for 256 CUs, device has %d\n", cus); grid = -1; return; }
    }
    if (grid < 0) return;
    if (hipMemsetAsync((char*)d_ws + WS_CTL, 0, CTL_ZERO_BYTES, stream) != hipSuccess) return;
    Args a{};
    for (int i = 0; i < 20; ++i) a.in[i] = (const float*)d_in[i];
    a.out = (float*)d_out; a.ws = (unsigned char*)d_ws;
#if MK_MULTI
    for (int p = 0; p < N_PHASES; ++p) { a.ph_lo = p; a.ph_hi = p + 1; hipLaunchKernelGGL(mk_fwd, dim3(grid), dim3(NWAVES * 64), LDS_BYTES, stream, a); }
#else
    a.ph_lo = 0; a.ph_hi = N_PHASES; hipLaunchKernelGGL(mk_fwd, dim3(grid), dim3(NWAVES * 64), LDS_BYTES, stream, a);
#endif
}
```

```cpp
#include <hip/hip_runtime.h>
#include <cstdio>
#include <cstdint>
namespace pg8 {
#define PG8_LAS __attribute__((address_space(3)))
typedef unsigned short bf16_t;
typedef short bf16x8 __attribute__((ext_vector_type(8)));
typedef float f32x4 __attribute__((ext_vector_type(4)));
typedef unsigned u32x4 __attribute__((ext_vector_type(4)));
constexpr int BM = 256, BK = 64, HALF = 128, HTB = HALF * BK * 2  , STAGE_BYTES = 8 * HTB, NXCD = 8, WGM = 8;

__host__ __device__ __forceinline__ int lds_byte(int r, int c) { const int st = (r >> 4) * 2 + (c >> 5), rr = r & 15, cc = c & 31, ob = rr * 64 + cc * 2; return st * 1024 + (ob ^ (((ob >> 9) & 1) << 5)); }
__host__ __device__ __forceinline__ void stage_rc(int b, int& R, int& C) { const int st = b / 1024, sb = b % 1024, swz = sb ^ (((sb >> 9) & 1) << 5); R = (st >> 1) * 16 + swz / 64; C = (st & 1) * 32 + (swz % 64) / 2; }
__host__ __device__ __forceinline__ int perm32(int rho) { const int n = rho >> 4, i = rho & 15; return 8 * (i >> 2) + 4 * n + (i & 3); }

struct Unit { int pm, pn; };
struct Gemm { const bf16_t* A; const bf16_t* Bt; int M, N, K; };

struct StaticOrder {
    int nM, nN, nwg, G, c;
    __host__ __device__ void init(int M, int N, int G_, int c_) { nM = M / BM; nN = N / BM; nwg = nM * nN; G = G_; c = c_; }
    __host__ __device__ bool next(int i, Unit& u) const {
        const long L = (long)i * G + c; if (L >= nwg) return false;
        int wgid = (int)L; { const int q = nwg / NXCD, r = nwg % NXCD, xcd = wgid % NXCD, off = wgid / NXCD; wgid = (xcd < r ? xcd * (q + 1) : r * (q + 1) + (xcd - r) * q) + off; }
        const int nig = WGM * nN, gid = wgid / nig, fm = gid * WGM, gsz = (nM - fm) < WGM ? (nM - fm) : WGM;
        u.pm = fm + ((wgid % nig) % gsz); u.pn = (wgid % nig) / gsz; return true;
    }
    __device__ __forceinline__ void a_ready(const Unit&) const {}
    __device__ __forceinline__ void done(const Unit&) const {}
};


__device__ __forceinline__ unsigned cvt_pk_bf16(float lo, float hi) { unsigned r; asm volatile("v_cvt_pk_bf16_f32 %0, %1, %2" : "=v"(r) : "v"(lo), "v"(hi)); return r; }
template <int ACT  > struct EpiAct {
    static constexpr bool PERM = true, AFTER_DRAIN = false;
    bf16_t* O; int ldc;
    __device__ __forceinline__ void operator()(const f32x4 (&acc)[2][2][4][2], const Unit& u, int wr, int wc, int fr, int fq) const {
        const int row0 = u.pm * BM + wr * 64 + fr; const int col0 = u.pn * BM + wc * 32 + 8 * fq;
#pragma unroll
        for (int ai = 0; ai < 2; ++ai)
#pragma unroll
            for (int m = 0; m < 4; ++m) { bf16_t* rowp = O + (size_t)(row0 + ai * HALF + m * 16) * ldc + col0;
#pragma unroll
                for (int bj = 0; bj < 2; ++bj) { f32x4 v0 = acc[ai][bj][m][0], v1 = acc[ai][bj][m][1];
                    if (ACT == 2) {
#pragma unroll
                        for (int i = 0; i < 4; ++i) { float a = v0[i] > 0.f ? v0[i] : 0.f; v0[i] = a * a; float b = v1[i] > 0.f ? v1[i] : 0.f; v1[i] = b * b; }
                    }
                    u32x4 w; w.x = cvt_pk_bf16(v0[0], v0[1]); w.y = cvt_pk_bf16(v0[2], v0[3]); w.z = cvt_pk_bf16(v1[0], v1[1]); w.w = cvt_pk_bf16(v1[2], v1[3]);
                    *(u32x4*)(rowp + bj * HALF) = w; } }
    }
};
template <class Epi, class Sched, bool ALIGN_EPI = false, bool SP2 = false>
__device__ __forceinline__ void gemm_phase(PG8_LAS unsigned char* lds, const Gemm g, const Sched& S, const Epi& E) {
    int tid_ = threadIdx.x; asm volatile("" : "+v"(tid_)); const int tid = tid_, wid = __builtin_amdgcn_readfirstlane(tid >> 6), lane = tid & 63, wr = wid >> 2, wc = wid & 3, fr = lane & 15, fq = lane >> 4;
    const int K = g.K, nt = K / BK;
    unsigned voffA[2], voffB[2];
#pragma unroll
    for (int i = 0; i < 2; ++i) { int R, C; stage_rc(tid * 16 + i * 8192, R, C); const int Rb = Epi::PERM ? ((R & ~31) + perm32(R & 31)) : R;
        voffA[i] = (unsigned)(R * K + C) * 2u; voffB[i] = (unsigned)(Rb * K + C) * 2u; }
    const size_t kstep = (size_t)(BK * 2);
    const size_t hstep = (size_t)HALF * K * 2;
    const size_t tstep = 2 * hstep;
    const unsigned ldsw = (unsigned)wid * 1024u;
    const int aoff = lds_byte(wr * 64 + fr, fq * 8), boff = lds_byte(wc * 32 + fr, fq * 8);
#define PG8_SA(b, h) (((b) * 2 + (h)) * HTB)
#define PG8_SB(b, h) ((4 + (b) * 2 + (h)) * HTB)
#define PG8_STAGE(bufoff, gbase, voff) do { _Pragma("unroll") for (int _i = 0; _i < 2; ++_i) \
        __builtin_amdgcn_global_load_lds((const unsigned*)((const char*)(gbase) + (voff)[_i]), (PG8_LAS unsigned*)(lds + (bufoff) + ldsw + _i * 8192), 16, 0, 0); } while (0)
#define PG8_LDA(dst, b, h) do { _Pragma("unroll") for (int m = 0; m < 4; ++m) _Pragma("unroll") for (int k = 0; k < 2; ++k) dst[m][k] = *(const PG8_LAS bf16x8*)(lds + PG8_SA(b, h) + aoff + m * 2048 + k * 1024); } while (0)
#define PG8_LDB(dst, b, h) do { _Pragma("unroll") for (int n = 0; n < 2; ++n) _Pragma("unroll") for (int k = 0; k < 2; ++k) dst[n][k] = *(const PG8_LAS bf16x8*)(lds + PG8_SB(b, h) + boff + n * 2048 + k * 1024); } while (0)
#define PG8_MMA(ai, bj, At, Bt) do { __builtin_amdgcn_s_setprio(1); _Pragma("unroll") for (int m = 0; m < 4; ++m) _Pragma("unroll") for (int n = 0; n < 2; ++n) _Pragma("unroll") for (int k = 0; k < 2; ++k) \
        acc[ai][bj][m][n] = __builtin_amdgcn_mfma_f32_16x16x32_bf16(Bt[n][k], At[m][k], acc[ai][bj][m][n], 0, 0, 0); __builtin_amdgcn_s_setprio(0); } while (0)
#define PG8_WAIT_V(n) asm volatile("s_waitcnt vmcnt(" #n ")" ::: "memory")
#define PG8_WAIT_L(n) asm volatile("s_waitcnt lgkmcnt(" #n ")" ::: "memory")
#define PG8_BAR __builtin_amdgcn_s_barrier()
#define PG8_SCHED __builtin_amdgcn_sched_barrier(0)
    Unit cur, nxt; int ui = 0;
    if (!S.next(0, cur)) return;
    f32x4 acc[2][2][4][2];
#pragma unroll
    for (int a = 0; a < 2; ++a)
#pragma unroll
        for (int b = 0; b < 2; ++b)
#pragma unroll
            for (int m = 0; m < 4; ++m)
#pragma unroll
                for (int n = 0; n < 2; ++n) acc[a][b][m][n] = (f32x4){0.f, 0.f, 0.f, 0.f};
    bf16x8 At[4][2], B0[2][2], B1[2][2];
    const char* cA = (const char*)g.A + (size_t)cur.pm * tstep; const char* cB = (const char*)g.Bt + (size_t)cur.pn * tstep;
    S.a_ready(cur);
    if constexpr (SP2) {
        PG8_STAGE(PG8_SB(0, 0), cB, voffB); PG8_STAGE(PG8_SB(0, 1), cB + hstep, voffB); PG8_STAGE(PG8_SA(0, 0), cA, voffA); PG8_STAGE(PG8_SA(0, 1), cA + hstep, voffA);
        if (wr == 1) PG8_BAR;
        PG8_WAIT_V(2); PG8_BAR;
        PG8_STAGE(PG8_SB(1, 0), cB + kstep, voffB); PG8_STAGE(PG8_SA(1, 0), cA + kstep, voffA); PG8_STAGE(PG8_SB(1, 1), cB + hstep + kstep, voffB);
        PG8_WAIT_V(6); PG8_BAR;
    } else {
        PG8_STAGE(PG8_SB(0, 0), cB, voffB); PG8_STAGE(PG8_SA(0, 0), cA, voffA); PG8_STAGE(PG8_SB(0, 1), cB + hstep, voffB); PG8_STAGE(PG8_SA(0, 1), cA + hstep, voffA);
        if (wr == 1) PG8_BAR;
        PG8_WAIT_V(4); PG8_BAR;
        PG8_STAGE(PG8_SB(1, 0), cB + kstep, voffB); PG8_STAGE(PG8_SA(1, 0), cA + kstep, voffA); PG8_STAGE(PG8_SB(1, 1), cB + hstep + kstep, voffB);
        PG8_WAIT_V(6); PG8_BAR;
    }
    for (;;) {
        const bool has_next = S.next(ui + 1, nxt);
        const char* nA = has_next ? (const char*)g.A + (size_t)nxt.pm * tstep : cA; const char* nB = has_next ? (const char*)g.Bt + (size_t)nxt.pn * tstep : cB;
        for (int t = 0; t < nt; t += 2) {
            const bool last = (t == nt - 2);
            const char* a1 = cA + (size_t)(t + 1) * kstep;
            const char* a2 = last ? nA : cA + (size_t)(t + 2) * kstep; const char* b2 = last ? nB : cB + (size_t)(t + 2) * kstep;
            const char* a3 = a2 + kstep; const char* b3 = b2 + kstep;
            if (last && has_next) S.a_ready(nxt);
            if constexpr (SP2) {
            PG8_LDB(B0, 0, 0); PG8_LDB(B1, 0, 1); PG8_SCHED; PG8_LDA(At, 0, 0); PG8_STAGE(PG8_SA(1, 1), a1 + hstep, voffA);
            PG8_WAIT_V(8); PG8_WAIT_L(0); PG8_BAR; PG8_MMA(0, 0, At, B0); PG8_MMA(0, 1, At, B1); PG8_BAR; PG8_SCHED;
            PG8_LDA(At, 0, 1); PG8_STAGE(PG8_SB(0, 0), b2, voffB); PG8_STAGE(PG8_SB(0, 1), b2 + hstep, voffB); PG8_STAGE(PG8_SA(0, 0), a2, voffA);
            PG8_WAIT_V(8); PG8_WAIT_L(0); PG8_BAR; PG8_MMA(1, 0, At, B0); PG8_MMA(1, 1, At, B1); PG8_BAR; PG8_SCHED;
            PG8_LDB(B0, 1, 0); PG8_LDB(B1, 1, 1); PG8_SCHED; PG8_LDA(At, 1, 0); PG8_STAGE(PG8_SA(0, 1), a2 + hstep, voffA);
            PG8_WAIT_V(8); PG8_WAIT_L(0); PG8_BAR; PG8_MMA(0, 0, At, B0); PG8_MMA(0, 1, At, B1); PG8_BAR; PG8_SCHED;
            PG8_LDA(At, 1, 1); PG8_STAGE(PG8_SB(1, 0), b3, voffB); PG8_STAGE(PG8_SB(1, 1), b3 + hstep, voffB); PG8_STAGE(PG8_SA(1, 0), a3, voffA);
            PG8_WAIT_V(8); PG8_WAIT_L(0); PG8_BAR; PG8_MMA(1, 0, At, B0); PG8_MMA(1, 1, At, B1); PG8_BAR; PG8_SCHED;
            } else {
            PG8_LDB(B0, 0, 0); PG8_SCHED; PG8_LDA(At, 0, 0); PG8_STAGE(PG8_SA(1, 1), a1 + hstep, voffA);
            PG8_WAIT_L(8); PG8_BAR; PG8_WAIT_L(0); PG8_MMA(0, 0, At, B0); PG8_BAR; PG8_SCHED;
            PG8_LDB(B1, 0, 1); PG8_STAGE(PG8_SB(0, 0), b2, voffB);
            PG8_BAR; PG8_WAIT_L(0); PG8_MMA(0, 1, At, B1); PG8_BAR;
            PG8_LDA(At, 0, 1); PG8_STAGE(PG8_SA(0, 0), a2, voffA);
            PG8_BAR; PG8_WAIT_L(0); PG8_MMA(1, 0, At, B0); PG8_BAR; PG8_SCHED;
            PG8_STAGE(PG8_SB(0, 1), b2 + hstep, voffB);
            PG8_WAIT_V(6); PG8_BAR; PG8_MMA(1, 1, At, B1); PG8_BAR;
            PG8_LDB(B0, 1, 0); PG8_SCHED; PG8_LDA(At, 1, 0); PG8_STAGE(PG8_SA(0, 1), a2 + hstep, voffA);
            PG8_WAIT_L(8); PG8_BAR; PG8_WAIT_L(0); PG8_MMA(0, 0, At, B0); PG8_BAR; PG8_SCHED;
            PG8_LDB(B1, 1, 1); PG8_STAGE(PG8_SB(1, 0), b3, voffB);
            PG8_BAR; PG8_WAIT_L(0); PG8_MMA(0, 1, At, B1); PG8_BAR;
            PG8_LDA(At, 1, 1); PG8_STAGE(PG8_SA(1, 0), a3, voffA);
            PG8_BAR; PG8_WAIT_L(0); PG8_MMA(1, 0, At, B0); PG8_BAR; PG8_SCHED;
            PG8_STAGE(PG8_SB(1, 1), b3 + hstep, voffB);
            PG8_WAIT_V(6); PG8_BAR; PG8_MMA(1, 1, At, B1); PG8_BAR;
            }
        }
        if constexpr (ALIGN_EPI) { if (wr == 0) PG8_BAR; }
        if constexpr (!Epi::AFTER_DRAIN) { E(acc, cur, wr, wc, fr, fq); S.done(cur); }
        if (!has_next) break;
#pragma unroll
        for (int a = 0; a < 2; ++a)
#pragma unroll
            for (int b = 0; b < 2; ++b)
#pragma unroll
                for (int m = 0; m < 4; ++m)
#pragma unroll
                    for (int n = 0; n < 2; ++n) acc[a][b][m][n] = (f32x4){0.f, 0.f, 0.f, 0.f};
        cur = nxt; cA = nA; cB = nB; ++ui;
        if constexpr (ALIGN_EPI) { if (wr == 1) PG8_BAR; }
    }
    PG8_WAIT_V(0);
    if constexpr (!ALIGN_EPI) { if (wr == 0) PG8_BAR; }
    PG8_BAR;
    if constexpr (Epi::AFTER_DRAIN) { E.fused(acc, cur, wr, wc, fr, fq, lds, wid, lane); S.done(cur); }
#undef PG8_SA
#undef PG8_SB
#undef PG8_STAGE
#undef PG8_LDA
#undef PG8_LDB
#undef PG8_MMA
#undef PG8_WAIT_V
#undef PG8_WAIT_L
#undef PG8_BAR
#undef PG8_SCHED
}
}

constexpr int NWAVES = 8;
constexpr int NB = 4, SEQ = 8192, D = 1024, M = NB * SEQ, FF = 4096, NMEM = 256;
constexpr int ZE = 3328, ZO = 1280;
constexpr int ZQL = 0, ZCKV = 1024, ZQI = 1152, ZKI = 1664, ZWI = 1728, ZQB = 1792, ZKB = 2304, ZVB = 2816;
constexpr int OQ = 0, OKK = 1024, OVV = 1152;
constexpr int EVC = 2760;
constexpr int HCE = 1536, HCO = 1024;
constexpr float EPS = 1e-6f;
constexpr float LOG2E = 1.4426950408889634f;

constexpr size_t MiB = 1u << 20;
constexpr size_t WS_CTL = 0, CTL_ZERO_BYTES = 1 * MiB;
constexpr size_t WS_WGT = 1 * MiB;
constexpr size_t WO_WIN = 0, WO_WOUT = 6 * MiB + MiB / 2, WO_WQ = 9 * MiB + MiB / 2, WO_WKV = 10 * MiB, WO_WO = 11 * MiB, WO_W1 = 11 * MiB + MiB / 2, WO_W2 = 19 * MiB + MiB / 2;
constexpr size_t WS_MEMN = 33 * MiB, WS_KVM = 35 * MiB, WS_CKVN = 36 * MiB, WS_QX = 44 * MiB, WS_OX = 60 * MiB, WS_HC = 76 * MiB, WS_ZS = 172 * MiB;
constexpr size_t WS_Z = WS_ZS, WS_SCR = WS_ZS + 208 * MiB, WS_U = WS_ZS, WS_Y = WS_ZS + 272 * MiB, WS_END = WS_ZS + 336 * MiB;
static_assert(WS_END == 508 * MiB, "ws map");
constexpr int CW_BAR = 4096;

constexpr int RING_OFF = 0, RING_BYTES = 131072;
constexpr int LDSCTL_OFF = RING_BYTES, MISC_OFF = LDSCTL_OFF + 320;
constexpr int LDS_BYTES = 147456;

#define GAS __attribute__((address_space(1)))
#define LAS __attribute__((address_space(3)))
typedef unsigned short bf16;
typedef unsigned v4u __attribute__((ext_vector_type(4)));
typedef unsigned v2u __attribute__((ext_vector_type(2)));
typedef float f32x4 __attribute__((ext_vector_type(4)));
typedef GAS unsigned gu32;
#define RLX_AGENT __ATOMIC_RELAXED, __HIP_MEMORY_SCOPE_AGENT
#define LDS_WAIT() asm volatile("s_waitcnt lgkmcnt(0)" ::: "memory")
#define VM_WAIT() asm volatile("s_waitcnt vmcnt(0)" ::: "memory")
__device__ __forceinline__ unsigned f2bf(float f) { unsigned u = __builtin_bit_cast(unsigned, f); return (u + 0x7fffu + ((u >> 16) & 1u)) >> 16; }
__device__ __forceinline__ unsigned pk2(float lo, float hi) { return f2bf(lo) | (f2bf(hi) << 16); }
__device__ __forceinline__ float bflo(unsigned w) { return __builtin_bit_cast(float, w << 16); }
__device__ __forceinline__ float bfhi(unsigned w) { return __builtin_bit_cast(float, w & 0xffff0000u); }
__device__ __forceinline__ float bf2f(unsigned short u) { return __builtin_bit_cast(float, (unsigned)u << 16); }
__device__ __forceinline__ float wave_sum(float v) {
#pragma unroll
    for (int o = 1; o < 64; o <<= 1) v += __shfl_xor(v, o);
    return v;
}
__device__ __forceinline__ float wave_max(float v) {
#pragma unroll
    for (int o = 1; o < 64; o <<= 1) v = fmaxf(v, __shfl_xor(v, o));
    return v;
}
__device__ __forceinline__ int t5_bucket(int rel) {
    const int n = rel < 0 ? -rel : rel;
    const int b = n < 8 ? n : 8 + (n >= 15) + (n >= 27) + (n >= 50) + (n >= 91) + (n >= 166) + (n >= 305) + (n >= 559);
    return b + (rel > 0 ? 16 : 0);
}
#define XB_TMO      128
#define XB_XCNT(j)  (256  + 64 * (j))
#define XB_XSUB(j)  (1280 + 64 * (j))
#define XB_XGEN(j)  (2304 + 64 * (j))
#define XB_TOP      3328
#define XB_TOPGEN   3392
#define XCD_BAR_WORDS 3456
#define XB_SPIN_CAP (1u << 25)

__device__ __forceinline__ unsigned xb_ld(unsigned* p)              { return __hip_atomic_load(p, __ATOMIC_RELAXED, __HIP_MEMORY_SCOPE_AGENT); }
__device__ __forceinline__ unsigned xb_add(unsigned* p, unsigned v) { return __hip_atomic_fetch_add(p, v, __ATOMIC_RELAXED, __HIP_MEMORY_SCOPE_AGENT); }
__device__ __forceinline__ unsigned xb_xcc_id() { return (unsigned)__builtin_amdgcn_s_getreg((3 << 11) | 20) & 0xFu; }
#define XB_SPIN(cond, bar) do { unsigned _sp = 0; while (cond) { __builtin_amdgcn_s_sleep(1); \
    if ((++_sp & 255u) == 0u) { if (xb_ld(&(bar)[XB_TMO])) break; if (_sp > XB_SPIN_CAP) { atomicAdd(&(bar)[XB_TMO], 1u); break; } } } } while (0)

struct XcdBarrier {
    unsigned* bar; unsigned x;
    volatile LAS unsigned* st;
};

__device__ __forceinline__ XcdBarrier xcd_barrier_post(unsigned* bar, volatile LAS unsigned* st) {
    XcdBarrier b; b.bar = bar; b.x = xb_xcc_id(); b.st = st;
    if (threadIdx.x == 0) (void)xb_add(&bar[XB_XCNT(b.x)], 1u);
    return b;
}
__device__ __forceinline__ void xcd_barrier_complete(unsigned* bar, unsigned x, unsigned& nloc, unsigned& nx) {
    const unsigned G = gridDim.x * gridDim.y * gridDim.z;
    unsigned sum, cnt, mine, sp = 0u;
    for (;;) {
        sum = 0u; cnt = 0u; mine = 0u;
#pragma unroll
        for (unsigned j = 0; j < 16; ++j) { const unsigned c = xb_ld(&bar[XB_XCNT(j)]); sum += c; cnt += (c > 0u) ? 1u : 0u; mine = (j == x) ? c : mine; }
        if (sum == G) break;
        __builtin_amdgcn_s_sleep(1);
        if ((++sp & 255u) == 0u) { if (xb_ld(&bar[XB_TMO])) break; if (sp > XB_SPIN_CAP) { atomicAdd(&bar[XB_TMO], 1u); break; } }
    }
    nloc = mine > 0u ? mine : 1u; nx = cnt > 0u ? cnt : 1u;
}

__device__ __forceinline__ void xcd_barrier(const XcdBarrier& b) {
    asm volatile("s_waitcnt vmcnt(0)" ::: "memory");
    __syncthreads();
    if (threadIdx.x == 0) {
        unsigned* bar = b.bar;
        __builtin_amdgcn_s_waitcnt(0);
        unsigned nloc = b.st[0], nx = b.st[1];
        if (nloc == 0u) { xcd_barrier_complete(bar, b.x, nloc, nx); b.st[0] = nloc; b.st[1] = nx; }
        const unsigned old = xb_add(&bar[XB_XSUB(b.x)], 1u);
        const unsigned gen = old / nloc;
        if (old + 1u == (gen + 1u) * nloc) {
            __builtin_amdgcn_fence(__ATOMIC_RELEASE, "agent");
            asm volatile("s_waitcnt vmcnt(0)" ::: "memory");
            const unsigned og = xb_add(&bar[XB_TOP], 1u);
            const unsigned tg = og / nx;
            if (og + 1u == (tg + 1u) * nx) xb_add(&bar[XB_TOPGEN], 1u);
            else XB_SPIN(xb_ld(&bar[XB_TOPGEN]) == tg, bar);
            __builtin_amdgcn_fence(__ATOMIC_ACQUIRE, "agent");
            xb_add(&bar[XB_XGEN(b.x)], 1u);
            asm volatile("s_waitcnt vmcnt(0)" ::: "memory");
        } else {
            XB_SPIN(xb_ld(&bar[XB_XGEN(b.x)]) == gen, bar);
            __builtin_amdgcn_fence(__ATOMIC_ACQUIRE, "agent");
            asm volatile("s_waitcnt vmcnt(0)" ::: "memory");
        }
    }
    __syncthreads();
}

struct Frame {
    LAS unsigned char* lds;
    volatile LAS unsigned* MISC;
    gu32* ctl;
    int tid, lane, wave, vcu, G;
    const float* in[20];
    float* out;
    unsigned char* ws;
};
__device__ __forceinline__ bool refresh(Frame& F) { int t_ = threadIdx.x; asm volatile("" : "+v"(t_)); F.tid = t_; F.lane = t_ & 63; return true; }
enum { I_X = 0, I_MEM, I_TAB, I_NG, I_EWIN, I_EKVN, I_EUK, I_EUV, I_ELAM, I_ESUB, I_EWOUT, I_OWIN, I_OSINK, I_OWOUT, I_XWQ, I_XWKV, I_XWO, I_XMN, I_W1, I_W2 };

__device__ __forceinline__ void tr_item(const float* src, int spitch, int scol0, bf16* dst, int dpitch, int drow0, int dcol0, int nblk, LAS float* scr, int item, int lane) {
    const int kb = item / nblk, nb = item % nblk, k0 = 64 * kb, n0 = 32 * nb;
#pragma unroll 8
    for (int i = 0; i < 32; ++i) { const int kk = 2 * i + (lane >> 5); scr[kk * 33 + (lane & 31)] = ((const GAS float*)src)[(size_t)(k0 + kk) * spitch + scol0 + n0 + (lane & 31)]; }
    LDS_WAIT(); asm volatile("" ::: "memory");
    const int c = lane & 7;
#pragma unroll
    for (int j = 0; j < 4; ++j) { const int n = (lane >> 3) + 8 * j; const LAS float* s = scr + (8 * c) * 33 + n;
        v4u o; o.x = pk2(s[0 * 33], s[1 * 33]); o.y = pk2(s[2 * 33], s[3 * 33]); o.z = pk2(s[4 * 33], s[5 * 33]); o.w = pk2(s[6 * 33], s[7 * 33]);
        *(GAS v4u*)(dst + (size_t)(drow0 + n0 + n) * dpitch + dcol0 + k0 + 8 * c) = o; }
    LDS_WAIT(); asm volatile("" ::: "memory");
}
__device__ __forceinline__ void fuse_qlat_item(const float* win, const float* wuk, bf16* dst, int item, int lane) {
    const int h = item >> 6, k0 = (item & 63) * 16;
    float a0[16], a1[16];
#pragma unroll
    for (int k = 0; k < 16; ++k) { a0[k] = 0.f; a1[k] = 0.f; }
    for (int d = 0; d < 64; ++d) {
        const float u0 = ((const GAS float*)wuk)[(size_t)(h * 64 + d) * 128 + 2 * lane], u1 = ((const GAS float*)wuk)[(size_t)(h * 64 + d) * 128 + 2 * lane + 1];
#pragma unroll
        for (int k = 0; k < 16; ++k) { const float w = ((const GAS float*)win)[(size_t)(k0 + k) * EVC + h * 64 + d]; a0[k] += w * u0; a1[k] += w * u1; }
    }
    v4u o0, o1, p0, p1;
    o0.x = pk2(a0[0], a0[1]); o0.y = pk2(a0[2], a0[3]); o0.z = pk2(a0[4], a0[5]); o0.w = pk2(a0[6], a0[7]);
    o1.x = pk2(a0[8], a0[9]); o1.y = pk2(a0[10], a0[11]); o1.z = pk2(a0[12], a0[13]); o1.w = pk2(a0[14], a0[15]);
    p0.x = pk2(a1[0], a1[1]); p0.y = pk2(a1[2], a1[3]); p0.z = pk2(a1[4], a1[5]); p0.w = pk2(a1[6], a1[7]);
    p1.x = pk2(a1[8], a1[9]); p1.y = pk2(a1[10], a1[11]); p1.z = pk2(a1[12], a1[13]); p1.w = pk2(a1[14], a1[15]);
    GAS v4u* r0 = (GAS v4u*)(dst + (size_t)(h * 128 + 2 * lane) * 1024 + k0); GAS v4u* r1 = (GAS v4u*)(dst + (size_t)(h * 128 + 2 * lane + 1) * 1024 + k0);
    r0[0] = o0; r0[1] = o1; r1[0] = p0; r1[1] = p1;
}
__device__ __forceinline__ void fuse_ov_item(const float* wuv, const float* wout, bf16* dst, int item, int lane) {
    const int h = item >> 6, n0 = (item & 63) * 16;
    float a0[16], a1[16];
#pragma unroll
    for (int k = 0; k < 16; ++k) { a0[k] = 0.f; a1[k] = 0.f; }
    for (int d = 0; d < 64; ++d) {
        const float u0 = ((const GAS float*)wuv)[(size_t)(h * 128 + 2 * lane) * 64 + d], u1 = ((const GAS float*)wuv)[(size_t)(h * 128 + 2 * lane + 1) * 64 + d];
#pragma unroll
        for (int k = 0; k < 16; ++k) { const float w = ((const GAS float*)wout)[(size_t)(h * 64 + d) * 1024 + n0 + k]; a0[k] += w * u0; a1[k] += w * u1; }
    }
#pragma unroll
    for (int k = 0; k < 16; ++k) *(GAS unsigned*)(dst + (size_t)(n0 + k) * HCE + h * 128 + 2 * lane) = pk2(a0[k], a1[k]);
}
__device__ __forceinline__ void widx_item(const float* win, bf16* dst, int item, int lane) {
    const int k = item * 64 + lane;
    for (int n = 0; n < 64; ++n) { const float v = n < 8 ? ((const GAS float*)win)[(size_t)k * EVC + 1216 + n] : 0.f; ((GAS bf16*)dst)[(size_t)(ZWI + n) * 1024 + k] = (bf16)f2bf(v); }
}

__device__ __forceinline__ void convert_weights(Frame& F, int l) {
    LAS float* scr = (LAS float*)(F.lds + RING_OFF + F.wave * 16384);
    const int gw = F.vcu * NWAVES + F.wave, NGW = F.G * NWAVES;
    bf16* WIN = (bf16*)(F.ws + WS_WGT + WO_WIN); bf16* WOUT = (bf16*)(F.ws + WS_WGT + WO_WOUT); bf16* WQ = (bf16*)(F.ws + WS_WGT + WO_WQ); bf16* WKV = (bf16*)(F.ws + WS_WGT + WO_WKV);
    bf16* WO = (bf16*)(F.ws + WS_WGT + WO_WO); bf16* W1 = (bf16*)(F.ws + WS_WGT + WO_W1); bf16* W2 = (bf16*)(F.ws + WS_WGT + WO_W2);
    const float* wq = F.in[I_XWQ] + (size_t)l * 1024 * 256; const float* wkv = F.in[I_XWKV] + (size_t)l * 1024 * 512; const float* wo = F.in[I_XWO] + (size_t)l * 256 * 1024;
    const float* w1 = F.in[I_W1] + (size_t)l * 1024 * 4096; const float* w2 = F.in[I_W2] + (size_t)l * 4096 * 1024;
    constexpr int N_Q = 16 * 8, N_KV = 16 * 16, N_O = 4 * 32, N_1 = 16 * 128, N_2 = 64 * 32;
    if ((l & 1) == 0) {
        const int e = l >> 1;
        const float* win = F.in[I_EWIN] + (size_t)e * 1024 * EVC; const float* wout = F.in[I_EWOUT] + (size_t)e * 1024 * 1024;
        const float* wuk = F.in[I_EUK] + (size_t)e * 8 * 64 * 128; const float* wuv = F.in[I_EUV] + (size_t)e * 8 * 128 * 64;
        constexpr int A0 = 512, A1 = 16 * 4, A2 = 16 * 16, A3 = 16 * 2, A4 = 16 * 48, A5 = 16, A6 = 512, A7 = 8 * 32;
        constexpr int TOT = A0 + A1 + A2 + A3 + A4 + A5 + A6 + A7 + N_Q + N_KV + N_O + N_1 + N_2;
        for (int it = gw; it < TOT; it += NGW) {
            int r = it;
            if (r < A0) { fuse_qlat_item(win, wuk, WIN, r, F.lane); continue; } r -= A0;
            if (r < A1) { tr_item(win, EVC, 512, WIN, 1024, ZCKV, 0, 4, scr, r, F.lane); continue; } r -= A1;
            if (r < A2) { tr_item(win, EVC, 640, WIN, 1024, ZQI, 0, 16, scr, r, F.lane); continue; } r -= A2;
            if (r < A3) { tr_item(win, EVC, 1152, WIN, 1024, ZKI, 0, 2, scr, r, F.lane); continue; } r -= A3;
            if (r < A4) { tr_item(win, EVC, 1224, WIN, 1024, ZQB, 0, 48, scr, r, F.lane); continue; } r -= A4;
            if (r < A5) { widx_item(win, WIN, r, F.lane); continue; } r -= A5;
            if (r < A6) { fuse_ov_item(wuv, wout, WOUT, r, F.lane); continue; } r -= A6;
            if (r < A7) { tr_item(wout + (size_t)512 * 1024, 1024, 0, WOUT, HCE, 0, 1024, 32, scr, r, F.lane); continue; } r -= A7;
            if (r < N_Q) { tr_item(wq, 256, 0, WQ, 1024, 0, 0, 8, scr, r, F.lane); continue; } r -= N_Q;
            if (r < N_KV) { tr_item(wkv, 512, 0, WKV, 1024, 0, 0, 16, scr, r, F.lane); continue; } r -= N_KV;
            if (r < N_O) { tr_item(wo, 1024, 0, WO, 256, 0, 0, 32, scr, r, F.lane); continue; } r -= N_O;
            if (r < N_1) { tr_item(w1, 4096, 0, W1, 1024, 0, 0, 128, scr, r, F.lane); continue; } r -= N_1;
            tr_item(w2, 1024, 0, W2, 4096, 0, 0, 32, scr, r, F.lane);
        }
    } else {
        const int o = l >> 1;
        const float* win = F.in[I_OWIN] + (size_t)o * 1024 * ZO; const float* wout = F.in[I_OWOUT] + (size_t)o * 1024 * 1024;
        constexpr int B0 = 16 * 40, B1 = 16 * 32;
        constexpr int TOT = B0 + B1 + N_Q + N_KV + N_O + N_1 + N_2;
        for (int it = gw; it < TOT; it += NGW) {
            int r = it;
            if (r < B0) { tr_item(win, ZO, 0, WIN, 1024, 0, 0, 40, scr, r, F.lane); continue; } r -= B0;
            if (r < B1) { tr_item(wout, 1024, 0, WOUT, 1024, 0, 0, 32, scr, r, F.lane); continue; } r -= B1;
            if (r < N_Q) { tr_item(wq, 256, 0, WQ, 1024, 0, 0, 8, scr, r, F.lane); continue; } r -= N_Q;
            if (r < N_KV) { tr_item(wkv, 512, 0, WKV, 1024, 0, 0, 16, scr, r, F.lane); continue; } r -= N_KV;
            if (r < N_O) { tr_item(wo, 1024, 0, WO, 256, 0, 0, 32, scr, r, F.lane); continue; } r -= N_O;
            if (r < N_1) { tr_item(w1, 4096, 0, W1, 1024, 0, 0, 128, scr, r, F.lane); continue; } r -= N_1;
            tr_item(w2, 1024, 0, W2, 4096, 0, 0, 32, scr, r, F.lane);
        }
    }
}

__device__ __forceinline__ void row_first(int lane, const float* xin, float* xout, const float* g, bf16* h) {
    const GAS f32x4* xr = (const GAS f32x4*)xin + lane; f32x4 v[4]; float ss = 0.f;
#pragma unroll
    for (int j = 0; j < 4; ++j) { v[j] = xr[64 * j]; ss += (v[j].x * v[j].x + v[j].y * v[j].y) + (v[j].z * v[j].z + v[j].w * v[j].w); }
    const float r = 1.f / sqrtf(wave_sum(ss) * (1.f / 1024.f) + EPS);
    const GAS f32x4* gr = (const GAS f32x4*)g + lane; GAS v2u* ho = (GAS v2u*)h + lane;
#pragma unroll
    for (int j = 0; j < 4; ++j) {
        if (xout) ((GAS f32x4*)xout + lane)[64 * j] = v[j];
        const f32x4 gg = gr[64 * j]; v2u o; o.x = pk2(v[j].x * r * gg.x, v[j].y * r * gg.y); o.y = pk2(v[j].z * r * gg.z, v[j].w * r * gg.w); ho[64 * j] = o; }
}
__device__ __forceinline__ void row_mid(int lane, const bf16* y, float* x, const float* ga, const float* gb, bf16* h) {
    const GAS v2u* yr = (const GAS v2u*)y + lane; GAS f32x4* xr = (GAS f32x4*)x + lane; f32x4 yv[4], xv[4]; float ss = 0.f;
#pragma unroll
    for (int j = 0; j < 4; ++j) { const v2u w = yr[64 * j]; yv[j] = (f32x4){bflo(w.x), bfhi(w.x), bflo(w.y), bfhi(w.y)}; xv[j] = xr[64 * j];
        ss += (yv[j].x * yv[j].x + yv[j].y * yv[j].y) + (yv[j].z * yv[j].z + yv[j].w * yv[j].w); }
    const float r1 = 1.f / sqrtf(wave_sum(ss) * (1.f / 1024.f) + EPS);
    const GAS f32x4* gar = (const GAS f32x4*)ga + lane; float s2 = 0.f;
#pragma unroll
    for (int j = 0; j < 4; ++j) { const f32x4 gg = gar[64 * j]; xv[j].x += yv[j].x * r1 * gg.x; xv[j].y += yv[j].y * r1 * gg.y; xv[j].z += yv[j].z * r1 * gg.z; xv[j].w += yv[j].w * r1 * gg.w;
        xr[64 * j] = xv[j]; s2 += (xv[j].x * xv[j].x + xv[j].y * xv[j].y) + (xv[j].z * xv[j].z + xv[j].w * xv[j].w); }
    if (gb) {
        const float r2 = 1.f / sqrtf(wave_sum(s2) * (1.f / 1024.f) + EPS);
        const GAS f32x4* gbr = (const GAS f32x4*)gb + lane; GAS v2u* ho = (GAS v2u*)h + lane;
#pragma unroll
        for (int j = 0; j < 4; ++j) { const f32x4 gg = gbr[64 * j]; v2u o; o.x = pk2(xv[j].x * r2 * gg.x, xv[j].y * r2 * gg.y); o.y = pk2(xv[j].z * r2 * gg.z, xv[j].w * r2 * gg.w); ho[64 * j] = o; }
    }
}
__device__ __forceinline__ void thin_first(Frame& F, const float* g) {
    const int gw = F.vcu * NWAVES + F.wave, NGW = F.G * NWAVES; bf16* h = (bf16*)(F.ws + WS_HC);
    for (int m = gw; m < M; m += NGW) row_first(F.lane, F.in[I_X] + (size_t)m * D, F.out + (size_t)m * D, g, h + (size_t)m * D);
}
__device__ __forceinline__ void thin_mid(Frame& F, const float* ga, const float* gb) {
    const int gw = F.vcu * NWAVES + F.wave, NGW = F.G * NWAVES; bf16* h = (bf16*)(F.ws + WS_HC); const bf16* y = (const bf16*)(F.ws + WS_Y);
    for (int m = gw; m < M; m += NGW) row_mid(F.lane, y + (size_t)m * D, F.out + (size_t)m * D, ga, gb, h + (size_t)m * D);
}
__device__ __forceinline__ void thin_memn(Frame& F, const float* g) {
    const int gw = F.vcu * NWAVES + F.wave, NGW = F.G * NWAVES; bf16* mn = (bf16*)(F.ws + WS_MEMN);
    for (int m = NGW - 1 - gw; m < NB * NMEM; m += NGW) row_first(F.lane, F.in[I_MEM] + (size_t)m * D, nullptr, g, mn + (size_t)m * D);
}
__device__ __forceinline__ void thin_ckvn(Frame& F, const float* akvn) {
    const int gw = F.vcu * NWAVES + F.wave, NGW = F.G * NWAVES; const bf16* z = (const bf16*)(F.ws + WS_Z); bf16* ck = (bf16*)(F.ws + WS_CKVN);
    const float g0 = ((const GAS float*)akvn)[2 * F.lane], g1 = ((const GAS float*)akvn)[2 * F.lane + 1];
    for (int m = gw; m < M; m += NGW) {
        const unsigned w = *((const GAS unsigned*)(z + (size_t)m * ZE + ZCKV) + F.lane); const float a = bflo(w), b = bfhi(w);
        const float r = 1.f / sqrtf(wave_sum(a * a + b * b) * (1.f / 128.f) + EPS);
        *((GAS unsigned*)(ck + (size_t)m * 128) + F.lane) = pk2(a * r * g0, b * r * g1);
    }
}

#define UNPK8(dst, off, VV) do { dst[(off) + 0] = bflo((VV).x); dst[(off) + 1] = bfhi((VV).x); dst[(off) + 2] = bflo((VV).y); dst[(off) + 3] = bfhi((VV).y); \
    dst[(off) + 4] = bflo((VV).z); dst[(off) + 5] = bfhi((VV).z); dst[(off) + 6] = bflo((VV).w); dst[(off) + 7] = bfhi((VV).w); } while (0)
#define DOT8(q, off, VV) ((q[(off) + 0] * bflo((VV).x) + q[(off) + 1] * bfhi((VV).x)) + (q[(off) + 2] * bflo((VV).y) + q[(off) + 3] * bfhi((VV).y)) + \
    (q[(off) + 4] * bflo((VV).z) + q[(off) + 5] * bfhi((VV).z)) + (q[(off) + 6] * bflo((VV).w) + q[(off) + 7] * bfhi((VV).w)))
#define AXPY8(acc, off, al, p, VV) do { acc[(off) + 0] = acc[(off) + 0] * (al) + (p) * bflo((VV).x); acc[(off) + 1] = acc[(off) + 1] * (al) + (p) * bfhi((VV).x); \
    acc[(off) + 2] = acc[(off) + 2] * (al) + (p) * bflo((VV).y); acc[(off) + 3] = acc[(off) + 3] * (al) + (p) * bfhi((VV).y); \
    acc[(off) + 4] = acc[(off) + 4] * (al) + (p) * bflo((VV).z); acc[(off) + 5] = acc[(off) + 5] * (al) + (p) * bfhi((VV).z); \
    acc[(off) + 6] = acc[(off) + 6] * (al) + (p) * bflo((VV).w); acc[(off) + 7] = acc[(off) + 7] * (al) + (p) * bfhi((VV).w); } while (0)

__device__ __forceinline__ void xattn_naive(Frame& F) {
    LAS v4u* Ks = (LAS v4u*)(F.lds); LAS v4u* Vs = (LAS v4u*)(F.lds + 32768);
    const bf16* kvm = (const bf16*)(F.ws + WS_KVM); const bf16* qx = (const bf16*)(F.ws + WS_QX); bf16* ox = (bf16*)(F.ws + WS_OX);
    for (int u = F.vcu; u < 256; u += F.G) {
        const int b = u >> 6, h = (u >> 4) & 3, blk = u & 15;
        __syncthreads();
        for (int i = F.tid; i < 2048; i += 512) { const int key = i >> 3, c = i & 7;
            const GAS v4u* src = (const GAS v4u*)(kvm + (size_t)(b * NMEM + key) * 512 + h * 64) + c; Ks[i] = src[0]; Vs[i] = src[32]; }
        __syncthreads();
        const size_t token = (size_t)b * SEQ + blk * 512 + F.tid;
        float q[64], acc[64];
        { const GAS v4u* qp = (const GAS v4u*)(qx + token * 256 + h * 64);
#pragma unroll
          for (int c = 0; c < 8; ++c) { const v4u w = qp[c]; UNPK8(q, 8 * c, w); } }
#pragma unroll
        for (int d = 0; d < 64; ++d) acc[d] = 0.f;
        float m = -1e30f, l = 0.f;
        for (int key = 0; key < NMEM; ++key) {
            float s = 0.f;
#pragma unroll
            for (int c = 0; c < 8; ++c) { const v4u w = Ks[key * 8 + c]; s += DOT8(q, 8 * c, w); }
            s *= 0.125f;
            const float mn = fmaxf(m, s), al = __expf(m - mn), p = __expf(s - mn); l = l * al + p; m = mn;
#pragma unroll
            for (int c = 0; c < 8; ++c) { const v4u w = Vs[key * 8 + c]; AXPY8(acc, 8 * c, al, p, w); }
        }
        const float inv = 1.f / l;
        GAS v4u* op = (GAS v4u*)(ox + token * 256 + h * 64);
#pragma unroll
        for (int c = 0; c < 8; ++c) { v4u o; o.x = pk2(acc[8 * c] * inv, acc[8 * c + 1] * inv); o.y = pk2(acc[8 * c + 2] * inv, acc[8 * c + 3] * inv);
            o.z = pk2(acc[8 * c + 4] * inv, acc[8 * c + 5] * inv); o.w = pk2(acc[8 * c + 6] * inv, acc[8 * c + 7] * inv); op[c] = o; }
    }
}

__device__ __forceinline__ void swa_naive(Frame& F, int o) {
    LAS v4u* Ks = (LAS v4u*)(F.lds); LAS v4u* Vs = (LAS v4u*)(F.lds + 24576); LAS float* lut = (LAS float*)(F.lds + 49152);
    const bf16* z = (const bf16*)(F.ws + WS_Z); bf16* hc = (bf16*)(F.ws + WS_HC);
    const float* tab = F.in[I_TAB]; const float* sinks = F.in[I_OSINK] + o * 16;
    for (int u = F.vcu; u < NB * 128 * 2; u += F.G) {
        const int b = u >> 8, c = (u >> 1) & 127, kvh = u & 1;
        __syncthreads();
        const int jmin = c >= 2 ? 0 : (2 - c) * 64;
        for (int i = F.tid; i < 192 * 8; i += 512) { const int j = i >> 3, cc = i & 7;
            if (j >= jmin) { const size_t kt = (size_t)b * SEQ + (c - 2) * 64 + j;
                Ks[i] = *((const GAS v4u*)(z + kt * ZO + OKK + kvh * 64) + cc); Vs[i] = *((const GAS v4u*)(z + kt * ZO + OVV + kvh * 64) + cc); } }
        for (int i = F.tid; i < 8 * 256; i += 512) { const int g = i >> 8, r = i & 255; lut[i] = r < 255 ? ((const GAS float*)tab)[t5_bucket(r - 191) * 28 + 12 + kvh * 8 + g] : 0.f; }
        __syncthreads();
        const int g = F.wave, head = kvh * 8 + g, qi = F.lane;
        const size_t token = (size_t)b * SEQ + c * 64 + qi;
        float q[64], acc[64];
        { const GAS v4u* qp = (const GAS v4u*)(z + token * ZO + OQ + head * 64);
#pragma unroll
          for (int cc = 0; cc < 8; ++cc) { const v4u w = qp[cc]; UNPK8(q, 8 * cc, w); } }
#pragma unroll
        for (int d = 0; d < 64; ++d) acc[d] = 0.f;
        float m = ((const GAS float*)sinks)[head], l = 1.f;
        for (int j = jmin; j < 192; ++j) {
            float s = 0.f;
#pragma unroll
            for (int cc = 0; cc < 8; ++cc) { const v4u w = Ks[j * 8 + cc]; s += DOT8(q, 8 * cc, w); }
            s = s * 0.125f + lut[g * 256 + j + 63 - qi];
            const float mn = fmaxf(m, s), al = __expf(m - mn), p = __expf(s - mn); l = l * al + p; m = mn;
#pragma unroll
            for (int cc = 0; cc < 8; ++cc) { const v4u w = Vs[j * 8 + cc]; AXPY8(acc, 8 * cc, al, p, w); }
        }
        const float inv = 1.f / l;
        GAS v4u* op = (GAS v4u*)(hc + token * HCO + head * 64);
#pragma unroll
        for (int cc = 0; cc < 8; ++cc) { v4u ov; ov.x = pk2(acc[8 * cc] * inv, acc[8 * cc + 1] * inv); ov.y = pk2(acc[8 * cc + 2] * inv, acc[8 * cc + 3] * inv);
            ov.z = pk2(acc[8 * cc + 4] * inv, acc[8 * cc + 5] * inv); ov.w = pk2(acc[8 * cc + 6] * inv, acc[8 * cc + 7] * inv); op[cc] = ov; }
    }
}

constexpr int DLUT = 832, DLUT_OFF = 767;
__device__ __forceinline__ void diff_naive(Frame& F, int e, float lam_init) {
    LAS v4u* Ks = (LAS v4u*)(F.lds); LAS v4u* Vs = (LAS v4u*)(F.lds + 16384); LAS float* lut = (LAS float*)(F.lds + 32768); LAS float* xb = (LAS float*)(F.lds + 36864);
    LAS float* xs = (LAS float*)(F.lds + 36864 + 256 * 65 * 4);
    const bf16* z = (const bf16*)(F.ws + WS_Z); bf16* hc = (bf16*)(F.ws + WS_HC);
    const float* tab = F.in[I_TAB]; const float* lamv = F.in[I_ELAM] + e * 256; const float* subln = F.in[I_ESUB] + e * 128;
    float lam;
    { const float a = ((const GAS float*)lamv)[F.lane] * ((const GAS float*)lamv)[64 + F.lane], b2 = ((const GAS float*)lamv)[128 + F.lane] * ((const GAS float*)lamv)[192 + F.lane];
      lam = __expf(wave_sum(a)) - __expf(wave_sum(b2)) + lam_init; }
    for (int u = F.vcu; u < NB * 4 * 64; u += F.G) {
        const int b = u >> 8, h = (u >> 6) & 3, qb = u & 63;
        const int mm = F.tid >> 8, half = (F.tid >> 7) & 1, qi = F.tid & 127, t = qb * 128 + qi, ct = t >> 6;
        const size_t token = (size_t)b * SEQ + t;
        __syncthreads();
        for (int i = F.tid; i < DLUT; i += 512) lut[i] = ((const GAS float*)tab)[t5_bucket(i - DLUT_OFF) * 28 + 8 + h];
        float acc[64]; v4u qpk[8];
        { const GAS v4u* qp = (const GAS v4u*)(z + token * ZE + ZQB + h * 128 + mm * 64);
#pragma unroll
          for (int c = 0; c < 8; ++c) qpk[c] = qp[c]; }
#pragma unroll
        for (int d = 0; d < 64; ++d) acc[d] = 0.f;
        float m = -1e30f, l = 0.f;
        const int ntile = 2 * qb + 2;
        for (int tile = 0; tile < ntile; ++tile) {
            __syncthreads();
            for (int i = F.tid; i < 1024; i += 512) { const int key = i >> 4, c = i & 15; const size_t kt = (size_t)b * SEQ + tile * 64 + key;
                Ks[i] = *((const GAS v4u*)(z + kt * ZE + ZKB + h * 128) + c); Vs[i] = *((const GAS v4u*)(z + kt * ZE + ZVB + h * 128) + c); }
            __syncthreads();
            if (tile <= ct) {
                for (int key = 0; key < 64; ++key) {
                    float s = 0.f;
#pragma unroll
                    for (int c = 0; c < 8; ++c) { const v4u w = Ks[key * 16 + mm * 8 + c]; float qq[8]; UNPK8(qq, 0, qpk[c]); s += DOT8(qq, 0, w); }
                    int rel = tile * 64 + key - t; rel = rel < -DLUT_OFF ? -DLUT_OFF : rel;
                    s = s * 0.125f + lut[rel + DLUT_OFF];
                    const float mn = fmaxf(m, s), al = __expf(m - mn), p = __expf(s - mn); l = l * al + p; m = mn;
#pragma unroll
                    for (int c = 0; c < 8; ++c) { const v4u w = Vs[key * 16 + half * 8 + c]; AXPY8(acc, 8 * c, al, p, w); }
                }
            }
        }
        const float inv = 1.f / l;
#pragma unroll
        for (int d = 0; d < 64; ++d) acc[d] *= inv;
        __syncthreads();
        if (mm == 1) {
#pragma unroll
            for (int d = 0; d < 64; ++d) xb[(half * 128 + qi) * 65 + d] = acc[d]; }
        __syncthreads();
        float ss = 0.f;
        if (mm == 0) {
#pragma unroll
            for (int d = 0; d < 64; ++d) { acc[d] -= lam * xb[(half * 128 + qi) * 65 + d]; ss += acc[d] * acc[d]; }
            xs[half * 128 + qi] = ss; }
        __syncthreads();
        if (mm == 0) {
            ss += xs[(half ^ 1) * 128 + qi];
            const float rr = (1.f / sqrtf(ss * (1.f / 128.f) + EPS)) * (1.f - lam_init);
            GAS v4u* op = (GAS v4u*)(hc + token * HCE + 1024 + h * 128 + half * 64);
#pragma unroll
            for (int c = 0; c < 8; ++c) { const GAS f32x4* sg = (const GAS f32x4*)(subln + half * 64 + 8 * c); const f32x4 g0 = sg[0], g1 = sg[1]; v4u ov;
                ov.x = pk2(acc[8 * c] * rr * g0.x, acc[8 * c + 1] * rr * g0.y); ov.y = pk2(acc[8 * c + 2] * rr * g0.z, acc[8 * c + 3] * rr * g0.w);
                ov.z = pk2(acc[8 * c + 4] * rr * g1.x, acc[8 * c + 5] * rr * g1.y); ov.w = pk2(acc[8 * c + 6] * rr * g1.z, acc[8 * c + 7] * rr * g1.w); op[c] = ov; }
        }
    }
}

typedef short bf16x8_t __attribute__((ext_vector_type(8)));
typedef float f32x16 __attribute__((ext_vector_type(16)));
typedef short v4i16_t __attribute__((ext_vector_type(4)));
constexpr int DK_STR = 272, DV_STR = 320, DSTG = 64 * DK_STR + 64 * DV_STR, D_LUTOFF = 2 * DSTG;
static_assert(D_LUTOFF + DLUT * 4 <= RING_BYTES, "diff LDS map");
__device__ __forceinline__ unsigned cvtpk(float lo, float hi) { unsigned r; asm("v_cvt_pk_bf16_f32 %0, %1, %2" : "=v"(r) : "v"(lo), "v"(hi)); return r; }
__device__ __forceinline__ bf16x8_t vtr8(const LAS unsigned char* p0, const LAS unsigned char* p1) {
    const v4i16_t a = __builtin_amdgcn_ds_read_tr16_b64_v4i16((LAS v4i16_t*)p0), b = __builtin_amdgcn_ds_read_tr16_b64_v4i16((LAS v4i16_t*)p1);
    return (bf16x8_t){a[0], a[1], a[2], a[3], b[0], b[1], b[2], b[3]};
}
__device__ __forceinline__ void diff_mfma(Frame& F, int e, float lam_init) {
    LAS unsigned char* L = F.lds; LAS float* lut = (LAS float*)(L + D_LUTOFF); LAS float* xbuf = (LAS float*)L;
    const bf16* z = (const bf16*)(F.ws + WS_Z); bf16* hc = (bf16*)(F.ws + WS_HC);
    const float* tab = F.in[I_TAB]; const float* lamv = F.in[I_ELAM] + e * 256; const float* subln = F.in[I_ESUB] + e * 128;
    const int w = F.wave, lane = F.lane, r32 = lane & 31, hi = lane >> 5, mm = w >> 2, wq = w & 3;
    float lam;
    { const float a = ((const GAS float*)lamv)[lane] * ((const GAS float*)lamv)[64 + lane], b2 = ((const GAS float*)lamv)[128 + lane] * ((const GAS float*)lamv)[192 + lane];
      lam = __expf(wave_sum(a)) - __expf(wave_sum(b2)) + lam_init; }
    constexpr float C2 = 0.125f * LOG2E;
    const int bh = F.vcu >> 4, su = F.vcu & 15, b = bh >> 2, h = bh & 3;
#pragma unroll 1
    for (int rr = 0; rr < 4; ++rr) {
        const int qb = rr == 0 ? su : rr == 1 ? 31 - su : rr == 2 ? 32 + su : 63 - su;
        const int q0 = qb * 128 + wq * 32, cw = q0 >> 6, NT = 2 * qb + 2, tq = q0 + r32;
        __syncthreads();
        for (int i = F.tid; i < DLUT; i += 512) lut[i] = ((const GAS float*)tab)[t5_bucket(i - DLUT_OFF) * 28 + 8 + h] * LOG2E;
        bf16x8_t qf[4];
        { const bf16* qrow = z + ((size_t)b * SEQ + tq) * ZE + ZQB + h * 128 + mm * 64 + 8 * hi;
#pragma unroll
          for (int ks = 0; ks < 4; ++ks) qf[ks] = *(const GAS bf16x8_t*)(qrow + 16 * ks); }
        const int k0i = F.tid >> 4, c0 = F.tid & 15;
        const bf16* ksrc = z + ((size_t)b * SEQ + k0i) * ZE + ZKB + h * 128 + c0 * 8;
        const bf16* vsrc = z + ((size_t)b * SEQ + k0i) * ZE + ZVB + h * 128 + c0 * 8;
        const int kdst = k0i * DK_STR + c0 * 16, vdst = 64 * DK_STR + k0i * DV_STR + c0 * 16;
        v4u pk0, pk1, pv0, pv1;
        pk0 = *(const GAS v4u*)(ksrc); pk1 = *(const GAS v4u*)(ksrc + (size_t)32 * ZE); pv0 = *(const GAS v4u*)(vsrc); pv1 = *(const GAS v4u*)(vsrc + (size_t)32 * ZE);
        *(LAS v4u*)(L + kdst) = pk0; *(LAS v4u*)(L + kdst + 32 * DK_STR) = pk1; *(LAS v4u*)(L + vdst) = pv0; *(LAS v4u*)(L + vdst + 32 * DV_STR) = pv1;
        __syncthreads();
        f32x16 o[4];
#pragma unroll
        for (int i = 0; i < 4; ++i)
#pragma unroll
            for (int r = 0; r < 16; ++r) o[i][r] = 0.f;
        float m_run = -1e30f, l_run = 0.f;
        const int ka = r32 * DK_STR + (mm * 64 + 8 * hi) * 2;
        const int va = (4 * hi + ((lane & 15) >> 2)) * DV_STR + (16 * ((lane >> 4) & 1) + 4 * (lane & 3)) * 2;
#pragma unroll 1
        for (int t = 0; t < NT; ++t) {
            const int stg = (t & 1) * DSTG;
            if (t + 1 < NT) { const size_t off = (size_t)(t + 1) * 64 * ZE;
                pk0 = *(const GAS v4u*)(ksrc + off); pk1 = *(const GAS v4u*)(ksrc + off + (size_t)32 * ZE); pv0 = *(const GAS v4u*)(vsrc + off); pv1 = *(const GAS v4u*)(vsrc + off + (size_t)32 * ZE); }
            if (t <= cw) {
                const LAS unsigned char* Kb = L + stg + ka; const LAS unsigned char* Vb = L + stg + 64 * DK_STR + va;
                f32x16 s0, s1;
#pragma unroll
                for (int r = 0; r < 16; ++r) { s0[r] = 0.f; s1[r] = 0.f; }
#pragma unroll
                for (int ks = 0; ks < 4; ++ks) { const bf16x8_t a0 = *(const LAS bf16x8_t*)(Kb + ks * 32), a1 = *(const LAS bf16x8_t*)(Kb + 32 * DK_STR + ks * 32);
                    s0 = __builtin_amdgcn_mfma_f32_32x32x16_bf16(a0, qf[ks], s0, 0, 0, 0); s1 = __builtin_amdgcn_mfma_f32_32x32x16_bf16(a1, qf[ks], s1, 0, 0, 0); }
                if (64 * t + 622 > q0) {
                    const LAS float* lp = lut + (64 * t - tq + DLUT_OFF + 4 * hi);
#pragma unroll
                    for (int r = 0; r < 16; ++r) { const int ko = (r & 3) + 8 * (r >> 2); s0[r] = s0[r] * C2 + lp[ko]; s1[r] = s1[r] * C2 + lp[ko + 32]; }
                } else { const float bf = lut[0];
#pragma unroll
                    for (int r = 0; r < 16; ++r) { s0[r] = s0[r] * C2 + bf; s1[r] = s1[r] * C2 + bf; } }
                float mx = fmaxf(s0[0], s1[0]);
#pragma unroll
                for (int r = 1; r < 16; ++r) mx = fmaxf(mx, fmaxf(s0[r], s1[r]));
                mx = fmaxf(mx, __shfl_xor(mx, 32));
                if (__any(mx > m_run)) { const float mn = fmaxf(m_run, mx), al = __builtin_amdgcn_exp2f(m_run - mn); m_run = mn; l_run *= al;
#pragma unroll
                    for (int i = 0; i < 4; ++i)
#pragma unroll
                        for (int r = 0; r < 16; ++r) o[i][r] *= al; }
                float ps = 0.f;
#pragma unroll
                for (int r = 0; r < 16; ++r) { s0[r] = __builtin_amdgcn_exp2f(s0[r] - m_run); s1[r] = __builtin_amdgcn_exp2f(s1[r] - m_run); ps += s0[r] + s1[r]; }
                l_run += ps;
                bf16x8_t pf[4];
#pragma unroll
                for (int k2 = 0; k2 < 2; ++k2) {
                    v4u a; a.x = cvtpk(s0[8 * k2], s0[8 * k2 + 1]); a.y = cvtpk(s0[8 * k2 + 2], s0[8 * k2 + 3]); a.z = cvtpk(s0[8 * k2 + 4], s0[8 * k2 + 5]); a.w = cvtpk(s0[8 * k2 + 6], s0[8 * k2 + 7]);
                    v4u c; c.x = cvtpk(s1[8 * k2], s1[8 * k2 + 1]); c.y = cvtpk(s1[8 * k2 + 2], s1[8 * k2 + 3]); c.z = cvtpk(s1[8 * k2 + 4], s1[8 * k2 + 5]); c.w = cvtpk(s1[8 * k2 + 6], s1[8 * k2 + 7]);
                    pf[k2] = __builtin_bit_cast(bf16x8_t, a); pf[2 + k2] = __builtin_bit_cast(bf16x8_t, c); }
#pragma unroll
                for (int blk = 0; blk < 4; ++blk)
#pragma unroll
                    for (int kk = 0; kk < 4; ++kk) {
                        const LAS unsigned char* vp = Vb + kk * 16 * DV_STR + blk * 64;
                        const bf16x8_t vf = vtr8(vp, vp + 8 * DV_STR);
                        o[blk] = __builtin_amdgcn_mfma_f32_32x32x16_bf16(vf, pf[kk], o[blk], 0, 0, 0); }
            }
            if (t + 1 < NT) { const int s2 = ((t + 1) & 1) * DSTG;
                *(LAS v4u*)(L + s2 + kdst) = pk0; *(LAS v4u*)(L + s2 + kdst + 32 * DK_STR) = pk1; *(LAS v4u*)(L + s2 + vdst) = pv0; *(LAS v4u*)(L + s2 + vdst + 32 * DV_STR) = pv1; }
            __syncthreads();
        }
        const float linv = 1.f / (l_run + __shfl_xor(l_run, 32));
        if (mm == 1) {
#pragma unroll
            for (int blk = 0; blk < 4; ++blk)
#pragma unroll
                for (int r = 0; r < 16; ++r) xbuf[(wq * 64 + blk * 16 + r) * 64 + lane] = o[blk][r] * linv; }
        __syncthreads();
        if (mm == 0) {
            float ss = 0.f;
#pragma unroll
            for (int blk = 0; blk < 4; ++blk)
#pragma unroll
                for (int r = 0; r < 16; ++r) { const float d = o[blk][r] * linv - lam * xbuf[(wq * 64 + blk * 16 + r) * 64 + lane]; o[blk][r] = d; ss += d * d; }
            ss += __shfl_xor(ss, 32);
            const float rn = (1.f / sqrtf(ss * (1.f / 128.f) + EPS)) * (1.f - lam_init);
            bf16* orow = hc + ((size_t)b * SEQ + tq) * HCE + 1024 + h * 128 + 4 * hi;
#pragma unroll
            for (int blk = 0; blk < 4; ++blk)
#pragma unroll
                for (int a = 0; a < 4; ++a) { const f32x4 g = *(const GAS f32x4*)(subln + 32 * blk + 8 * a + 4 * hi); v2u ov;
                    ov.x = pk2(o[blk][4 * a] * rn * g.x, o[blk][4 * a + 1] * rn * g.y); ov.y = pk2(o[blk][4 * a + 2] * rn * g.z, o[blk][4 * a + 3] * rn * g.w);
                    *(GAS v2u*)(orow + 32 * blk + 8 * a) = ov; }
        }
    }
}

template <int NBLK, int KSTR, int VSTR, bool BIAS>
__device__ __forceinline__ void attn_step64(const LAS unsigned char* Kb, const LAS unsigned char* Vb, const bf16x8_t (&qf)[4], const LAS float* lp, f32x16 (&o)[NBLK], float& m_run, float& l_run) {
    constexpr float C2 = 0.125f * LOG2E;
    f32x16 s0, s1;
#pragma unroll
    for (int r = 0; r < 16; ++r) { s0[r] = 0.f; s1[r] = 0.f; }
#pragma unroll
    for (int ks = 0; ks < 4; ++ks) { const bf16x8_t a0 = *(const LAS bf16x8_t*)(Kb + ks * 32), a1 = *(const LAS bf16x8_t*)(Kb + 32 * KSTR + ks * 32);
        s0 = __builtin_amdgcn_mfma_f32_32x32x16_bf16(a0, qf[ks], s0, 0, 0, 0); s1 = __builtin_amdgcn_mfma_f32_32x32x16_bf16(a1, qf[ks], s1, 0, 0, 0); }
    if (BIAS) {
#pragma unroll
        for (int r = 0; r < 16; ++r) { const int ko = (r & 3) + 8 * (r >> 2); s0[r] = s0[r] * C2 + lp[ko]; s1[r] = s1[r] * C2 + lp[ko + 32]; }
    } else {
#pragma unroll
        for (int r = 0; r < 16; ++r) { s0[r] *= C2; s1[r] *= C2; } }
    float mx = fmaxf(s0[0], s1[0]);
#pragma unroll
    for (int r = 1; r < 16; ++r) mx = fmaxf(mx, fmaxf(s0[r], s1[r]));
    mx = fmaxf(mx, __shfl_xor(mx, 32));
    if (__any(mx > m_run)) { const float mn = fmaxf(m_run, mx), al = __builtin_amdgcn_exp2f(m_run - mn); m_run = mn; l_run *= al;
#pragma unroll
        for (int i = 0; i < NBLK; ++i)
#pragma unroll
            for (int r = 0; r < 16; ++r) o[i][r] *= al; }
    float ps = 0.f;
#pragma unroll
    for (int r = 0; r < 16; ++r) { s0[r] = __builtin_amdgcn_exp2f(s0[r] - m_run); s1[r] = __builtin_amdgcn_exp2f(s1[r] - m_run); ps += s0[r] + s1[r]; }
    l_run += ps;
    bf16x8_t pf[4];
#pragma unroll
    for (int k2 = 0; k2 < 2; ++k2) {
        v4u a; a.x = cvtpk(s0[8 * k2], s0[8 * k2 + 1]); a.y = cvtpk(s0[8 * k2 + 2], s0[8 * k2 + 3]); a.z = cvtpk(s0[8 * k2 + 4], s0[8 * k2 + 5]); a.w = cvtpk(s0[8 * k2 + 6], s0[8 * k2 + 7]);
        v4u c; c.x = cvtpk(s1[8 * k2], s1[8 * k2 + 1]); c.y = cvtpk(s1[8 * k2 + 2], s1[8 * k2 + 3]); c.z = cvtpk(s1[8 * k2 + 4], s1[8 * k2 + 5]); c.w = cvtpk(s1[8 * k2 + 6], s1[8 * k2 + 7]);
        pf[k2] = __builtin_bit_cast(bf16x8_t, a); pf[2 + k2] = __builtin_bit_cast(bf16x8_t, c); }
#pragma unroll
    for (int blk = 0; blk < NBLK; ++blk)
#pragma unroll
        for (int kk = 0; kk < 4; ++kk) { const LAS unsigned char* vp = Vb + kk * 16 * VSTR + blk * 64; const bf16x8_t vf = vtr8(vp, vp + 8 * VSTR);
            o[blk] = __builtin_amdgcn_mfma_f32_32x32x16_bf16(vf, pf[kk], o[blk], 0, 0, 0); }
}
constexpr int A_KSTR = 144, A_VSTR = 192;

__device__ __forceinline__ void xattn_mfma(Frame& F) {
    LAS unsigned char* L = F.lds; constexpr int KOFF = 0, VOFF = 256 * A_KSTR;
    const bf16* kvm = (const bf16*)(F.ws + WS_KVM); const bf16* qx = (const bf16*)(F.ws + WS_QX); bf16* ox = (bf16*)(F.ws + WS_OX);
    const int w = F.wave, lane = F.lane, r32 = lane & 31, hi = lane >> 5;
    for (int u = F.vcu; u < NB * 4 * 32; u += F.G) {
        const int b = u >> 7, h = (u >> 5) & 3, blk = u & 31;
        __syncthreads();
        for (int i = F.tid; i < 2048; i += 512) { const int key = i >> 3, c = i & 7;
            const GAS v4u* src = (const GAS v4u*)(kvm + (size_t)(b * NMEM + key) * 512 + h * 64) + c;
            *(LAS v4u*)(L + KOFF + key * A_KSTR + c * 16) = src[0]; *(LAS v4u*)(L + VOFF + key * A_VSTR + c * 16) = src[32]; }
        const size_t token = (size_t)b * SEQ + blk * 256 + w * 32 + r32;
        bf16x8_t qf[4];
#pragma unroll
        for (int ks = 0; ks < 4; ++ks) qf[ks] = *(const GAS bf16x8_t*)(qx + token * 256 + h * 64 + 16 * ks + 8 * hi);
        __syncthreads();
        f32x16 o[2];
#pragma unroll
        for (int i = 0; i < 2; ++i)
#pragma unroll
            for (int r = 0; r < 16; ++r) o[i][r] = 0.f;
        float m_run = -1e30f, l_run = 0.f;
        const LAS unsigned char* Kb = L + KOFF + r32 * A_KSTR + 16 * hi;
        const LAS unsigned char* Vb = L + VOFF + (4 * hi + ((lane & 15) >> 2)) * A_VSTR + (16 * ((lane >> 4) & 1) + 4 * (lane & 3)) * 2;
#pragma unroll 1
        for (int t = 0; t < 4; ++t) attn_step64<2, A_KSTR, A_VSTR, false>(Kb + t * 64 * A_KSTR, Vb + t * 64 * A_VSTR, qf, nullptr, o, m_run, l_run);
        const float inv = 1.f / (l_run + __shfl_xor(l_run, 32));
        bf16* orow = ox + token * 256 + h * 64 + 4 * hi;
#pragma unroll
        for (int bk = 0; bk < 2; ++bk)
#pragma unroll
            for (int a = 0; a < 4; ++a) { v2u ov; ov.x = pk2(o[bk][4 * a] * inv, o[bk][4 * a + 1] * inv); ov.y = pk2(o[bk][4 * a + 2] * inv, o[bk][4 * a + 3] * inv); *(GAS v2u*)(orow + 32 * bk + 8 * a) = ov; }
    }
}

__device__ __forceinline__ void swa_mfma(Frame& F, int oi) {
    LAS unsigned char* L = F.lds; constexpr int KOFF = 0, VOFF = 192 * A_KSTR, LOFF = VOFF + 192 * A_VSTR;
    LAS float* lut = (LAS float*)(L + LOFF);
    const bf16* z = (const bf16*)(F.ws + WS_Z); bf16* hc = (bf16*)(F.ws + WS_HC);
    const float* tab = F.in[I_TAB]; const float* sinks = F.in[I_OSINK] + oi * 16;
    const int w = F.wave, lane = F.lane, r32 = lane & 31, hi = lane >> 5;
    for (int u = F.vcu; u < NB * 128 * 2; u += F.G) {
        const int b = u >> 8, c = (u >> 1) & 127, kvh = u & 1;
        __syncthreads();
        const int jmin = c >= 2 ? 0 : (2 - c) * 64;
        for (int i = F.tid; i < 192 * 8; i += 512) { const int j = i >> 3, cc = i & 7;
            if (j >= jmin) { const size_t kt = (size_t)b * SEQ + (c - 2) * 64 + j;
                *(LAS v4u*)(L + KOFF + j * A_KSTR + cc * 16) = *((const GAS v4u*)(z + kt * ZO + OKK + kvh * 64) + cc);
                *(LAS v4u*)(L + VOFF + j * A_VSTR + cc * 16) = *((const GAS v4u*)(z + kt * ZO + OVV + kvh * 64) + cc); } }
        for (int i = F.tid; i < 8 * 256; i += 512) { const int g = i >> 8, r = i & 255; lut[i] = r < 255 ? ((const GAS float*)tab)[t5_bucket(r - 191) * 28 + 12 + kvh * 8 + g] * LOG2E : 0.f; }
        __syncthreads();
        const int head = kvh * 8 + w;
        const float sk = ((const GAS float*)sinks)[head] * LOG2E;
#pragma unroll 1
        for (int qb2 = 0; qb2 < 2; ++qb2) {
            const int qi = qb2 * 32 + r32; const size_t token = (size_t)b * SEQ + c * 64 + qi;
            bf16x8_t qf[4];
#pragma unroll
            for (int ks = 0; ks < 4; ++ks) qf[ks] = *(const GAS bf16x8_t*)(z + token * ZO + OQ + head * 64 + 16 * ks + 8 * hi);
            f32x16 o[2];
#pragma unroll
            for (int i = 0; i < 2; ++i)
#pragma unroll
                for (int r = 0; r < 16; ++r) o[i][r] = 0.f;
            float m_run = sk, l_run = hi == 0 ? 1.f : 0.f;
            const LAS unsigned char* Kb = L + KOFF + r32 * A_KSTR + 16 * hi;
            const LAS unsigned char* Vb = L + VOFF + (4 * hi + ((lane & 15) >> 2)) * A_VSTR + (16 * ((lane >> 4) & 1) + 4 * (lane & 3)) * 2;
#pragma unroll 1
            for (int t = (c >= 2 ? 0 : 2 - c); t < 3; ++t)
                attn_step64<2, A_KSTR, A_VSTR, true>(Kb + t * 64 * A_KSTR, Vb + t * 64 * A_VSTR, qf, lut + w * 256 + 64 * t + 4 * hi + 63 - qi, o, m_run, l_run);
            const float inv = 1.f / (l_run + __shfl_xor(l_run, 32));
            bf16* orow = hc + token * HCO + head * 64 + 4 * hi;
#pragma unroll
            for (int bk = 0; bk < 2; ++bk)
#pragma unroll
                for (int a = 0; a < 4; ++a) { v2u ov; ov.x = pk2(o[bk][4 * a] * inv, o[bk][4 * a + 1] * inv); ov.y = pk2(o[bk][4 * a + 2] * inv, o[bk][4 * a + 3] * inv); *(GAS v2u*)(orow + 32 * bk + 8 * a) = ov; }
        }
    }
}

constexpr int TOPK = 256, CANDMAX = 512;
constexpr int DL_SEL = 0;
constexpr int DL_CNT = 16384;
constexpr int DL_W = 16640;
constexpr int DL_QI = DL_W;
constexpr int DL_WI = DL_W + 32768;
constexpr int DL_HIST = DL_W;
constexpr int DL_CAND = DL_W + 65536;
constexpr int DL_FB = 0;
constexpr int DL_QL = DL_W;
constexpr int DL_P = DL_W + 32768;
static_assert(DL_CAND + 32768 <= RING_BYTES && DL_P + 65536 <= RING_BYTES, "DSA LDS map");

__device__ __forceinline__ unsigned fkey(float f) { const unsigned u = __builtin_bit_cast(unsigned, f); return (u & 0x80000000u) ? ~u : (u | 0x80000000u); }

__device__ __forceinline__ void indexer_naive(Frame& F, int b, int t0, int N, float* scr) {
    LAS float* qi = (LAS float*)(F.lds + DL_QI); LAS float* wi = (LAS float*)(F.lds + DL_WI);
    const bf16* z = (const bf16*)(F.ws + WS_Z);
    for (int i = F.tid; i < 16 * 64; i += 512) { const int q = i >> 6, c = i & 63;
        const v4u w = *((const GAS v4u*)(z + ((size_t)b * SEQ + t0 + q) * ZE + ZQI) + c); float v[8]; UNPK8(v, 0, w);
#pragma unroll
        for (int k = 0; k < 8; ++k) qi[q * 512 + c * 8 + k] = v[k]; }
    if (F.tid < 128) { const int q = F.tid >> 3, hh = F.tid & 7; wi[F.tid] = bf2f(((const GAS bf16*)z)[((size_t)b * SEQ + t0 + q) * ZE + ZWI + hh]); }
    __syncthreads();
    for (int s = F.tid; s < N; s += 512) {
        float k[64];
        { const GAS v4u* kp = (const GAS v4u*)(z + ((size_t)b * SEQ + s) * ZE + ZKI);
#pragma unroll
          for (int c = 0; c < 8; ++c) { const v4u w = kp[c]; UNPK8(k, 8 * c, w); } }
        for (int q = 0; q < 16; ++q) {
            float acc = 0.f;
#pragma unroll
            for (int hh = 0; hh < 8; ++hh) {
                const LAS f32x4* qp = (const LAS f32x4*)(qi + q * 512 + hh * 64); float dsum = 0.f;
#pragma unroll
                for (int c = 0; c < 16; ++c) { const f32x4 qq = qp[c]; dsum += (qq.x * k[4 * c] + qq.y * k[4 * c + 1]) + (qq.z * k[4 * c + 2] + qq.w * k[4 * c + 3]); }
                acc = fmaf(wi[q * 8 + hh], fmaxf(dsum, 0.f), acc);
            }
            ((GAS float*)scr)[(size_t)q * SEQ + s] = acc;
        }
    }
}

__device__ __forceinline__ void indexer_mfma(Frame& F, int b, int t0, int N, float* scr, LAS unsigned* hist16) {
    const int w = F.wave, lane = F.lane, n = lane & 31, hi = lane >> 5, g = w & 3, kp = w >> 2;
    const bf16* z = (const bf16*)(F.ws + WS_Z);
    bf16x8_t af[4];
    { const bf16* qrow = z + ((size_t)b * SEQ + t0 + 4 * g + (n >> 3)) * ZE + ZQI + (n & 7) * 64 + 8 * hi;
#pragma unroll
      for (int ks = 0; ks < 4; ++ks) af[ks] = *(const GAS bf16x8_t*)(qrow + 16 * ks); }
    float wv[16];
#pragma unroll
    for (int r = 0; r < 16; ++r) wv[r] = bf2f(((const GAS bf16*)z)[((size_t)b * SEQ + t0 + 4 * g + (r >> 2)) * ZE + ZWI + 4 * hi + (r & 3)]);
    const bf16* kbase = z + ((size_t)b * SEQ + n) * ZE + ZKI + 8 * hi;
    const int nsub = N >> 5;
    bf16x8_t bfr[4], bnx[4];
    int j = kp;
    if (j < nsub) {
#pragma unroll
        for (int ks = 0; ks < 4; ++ks) bfr[ks] = *(const GAS bf16x8_t*)(kbase + (size_t)(32 * j) * ZE + 16 * ks); }
    float* sbase = scr + (size_t)(4 * g + 2 * hi) * SEQ + n;
    LAS unsigned* hq = hist16 + (4 * g + 2 * hi) * 1024;
#pragma unroll 1
    for (; j < nsub; j += 2) {
        const int jn = j + 2;
        if (jn < nsub) {
#pragma unroll
            for (int ks = 0; ks < 4; ++ks) bnx[ks] = *(const GAS bf16x8_t*)(kbase + (size_t)(32 * jn) * ZE + 16 * ks); }
        f32x16 c;
#pragma unroll
        for (int r = 0; r < 16; ++r) c[r] = 0.f;
#pragma unroll
        for (int ks = 0; ks < 4; ++ks) c = __builtin_amdgcn_mfma_f32_32x32x16_bf16(af[ks], bfr[ks], c, 0, 0, 0);
        float tot[4];
#pragma unroll
        for (int qi = 0; qi < 4; ++qi) { float p = 0.f;
#pragma unroll
            for (int i = 0; i < 4; ++i) p = fmaf(wv[4 * qi + i], fmaxf(c[4 * qi + i], 0.f), p);
            tot[qi] = p + __shfl_xor(p, 32); }
        const float sa = hi ? tot[2] : tot[0], sb = hi ? tot[3] : tot[1];
        ((GAS float*)sbase)[32 * j] = sa; ((GAS float*)sbase)[32 * j + SEQ] = sb;
        { const unsigned ba = fkey(sa) >> 21, bb = fkey(sb) >> 21;
          __hip_atomic_fetch_add(hq + (ba >> 1), 1u << (16 * (ba & 1)), __ATOMIC_RELAXED, __HIP_MEMORY_SCOPE_WORKGROUP);
          __hip_atomic_fetch_add(hq + 1024 + (bb >> 1), 1u << (16 * (bb & 1)), __ATOMIC_RELAXED, __HIP_MEMORY_SCOPE_WORKGROUP); }
#pragma unroll
        for (int ks = 0; ks < 4; ++ks) bfr[ks] = bnx[ks];
    }
}

__device__ __forceinline__ int find_bin(LAS unsigned* hist, int lane, unsigned target, unsigned& above) {
    unsigned ls = 0;
#pragma unroll 8
    for (int j = 0; j < 32; ++j) ls += hist[32 * lane + j];
    unsigned suf = ls;
#pragma unroll
    for (int o = 1; o < 64; o <<= 1) { const unsigned t = __shfl_down(suf, o); if (lane + o < 64) suf += t; }
    const unsigned long long mk = __ballot(suf >= target);
    const int L = 63 - __builtin_clzll(mk);
    unsigned cum = __shfl(suf, L) - __shfl(ls, L);
    int bsel = 32 * L;
    for (int j = 31; j >= 0; --j) { const unsigned c = hist[32 * L + j]; if (cum + c >= target) { bsel = 32 * L + j; break; } cum += c; }
    above = cum; return bsel;
}

__device__ __forceinline__ int select_topk(const float* row, int N, LAS int* sel, LAS unsigned* hist, LAS unsigned long long* cand, int lane) {
    if (N <= TOPK) { for (int i = lane; i < N; i += 64) sel[i] = i; LDS_WAIT(); return N; }
    const GAS float* r = (const GAS float*)row;
    const unsigned long long lt = (1ull << lane) - 1ull;
    for (int i = lane; i < 2048; i += 64) hist[i] = 0u;
    LDS_WAIT();
    for (int i = lane; i < N; i += 64) { const unsigned u = fkey(r[i]); __hip_atomic_fetch_add(hist + (u >> 21), 1u, __ATOMIC_RELAXED, __HIP_MEMORY_SCOPE_WORKGROUP); }
    LDS_WAIT();
    unsigned above; const unsigned b0 = (unsigned)find_bin(hist, lane, TOPK, above);
    unsigned need = TOPK - above;
    unsigned nsel = 0, nc = 0;
    for (int i0 = 0; i0 < N; i0 += 64) { const int i = i0 + lane; const unsigned u = fkey(r[i]); const unsigned bin = u >> 21;
        const bool ab = bin > b0, eq = bin == b0; const unsigned long long ma = __ballot(ab), me = __ballot(eq);
        { const unsigned pa = nsel + __builtin_popcountll(ma & lt); if (ab && pa < TOPK) sel[pa] = i; }
        const unsigned pe = nc + __builtin_popcountll(me & lt);
        if (eq && pe < CANDMAX) cand[pe] = ((unsigned long long)u << 32) | (unsigned)i;
        nsel += __builtin_popcountll(ma); nc += __builtin_popcountll(me); }
    LDS_WAIT();
    if (nc <= CANDMAX) {
        for (unsigned ci = lane; ci < nc; ci += 64) { const unsigned long long me = cand[ci]; const unsigned ui = (unsigned)(me >> 32), ii = (unsigned)me; unsigned rank = 0;
            for (unsigned j = 0; j < nc; ++j) { const unsigned long long o = cand[j]; const unsigned uj = (unsigned)(o >> 32), ij = (unsigned)o; rank += (uj > ui || (uj == ui && ij < ii)) ? 1u : 0u; }
            if (rank < need && above + rank < TOPK) sel[above + rank] = (int)ii; }
    } else {
        for (int i = lane; i < 2048; i += 64) hist[i] = 0u;
        LDS_WAIT();
        for (int i = lane; i < N; i += 64) { const unsigned u = fkey(r[i]); if ((u >> 21) == b0) __hip_atomic_fetch_add(hist + ((u >> 10) & 0x7ffu), 1u, __ATOMIC_RELAXED, __HIP_MEMORY_SCOPE_WORKGROUP); }
        LDS_WAIT();
        unsigned ab1; const unsigned b1 = (unsigned)find_bin(hist, lane, need, ab1); const unsigned need1 = need - ab1;
        const unsigned pre = (b0 << 11) | b1;
        for (int i = lane; i < 2048; i += 64) hist[i] = 0u;
        LDS_WAIT();
        for (int i = lane; i < N; i += 64) { const unsigned u = fkey(r[i]); if ((u >> 10) == pre) __hip_atomic_fetch_add(hist + (u & 0x3ffu), 1u, __ATOMIC_RELAXED, __HIP_MEMORY_SCOPE_WORKGROUP); }
        LDS_WAIT();
        unsigned ab2; const unsigned b2 = (unsigned)find_bin(hist, lane, need1, ab2); const unsigned need2 = need1 - ab2;
        const unsigned ustar = (pre << 10) | b2;
        unsigned pos = above, neq = 0;
        for (int i0 = 0; i0 < N; i0 += 64) { const int i = i0 + lane; const unsigned u = fkey(r[i]); const bool inb = (u >> 21) == b0;
            const bool gt = inb && u > ustar, eq = inb && u == ustar; const unsigned long long mg = __ballot(gt), me = __ballot(eq);
            const unsigned re = neq + __builtin_popcountll(me & lt);
            const bool take_eq = eq && re < need2; const unsigned long long mt = __ballot(take_eq);
            const unsigned long long mall = mg | mt;
            { const unsigned pp = pos + __builtin_popcountll(mall & lt); if ((gt || take_eq) && pp < TOPK) sel[pp] = i; }
            pos += __builtin_popcountll(mall); neq += __builtin_popcountll(me); }
    }
    LDS_WAIT();
    return TOPK;
}

__device__ __forceinline__ int find_bin16(const LAS unsigned* h16, int lane, unsigned target, unsigned& above) {
    unsigned ls = 0;
#pragma unroll
    for (int j = 0; j < 16; ++j) { const unsigned wv = h16[16 * lane + j]; ls += (wv & 0xffffu) + (wv >> 16); }
    unsigned suf = ls;
#pragma unroll
    for (int o = 1; o < 64; o <<= 1) { const unsigned t = __shfl_down(suf, o); if (lane + o < 64) suf += t; }
    const unsigned long long mk = __ballot(suf >= target);
    const int L = mk ? 63 - __builtin_clzll(mk) : 0;
    unsigned cum = __shfl(suf, L) - __shfl(ls, L);
    int bsel = 32 * L;
    for (int j = 31; j >= 0; --j) { const unsigned wv = h16[16 * L + (j >> 1)]; const unsigned c = (j & 1) ? (wv >> 16) : (wv & 0xffffu); if (cum + c >= target) { bsel = 32 * L + j; break; } cum += c; }
    above = cum; return bsel;
}
__device__ __forceinline__ int select_topk2(const float* row, int N, LAS int* sel, LAS unsigned* h16, LAS unsigned long long* cand, int lane) {
    if (N <= TOPK) { for (int i = lane; i < N; i += 64) sel[i] = i; LDS_WAIT(); return N; }
    const GAS float* r = (const GAS float*)row;
    const unsigned long long lt = (1ull << lane) - 1ull;
    unsigned above; const unsigned b0 = (unsigned)find_bin16(h16, lane, TOPK, above);
    const unsigned need = TOPK - above;
    unsigned nsel = 0, nc = 0;
#pragma unroll 1
    for (int i0 = 0; i0 < N; i0 += 512) {
        float v[8];
#pragma unroll
        for (int k = 0; k < 8; ++k) { const int i = i0 + 64 * k + lane; v[k] = i < N ? r[i] : 0.f; }
#pragma unroll
        for (int k = 0; k < 8; ++k) { const int i = i0 + 64 * k + lane; const unsigned u = fkey(v[k]); const unsigned bin = u >> 21; const bool inr = i < N;
            const bool ab = inr && bin > b0, eq = inr && bin == b0; const unsigned long long ma = __ballot(ab), me = __ballot(eq);
            { const unsigned pa = nsel + __builtin_popcountll(ma & lt); if (ab && pa < TOPK) sel[pa] = i; }
            const unsigned pe = nc + __builtin_popcountll(me & lt);
            if (eq && pe < CANDMAX) cand[pe] = ((unsigned long long)u << 32) | (unsigned)i;
            nsel += __builtin_popcountll(ma); nc += __builtin_popcountll(me); }
    }
    LDS_WAIT();
    if (nc <= CANDMAX) {
        unsigned cu[8], cidx[8];
#pragma unroll
        for (int k = 0; k < 8; ++k) { const unsigned ci = lane + 64 * k; const unsigned long long me = ci < nc ? cand[ci] : 0ull; cu[k] = (unsigned)(me >> 32); cidx[k] = (unsigned)me; }
        unsigned ustar = b0 << 21;
#pragma unroll 1
        for (int bit = 20; bit >= 0; --bit) { const unsigned trial = ustar | (1u << bit); unsigned c = 0;
#pragma unroll
            for (int k = 0; k < 8; ++k) c += __builtin_popcountll(__ballot((lane + 64 * k) < nc && cu[k] >= trial));
            if (c >= need) ustar = trial; }
        unsigned cgt = 0;
#pragma unroll
        for (int k = 0; k < 8; ++k) cgt += __builtin_popcountll(__ballot((lane + 64 * k) < nc && cu[k] > ustar));
        const unsigned need_eq = need - cgt;
        unsigned pos = above, neq = 0;
#pragma unroll
        for (int k = 0; k < 8; ++k) { const bool vld = (lane + 64 * k) < nc; const bool gt = vld && cu[k] > ustar, eq = vld && cu[k] == ustar;
            const unsigned long long me = __ballot(eq); const unsigned re = neq + __builtin_popcountll(me & lt); const bool take = gt || (eq && re < need_eq);
            const unsigned long long mt = __ballot(take); const unsigned pp = pos + __builtin_popcountll(mt & lt);
            if (take && pp < TOPK) sel[pp] = (int)cidx[k];
            pos += __builtin_popcountll(mt); neq += __builtin_popcountll(me); }
    } else {
        for (int i = lane; i < 1024; i += 64) h16[i] = 0u;
        LDS_WAIT();
        for (int i = lane; i < N; i += 64) { const unsigned u = fkey(r[i]); if ((u >> 21) == b0) { const unsigned bb = (u >> 10) & 0x7ffu; __hip_atomic_fetch_add(h16 + (bb >> 1), 1u << (16 * (bb & 1)), __ATOMIC_RELAXED, __HIP_MEMORY_SCOPE_WORKGROUP); } }
        LDS_WAIT();
        unsigned ab1; const unsigned b1 = (unsigned)find_bin16(h16, lane, need, ab1); const unsigned need1 = need - ab1;
        const unsigned pre = (b0 << 11) | b1;
        for (int i = lane; i < 1024; i += 64) h16[i] = 0u;
        LDS_WAIT();
        for (int i = lane; i < N; i += 64) { const unsigned u = fkey(r[i]); if ((u >> 10) == pre) { const unsigned bb = u & 0x3ffu; __hip_atomic_fetch_add(h16 + (bb >> 1), 1u << (16 * (bb & 1)), __ATOMIC_RELAXED, __HIP_MEMORY_SCOPE_WORKGROUP); } }
        LDS_WAIT();
        unsigned ab2; const unsigned b2 = (unsigned)find_bin16(h16, lane, need1, ab2); const unsigned need2 = need1 - ab2;
        const unsigned ustar = (pre << 10) | b2;
        unsigned pos = above, neq = 0;
        for (int i0 = 0; i0 < N; i0 += 64) { const int i = i0 + lane; const unsigned u = fkey(r[i]); const bool inb = (u >> 21) == b0;
            const bool gt = inb && u > ustar, eq = inb && u == ustar; const unsigned long long mg = __ballot(gt), me = __ballot(eq);
            const unsigned re = neq + __builtin_popcountll(me & lt);
            const bool take_eq = eq && re < need2; const unsigned long long mt = __ballot(take_eq);
            const unsigned long long mall = mg | mt;
            { const unsigned pp = pos + __builtin_popcountll(mall & lt); if ((gt || take_eq) && pp < TOPK) sel[pp] = i; }
            pos += __builtin_popcountll(mall); neq += __builtin_popcountll(me); }
    }
    LDS_WAIT();
    return TOPK;
}

__device__ __forceinline__ void sparse_naive(Frame& F, int b, int t, const LAS int* sel, int cnt, LAS float* qlw, LAS float* Pw, int lane) {
    const bf16* z = (const bf16*)(F.ws + WS_Z); const bf16* ck = (const bf16*)(F.ws + WS_CKVN) + (size_t)b * SEQ * 128; bf16* hc = (bf16*)(F.ws + WS_HC);
    const float* tab = F.in[I_TAB];
    const size_t token = (size_t)b * SEQ + t;
    { const GAS v4u* qp = (const GAS v4u*)(z + token * ZE + ZQL) + 2 * lane; const v4u w0 = qp[0], w1 = qp[1]; float v[16]; UNPK8(v, 0, w0); UNPK8(v, 8, w1);
#pragma unroll
      for (int k = 0; k < 16; ++k) qlw[16 * lane + k] = v[k]; }
    LDS_WAIT();
    float s[4][8];
#pragma unroll
    for (int kk = 0; kk < 4; ++kk) {
        const int j = lane + 64 * kk; const bool valid = j < cnt; const int key = valid ? sel[j] : 0;
        float acc[8];
#pragma unroll
        for (int hh = 0; hh < 8; ++hh) acc[hh] = 0.f;
        const GAS v4u* cp = (const GAS v4u*)(ck + (size_t)key * 128);
        for (int ch = 0; ch < 16; ++ch) { const v4u w = cp[ch]; float c8[8]; UNPK8(c8, 0, w);
#pragma unroll
            for (int hh = 0; hh < 8; ++hh) { const LAS f32x4* qq = (const LAS f32x4*)(qlw + hh * 128 + ch * 8); const f32x4 a = qq[0], bq = qq[1];
                acc[hh] += (a.x * c8[0] + a.y * c8[1]) + (a.z * c8[2] + a.w * c8[3]) + (bq.x * c8[4] + bq.y * c8[5]) + (bq.z * c8[6] + bq.w * c8[7]); } }
        const int bk = t5_bucket(key - t);
#pragma unroll
        for (int hh = 0; hh < 8; ++hh) s[kk][hh] = valid ? acc[hh] * 0.125f + ((const GAS float*)tab)[bk * 28 + hh] : -1e30f;
    }
#pragma unroll
    for (int hh = 0; hh < 8; ++hh) {
        const float mx = wave_max(fmaxf(fmaxf(s[0][hh], s[1][hh]), fmaxf(s[2][hh], s[3][hh])));
        float p[4], sum = 0.f;
#pragma unroll
        for (int kk = 0; kk < 4; ++kk) { p[kk] = __expf(s[kk][hh] - mx); sum += p[kk]; }
        const float inv = 1.f / wave_sum(sum);
#pragma unroll
        for (int kk = 0; kk < 4; ++kk) Pw[(lane + 64 * kk) * 8 + hh] = p[kk] * inv;
    }
    LDS_WAIT();
    float o0[8], o1[8];
#pragma unroll
    for (int hh = 0; hh < 8; ++hh) { o0[hh] = 0.f; o1[hh] = 0.f; }
    for (int j = 0; j < cnt; ++j) {
        const int key = sel[j]; const unsigned w = *((const GAS unsigned*)(ck + (size_t)key * 128) + lane); const float c0 = bflo(w), c1 = bfhi(w);
        const LAS f32x4* pp = (const LAS f32x4*)(Pw + j * 8); const f32x4 pa = pp[0], pb = pp[1];
        o0[0] += pa.x * c0; o1[0] += pa.x * c1; o0[1] += pa.y * c0; o1[1] += pa.y * c1; o0[2] += pa.z * c0; o1[2] += pa.z * c1; o0[3] += pa.w * c0; o1[3] += pa.w * c1;
        o0[4] += pb.x * c0; o1[4] += pb.x * c1; o0[5] += pb.y * c0; o1[5] += pb.y * c1; o0[6] += pb.z * c0; o1[6] += pb.z * c1; o0[7] += pb.w * c0; o1[7] += pb.w * c1;
    }
#pragma unroll
    for (int hh = 0; hh < 8; ++hh) *((GAS unsigned*)(hc + token * HCE + hh * 128) + lane) = pk2(o0[hh], o1[hh]);
    LDS_WAIT();
}

constexpr int DL_IMG = DL_W, IMG_STR = 288, IMG_BYTES = 32 * IMG_STR, DL_TABA = DL_W + 8 * IMG_BYTES;
static_assert(DL_TABA + 1024 <= RING_BYTES, "sparse LDS map");
__device__ __forceinline__ void sparse_mfma(Frame& F, int b, int t, const LAS int* sel, int cnt, LAS unsigned char* img, const LAS float* tabA, int lane) {
    const bf16* z = (const bf16*)(F.ws + WS_Z); const bf16* ck = (const bf16*)(F.ws + WS_CKVN) + (size_t)b * SEQ * 128; bf16* hc = (bf16*)(F.ws + WS_HC);
    const int hd = lane & 15, g = lane >> 4; const size_t token = (size_t)b * SEQ + t;
    constexpr float C2A = 0.125f * LOG2E;
    bf16x8_t qf[4];
#pragma unroll
    for (int ks = 0; ks < 4; ++ks) { qf[ks] = *(const GAS bf16x8_t*)(z + token * ZE + ZQL + (hd & 7) * 128 + 32 * ks + 8 * g); if (hd >= 8) qf[ks] = (bf16x8_t){0, 0, 0, 0, 0, 0, 0, 0}; }
    f32x4 o[8];
#pragma unroll
    for (int mt = 0; mt < 8; ++mt) o[mt] = (f32x4){0.f, 0.f, 0.f, 0.f};
    float m_run = -1e30f, l_run = 0.f;
    v4u gb[8];
    const int nblk = cnt >> 5;
#pragma unroll
    for (int k = 0; k < 8; ++k) { const int key = sel[4 * k + g]; gb[k] = *(const GAS v4u*)(ck + (size_t)key * 128 + hd * 8); }
#pragma unroll 1
    for (int blk = 0; blk < nblk; ++blk) {
#pragma unroll
        for (int k = 0; k < 8; ++k) *(LAS v4u*)(img + (4 * k + g) * IMG_STR + hd * 16) = gb[k];
        if (blk + 1 < nblk) {
#pragma unroll
            for (int k = 0; k < 8; ++k) { const int key = sel[(blk + 1) * 32 + 4 * k + g]; gb[k] = *(const GAS v4u*)(ck + (size_t)key * 128 + hd * 8); } }
        f32x4 s[2];
#pragma unroll
        for (int tau = 0; tau < 2; ++tau) { s[tau] = (f32x4){0.f, 0.f, 0.f, 0.f};
#pragma unroll
            for (int ks = 0; ks < 4; ++ks) { const bf16x8_t a = *(const LAS bf16x8_t*)(img + (16 * tau + hd) * IMG_STR + (32 * ks + 8 * g) * 2);
                s[tau] = __builtin_amdgcn_mfma_f32_16x16x32_bf16(a, qf[ks], s[tau], 0, 0, 0); } }
        float x[8]; float mx = -1e30f;
#pragma unroll
        for (int tau = 0; tau < 2; ++tau)
#pragma unroll
            for (int i = 0; i < 4; ++i) { const int key = sel[blk * 32 + 16 * tau + 4 * g + i]; const int bk = t5_bucket(key - t);
                x[4 * tau + i] = s[tau][i] * C2A + tabA[bk * 8 + (hd & 7)]; mx = fmaxf(mx, x[4 * tau + i]); }
        mx = fmaxf(mx, __shfl_xor(mx, 16)); mx = fmaxf(mx, __shfl_xor(mx, 32));
        if (__any(mx > m_run)) { const float mn = fmaxf(m_run, mx), al = __builtin_amdgcn_exp2f(m_run - mn); m_run = mn; l_run *= al;
#pragma unroll
            for (int mt = 0; mt < 8; ++mt) o[mt] *= al; }
        float ps = 0.f;
#pragma unroll
        for (int i = 0; i < 8; ++i) { x[i] = __builtin_amdgcn_exp2f(x[i] - m_run); ps += x[i]; }
        l_run += ps;
        v4u pw; pw.x = cvtpk(x[0], x[1]); pw.y = cvtpk(x[2], x[3]); pw.z = cvtpk(x[4], x[5]); pw.w = cvtpk(x[6], x[7]);
        const bf16x8_t pf = __builtin_bit_cast(bf16x8_t, pw);
        const LAS unsigned char* vb = img + (4 * g + (hd >> 2)) * IMG_STR + (4 * (hd & 3)) * 2;
#pragma unroll
        for (int mt = 0; mt < 8; ++mt) { const bf16x8_t vf = vtr8(vb + mt * 32, vb + mt * 32 + 16 * IMG_STR); o[mt] = __builtin_amdgcn_mfma_f32_16x16x32_bf16(vf, pf, o[mt], 0, 0, 0); }
    }
    float l = l_run; l += __shfl_xor(l, 16); l += __shfl_xor(l, 32);
    const float inv = 1.f / l;
    if (hd < 8) {
        bf16* orow = hc + token * HCE + hd * 128 + 4 * g;
#pragma unroll
        for (int mt = 0; mt < 8; ++mt) { v2u ov; ov.x = pk2(o[mt][0] * inv, o[mt][1] * inv); ov.y = pk2(o[mt][2] * inv, o[mt][3] * inv); *(GAS v2u*)(orow + 16 * mt) = ov; }
    }
    LDS_WAIT();
}

__device__ __forceinline__ void dsa_phase(Frame& F) {
    float* scr = (float*)(F.ws + WS_SCR) + (size_t)blockIdx.x * 16 * SEQ;
    LAS int* selA = (LAS int*)(F.lds + DL_SEL); LAS int* cntA = (LAS int*)(F.lds + DL_CNT);
    const int NU = NB * 128 * 4;
    for (int ui = F.vcu; ui < NU; ui += F.G) {
        const int rr = ui / F.G, v = ui % F.G;
        const int b = (v * NB) / F.G, j = v % (F.G / NB);
        const int half = rr >> 2, sub = rr & 3;
        const int c = (F.G / NB == 64) ? (half == 0 ? j : 127 - j) : 0;
        const int t0 = c * 64 + sub * 16, N = 64 * (c + 1);
        __syncthreads();
        for (int i = F.tid; i < 16 * 1024; i += 512) ((LAS unsigned*)(F.lds + DL_HIST))[i] = 0u;
        __syncthreads();
        indexer_mfma(F, b, t0, N, scr, (LAS unsigned*)(F.lds + DL_HIST));
        VM_WAIT(); __syncthreads();
#pragma unroll 1
        for (int r2 = 0; r2 < 2; ++r2) { const int q = F.wave + 8 * r2;
            const int cnt = select_topk2(scr + (size_t)q * SEQ, N, selA + q * 256, (LAS unsigned*)(F.lds + DL_HIST) + q * 1024, (LAS unsigned long long*)(F.lds + DL_CAND) + F.wave * 512, F.lane);
            if (F.lane == 0) cntA[q] = cnt; }
        __syncthreads();
        if (F.tid < 256) ((LAS float*)(F.lds + DL_TABA))[F.tid] = ((const GAS float*)F.in[I_TAB])[(F.tid >> 3) * 28 + (F.tid & 7)] * LOG2E;
        __syncthreads();
#pragma unroll 1
        for (int r2 = 0; r2 < 2; ++r2) { const int q = F.wave + 8 * r2;
            sparse_mfma(F, b, t0 + q, selA + q * 256, cntA[q], F.lds + DL_IMG + F.wave * IMG_BYTES, (const LAS float*)(F.lds + DL_TABA), F.lane); }
    }
}

#ifndef MK_MULTI
#define MK_MULTI 0
#endif
constexpr int N_PHASES = 1 + 2 * (4 + 8) + 2 * (3 + 8);
struct Args { const float* in[20]; float* out; unsigned char* ws; int ph_lo, ph_hi; };
static_assert(sizeof(Args) == 22 * 8 + 8, "Args has no padding");

#define GEMM_CALL(ACTV, Aptr, Bptr, Mv, Nv, Kv, Optr, LDC, CID) do { \
    pg8::Gemm g_{(const pg8::bf16_t*)(Aptr), (const pg8::bf16_t*)(Bptr), (Mv), (Nv), (Kv)}; pg8::StaticOrder S_; S_.init((Mv), (Nv), F.G, (CID)); \
    pg8::EpiAct<ACTV> E_{(pg8::bf16_t*)(Optr), (LDC)}; \
    pg8::gemm_phase<pg8::EpiAct<ACTV>, pg8::StaticOrder, true, true>(F.lds + RING_OFF, g_, S_, E_); } while (0)

__global__ void __launch_bounds__(NWAVES * 64, 2) mk_fwd(Args args) {
    extern __shared__ __attribute__((aligned(16))) unsigned char lds[];
    Frame F;
    F.lds = (LAS unsigned char*)lds;
    F.MISC = (volatile LAS unsigned*)(F.lds + MISC_OFF);
    F.tid = threadIdx.x; F.lane = F.tid & 63; F.wave = __builtin_amdgcn_readfirstlane(F.tid >> 6);
    F.G = gridDim.x; { const int bx = blockIdx.x; F.vcu = (F.G % 8 == 0) ? (bx % 8) * (F.G / 8) + bx / 8 : bx; }
    unsigned char* ws = args.ws; F.ws = ws; F.out = args.out;
    F.ctl = (gu32*)(ws + WS_CTL);
#pragma unroll
    for (int i = 0; i < 20; ++i) F.in[i] = args.in[i];
    for (int u = F.tid; u < (LDS_BYTES - LDSCTL_OFF) / 4; u += NWAVES * 64) ((LAS unsigned*)(F.lds + LDSCTL_OFF))[u] = 0u;
    __syncthreads();
#if MK_MULTI
    XcdBarrier bar; bar.bar = (unsigned*)(F.ctl + CW_BAR); bar.x = 0; bar.st = nullptr;
#else
    XcdBarrier bar = xcd_barrier_post((unsigned*)(F.ctl + CW_BAR), F.MISC + 8);
#endif
    const int lo = args.ph_lo, hi = args.ph_hi;
    int pid = 0;
#define PH_ON (pid >= lo && pid < hi && refresh(F))
#if MK_MULTI
#define PH_END do { ++pid; } while (0)
#else
#define PH_END do { if (pid >= lo && pid + 1 < hi) xcd_barrier(bar); ++pid; } while (0)
#endif
    bf16* const WIN = (bf16*)(ws + WS_WGT + WO_WIN); bf16* const WOUT = (bf16*)(ws + WS_WGT + WO_WOUT); bf16* const WQ = (bf16*)(ws + WS_WGT + WO_WQ); bf16* const WKV = (bf16*)(ws + WS_WGT + WO_WKV);
    bf16* const WO = (bf16*)(ws + WS_WGT + WO_WO); bf16* const W1 = (bf16*)(ws + WS_WGT + WO_W1); bf16* const W2 = (bf16*)(ws + WS_WGT + WO_W2);
    bf16* const HC = (bf16*)(ws + WS_HC); bf16* const Z = (bf16*)(ws + WS_Z); bf16* const Y = (bf16*)(ws + WS_Y); bf16* const U = (bf16*)(ws + WS_U);
    bf16* const QX = (bf16*)(ws + WS_QX); bf16* const OX = (bf16*)(ws + WS_OX); bf16* const MEMN = (bf16*)(ws + WS_MEMN); bf16* const KVM = (bf16*)(ws + WS_KVM);
    const float* const NG = F.in[I_NG];

    if (PH_ON) { convert_weights(F, 0); thin_first(F, NG); }
    PH_END;

#pragma unroll 1
    for (int l = 0; l < 4; ++l) {
        const float* g = NG + (size_t)l * 6 * D;
        if ((l & 1) == 0) {
            const int e = l >> 1; const float lam_init = e == 0 ? 0.20000000000000007f : 0.4707130183435842f;
            if (PH_ON) { GEMM_CALL(0, HC, WIN, M, ZE, D, Z, ZE, (int)blockIdx.x); }
            PH_END;
            if (PH_ON) { thin_ckvn(F, F.in[I_EKVN] + e * 128); }
            PH_END;
            if (PH_ON) { diff_mfma(F, e, lam_init); dsa_phase(F); }
            PH_END;
            if (PH_ON) { GEMM_CALL(0, HC, WOUT, M, D, HCE, Y, D, (int)blockIdx.x); }
            PH_END;
        } else {
            const int o = l >> 1;
            if (PH_ON) { GEMM_CALL(0, HC, WIN, M, ZO, D, Z, ZO, (int)blockIdx.x); }
            PH_END;
            if (PH_ON) { swa_mfma(F, o); }
            PH_END;
            if (PH_ON) { GEMM_CALL(0, HC, WOUT, M, D, HCO, Y, D, (int)blockIdx.x); }
            PH_END;
        }
        if (PH_ON) { thin_mid(F, g + 1 * D, g + 2 * D); thin_memn(F, F.in[I_XMN] + (size_t)l * D); }
        PH_END;
        if (PH_ON) { GEMM_CALL(0, HC, WQ, M, 256, D, QX, 256, (int)blockIdx.x); GEMM_CALL(0, MEMN, WKV, NB * NMEM, 512, D, KVM, 512, (int)((blockIdx.x + 128) % F.G)); }
        PH_END;
        if (PH_ON) { xattn_mfma(F); }
        PH_END;
        if (PH_ON) { GEMM_CALL(0, OX, WO, M, D, 256, Y, D, (int)blockIdx.x); }
        PH_END;
        if (PH_ON) { thin_mid(F, g + 3 * D, g + 4 * D); }
        PH_END;
        if (PH_ON) { GEMM_CALL(2, HC, W1, M, FF, D, U, FF, (int)blockIdx.x); }
        PH_END;
        if (PH_ON) { GEMM_CALL(0, U, W2, M, D, FF, Y, D, (int)blockIdx.x); }
        PH_END;
        if (PH_ON) { thin_mid(F, g + 5 * D, l < 3 ? g + 6 * D : nullptr); if (l < 3) convert_weights(F, l + 1); }
        PH_END;
    }
}

extern "C" void kernel_launch(void* const* d_in, const int* in_sizes, int n_in, void* d_out, int out_size, void* d_ws, size_t ws_size, hipStream_t stream) {
    static int grid = 0;
    if (grid == 0) {
        if (n_in != 20 || out_size != M * D || ws_size < WS_END) { fprintf(stderr, "kernel_launch: unexpected shapes: n_in %d out %d ws %zu (need %zu)\n", n_in, out_size, ws_size, (size_t)WS_END); grid = -1; return; }
        int dev = 0, cus = 0, per_cu = 0;
        if (hipGetDevice(&dev) != hipSuccess || hipDeviceGetAttribute(&cus, hipDeviceAttributeMultiprocessorCount, dev) != hipSuccess) { grid = -1; return; }
        if (hipFuncSetAttribute((const void*)mk_fwd, hipFuncAttributeMaxDynamicSharedMemorySize, LDS_BYTES) != hipSuccess) { fprintf(stderr, "kernel_launch: hipFuncSetAttribute failed\n"); grid = -1; return; }
        if (hipOccupancyMaxActiveBlocksPerMultiprocessor(&per_cu, (const void*)mk_fwd, NWAVES * 64, LDS_BYTES) != hipSuccess || per_cu < 1)
            fprintf(stderr, "kernel_launch: note: occupancy query reports %d workgroups per CU\n", per_cu);
        (void)hipGetLastError();
        grid = cus;
        if (grid != 256) { fprintf(stderr, "kernel_launch: built for 256 CUs, device has %d\n", cus); grid = -1; return; }
    }
    if (grid < 0) return;
    if (hipMemsetAsync((char*)d_ws + WS_CTL, 0, CTL_ZERO_BYTES, stream) != hipSuccess) return;
    Args a{};
    for (int i = 0; i < 20; ++i) a.in[i] = (const float*)d_in[i];
    a.out = (float*)d_out; a.ws = (unsigned char*)d_ws;
#if MK_MULTI
    for (int p = 0; p < N_PHASES; ++p) { a.ph_lo = p; a.ph_hi = p + 1; hipLaunchKernelGGL(mk_fwd, dim3(grid), dim3(NWAVES * 64), LDS_BYTES, stream, a); }
#else
    a.ph_lo = 0; a.ph_hi = N_PHASES; hipLaunchKernelGGL(mk_fwd, dim3(grid), dim3(NWAVES * 64), LDS_BYTES, stream, a);
#endif
}
```

```cpp
#include <hip/hip_runtime.h>
#include <cstdio>
#include <cstdint>
namespace pg8 {
#define PG8_LAS __attribute__((address_space(3)))
typedef unsigned short bf16_t;
typedef short bf16x8 __attribute__((ext_vector_type(8)));
typedef float f32x4 __attribute__((ext_vector_type(4)));
typedef unsigned u32x4 __attribute__((ext_vector_type(4)));
constexpr int BM = 256, BK = 64, HALF = 128, HTB = HALF * BK * 2  , STAGE_BYTES = 8 * HTB, NXCD = 8, WGM = 8;

__host__ __device__ __forceinline__ int lds_byte(int r, int c) { const int st = (r >> 4) * 2 + (c >> 5), rr = r & 15, cc = c & 31, ob = rr * 64 + cc * 2; return st * 1024 + (ob ^ (((ob >> 9) & 1) << 5)); }
__host__ __device__ __forceinline__ void stage_rc(int b, int& R, int& C) { const int st = b / 1024, sb = b % 1024, swz = sb ^ (((sb >> 9) & 1) << 5); R = (st >> 1) * 16 + swz / 64; C = (st & 1) * 32 + (swz % 64) / 2; }
__host__ __device__ __forceinline__ int perm32(int rho) { const int n = rho >> 4, i = rho & 15; return 8 * (i >> 2) + 4 * n + (i & 3); }

struct Unit { int pm, pn; };
struct Gemm { const bf16_t* A; const bf16_t* Bt; int M, N, K; };

struct StaticOrder {
    int nM, nN, nwg, G, c;
    __host__ __device__ void init(int M, int N, int G_, int c_) { nM = M / BM; nN = N / BM; nwg = nM * nN; G = G_; c = c_; }
    __host__ __device__ bool next(int i, Unit& u) const {
        const long L = (long)i * G + c; if (L >= nwg) return false;
        int wgid = (int)L; { const int q = nwg / NXCD, r = nwg % NXCD, xcd = wgid % NXCD, off = wgid / NXCD; wgid = (xcd < r ? xcd * (q + 1) : r * (q + 1) + (xcd - r) * q) + off; }
        const int nig = WGM * nN, gid = wgid / nig, fm = gid * WGM, gsz = (nM - fm) < WGM ? (nM - fm) : WGM;
        u.pm = fm + ((wgid % nig) % gsz); u.pn = (wgid % nig) / gsz; return true;
    }
    __device__ __forceinline__ void a_ready(const Unit&) const {}
    __device__ __forceinline__ void done(const Unit&) const {}
};


__device__ __forceinline__ unsigned cvt_pk_bf16(float lo, float hi) { unsigned r; asm volatile("v_cvt_pk_bf16_f32 %0, %1, %2" : "=v"(r) : "v"(lo), "v"(hi)); return r; }
template <int ACT  > struct EpiAct {
    static constexpr bool PERM = true, AFTER_DRAIN = false;
    bf16_t* O; int ldc; const float* rs;
    __device__ __forceinline__ void operator()(const f32x4 (&acc)[2][2][4][2], const Unit& u, int wr, int wc, int fr, int fq) const {
        const int row0 = u.pm * BM + wr * 64 + fr; const int col0 = u.pn * BM + wc * 32 + 8 * fq;
#pragma unroll
        for (int ai = 0; ai < 2; ++ai)
#pragma unroll
            for (int m = 0; m < 4; ++m) { bf16_t* rowp = O + (size_t)(row0 + ai * HALF + m * 16) * ldc + col0; const float rsc = rs ? rs[row0 + ai * HALF + m * 16] : 1.f;
#pragma unroll
                for (int bj = 0; bj < 2; ++bj) { f32x4 v0 = acc[ai][bj][m][0] * rsc, v1 = acc[ai][bj][m][1] * rsc;
                    if (ACT == 2) {
#pragma unroll
                        for (int i = 0; i < 4; ++i) { float a = v0[i] > 0.f ? v0[i] : 0.f; v0[i] = a * a; float b = v1[i] > 0.f ? v1[i] : 0.f; v1[i] = b * b; }
                    }
                    u32x4 w; w.x = cvt_pk_bf16(v0[0], v0[1]); w.y = cvt_pk_bf16(v0[2], v0[3]); w.z = cvt_pk_bf16(v1[0], v1[1]); w.w = cvt_pk_bf16(v1[2], v1[3]);
                    *(u32x4*)(rowp + bj * HALF) = w; } }
    }
};
template <class Epi, class Sched, bool ALIGN_EPI = false, bool SP2 = false>
__device__ __forceinline__ void gemm_phase(PG8_LAS unsigned char* lds, const Gemm g, const Sched& S, const Epi& E) {
    int tid_ = threadIdx.x; asm volatile("" : "+v"(tid_)); const int tid = tid_, wid = __builtin_amdgcn_readfirstlane(tid >> 6), lane = tid & 63, wr = wid >> 2, wc = wid & 3, fr = lane & 15, fq = lane >> 4;
    const int K = g.K, nt = K / BK;
    unsigned voffA[2], voffB[2];
#pragma unroll
    for (int i = 0; i < 2; ++i) { int R, C; stage_rc(tid * 16 + i * 8192, R, C); const int Rb = Epi::PERM ? ((R & ~31) + perm32(R & 31)) : R;
        voffA[i] = (unsigned)(R * K + C) * 2u; voffB[i] = (unsigned)(Rb * K + C) * 2u; }
    const size_t kstep = (size_t)(BK * 2);
    const size_t hstep = (size_t)HALF * K * 2;
    const size_t tstep = 2 * hstep;
    const unsigned ldsw = (unsigned)wid * 1024u;
    const int aoff = lds_byte(wr * 64 + fr, fq * 8), boff = lds_byte(wc * 32 + fr, fq * 8);
#define PG8_SA(b, h) (((b) * 2 + (h)) * HTB)
#define PG8_SB(b, h) ((4 + (b) * 2 + (h)) * HTB)
#define PG8_STAGE(bufoff, gbase, voff) do { _Pragma("unroll") for (int _i = 0; _i < 2; ++_i) \
        __builtin_amdgcn_global_load_lds((const unsigned*)((const char*)(gbase) + (voff)[_i]), (PG8_LAS unsigned*)(lds + (bufoff) + ldsw + _i * 8192), 16, 0, 0); } while (0)
#define PG8_LDA(dst, b, h) do { _Pragma("unroll") for (int m = 0; m < 4; ++m) _Pragma("unroll") for (int k = 0; k < 2; ++k) dst[m][k] = *(const PG8_LAS bf16x8*)(lds + PG8_SA(b, h) + aoff + m * 2048 + k * 1024); } while (0)
#define PG8_LDB(dst, b, h) do { _Pragma("unroll") for (int n = 0; n < 2; ++n) _Pragma("unroll") for (int k = 0; k < 2; ++k) dst[n][k] = *(const PG8_LAS bf16x8*)(lds + PG8_SB(b, h) + boff + n * 2048 + k * 1024); } while (0)
#define PG8_MMA(ai, bj, At, Bt) do { __builtin_amdgcn_s_setprio(1); _Pragma("unroll") for (int m = 0; m < 4; ++m) _Pragma("unroll") for (int n = 0; n < 2; ++n) _Pragma("unroll") for (int k = 0; k < 2; ++k) \
        acc[ai][bj][m][n] = __builtin_amdgcn_mfma_f32_16x16x32_bf16(Bt[n][k], At[m][k], acc[ai][bj][m][n], 0, 0, 0); __builtin_amdgcn_s_setprio(0); } while (0)
#define PG8_WAIT_V(n) asm volatile("s_waitcnt vmcnt(" #n ")" ::: "memory")
#define PG8_WAIT_L(n) asm volatile("s_waitcnt lgkmcnt(" #n ")" ::: "memory")
#define PG8_BAR __builtin_amdgcn_s_barrier()
#define PG8_SCHED __builtin_amdgcn_sched_barrier(0)
    Unit cur, nxt; int ui = 0;
    if (!S.next(0, cur)) return;
    f32x4 acc[2][2][4][2];
#pragma unroll
    for (int a = 0; a < 2; ++a)
#pragma unroll
        for (int b = 0; b < 2; ++b)
#pragma unroll
            for (int m = 0; m < 4; ++m)
#pragma unroll
                for (int n = 0; n < 2; ++n) acc[a][b][m][n] = (f32x4){0.f, 0.f, 0.f, 0.f};
    bf16x8 At[4][2], B0[2][2], B1[2][2];
    const char* cA = (const char*)g.A + (size_t)cur.pm * tstep; const char* cB = (const char*)g.Bt + (size_t)cur.pn * tstep;
    S.a_ready(cur);
    if constexpr (SP2) {
        PG8_STAGE(PG8_SB(0, 0), cB, voffB); PG8_STAGE(PG8_SB(0, 1), cB + hstep, voffB); PG8_STAGE(PG8_SA(0, 0), cA, voffA); PG8_STAGE(PG8_SA(0, 1), cA + hstep, voffA);
        if (wr == 1) PG8_BAR;
        PG8_WAIT_V(2); PG8_BAR;
        PG8_STAGE(PG8_SB(1, 0), cB + kstep, voffB); PG8_STAGE(PG8_SA(1, 0), cA + kstep, voffA); PG8_STAGE(PG8_SB(1, 1), cB + hstep + kstep, voffB);
        PG8_WAIT_V(6); PG8_BAR;
    } else {
        PG8_STAGE(PG8_SB(0, 0), cB, voffB); PG8_STAGE(PG8_SA(0, 0), cA, voffA); PG8_STAGE(PG8_SB(0, 1), cB + hstep, voffB); PG8_STAGE(PG8_SA(0, 1), cA + hstep, voffA);
        if (wr == 1) PG8_BAR;
        PG8_WAIT_V(4); PG8_BAR;
        PG8_STAGE(PG8_SB(1, 0), cB + kstep, voffB); PG8_STAGE(PG8_SA(1, 0), cA + kstep, voffA); PG8_STAGE(PG8_SB(1, 1), cB + hstep + kstep, voffB);
        PG8_WAIT_V(6); PG8_BAR;
    }
    for (;;) {
        const bool has_next = S.next(ui + 1, nxt);
        const char* nA = has_next ? (const char*)g.A + (size_t)nxt.pm * tstep : cA; const char* nB = has_next ? (const char*)g.Bt + (size_t)nxt.pn * tstep : cB;
        for (int t = 0; t < nt; t += 2) {
            const bool last = (t == nt - 2);
            const char* a1 = cA + (size_t)(t + 1) * kstep;
            const char* a2 = last ? nA : cA + (size_t)(t + 2) * kstep; const char* b2 = last ? nB : cB + (size_t)(t + 2) * kstep;
            const char* a3 = a2 + kstep; const char* b3 = b2 + kstep;
            if (last && has_next) S.a_ready(nxt);
            if constexpr (SP2) {
            PG8_LDB(B0, 0, 0); PG8_LDB(B1, 0, 1); PG8_SCHED; PG8_LDA(At, 0, 0); PG8_STAGE(PG8_SA(1, 1), a1 + hstep, voffA);
            PG8_WAIT_V(8); PG8_WAIT_L(0); PG8_BAR; PG8_MMA(0, 0, At, B0); PG8_MMA(0, 1, At, B1); PG8_BAR; PG8_SCHED;
            PG8_LDA(At, 0, 1); PG8_STAGE(PG8_SB(0, 0), b2, voffB); PG8_STAGE(PG8_SB(0, 1), b2 + hstep, voffB); PG8_STAGE(PG8_SA(0, 0), a2, voffA);
            PG8_WAIT_V(8); PG8_WAIT_L(0); PG8_BAR; PG8_MMA(1, 0, At, B0); PG8_MMA(1, 1, At, B1); PG8_BAR; PG8_SCHED;
            PG8_LDB(B0, 1, 0); PG8_LDB(B1, 1, 1); PG8_SCHED; PG8_LDA(At, 1, 0); PG8_STAGE(PG8_SA(0, 1), a2 + hstep, voffA);
            PG8_WAIT_V(8); PG8_WAIT_L(0); PG8_BAR; PG8_MMA(0, 0, At, B0); PG8_MMA(0, 1, At, B1); PG8_BAR; PG8_SCHED;
            PG8_LDA(At, 1, 1); PG8_STAGE(PG8_SB(1, 0), b3, voffB); PG8_STAGE(PG8_SB(1, 1), b3 + hstep, voffB); PG8_STAGE(PG8_SA(1, 0), a3, voffA);
            PG8_WAIT_V(8); PG8_WAIT_L(0); PG8_BAR; PG8_MMA(1, 0, At, B0); PG8_MMA(1, 1, At, B1); PG8_BAR; PG8_SCHED;
            } else {
            PG8_LDB(B0, 0, 0); PG8_SCHED; PG8_LDA(At, 0, 0); PG8_STAGE(PG8_SA(1, 1), a1 + hstep, voffA);
            PG8_WAIT_L(8); PG8_BAR; PG8_WAIT_L(0); PG8_MMA(0, 0, At, B0); PG8_BAR; PG8_SCHED;
            PG8_LDB(B1, 0, 1); PG8_STAGE(PG8_SB(0, 0), b2, voffB);
            PG8_BAR; PG8_WAIT_L(0); PG8_MMA(0, 1, At, B1); PG8_BAR;
            PG8_LDA(At, 0, 1); PG8_STAGE(PG8_SA(0, 0), a2, voffA);
            PG8_BAR; PG8_WAIT_L(0); PG8_MMA(1, 0, At, B0); PG8_BAR; PG8_SCHED;
            PG8_STAGE(PG8_SB(0, 1), b2 + hstep, voffB);
            PG8_WAIT_V(6); PG8_BAR; PG8_MMA(1, 1, At, B1); PG8_BAR;
            PG8_LDB(B0, 1, 0); PG8_SCHED; PG8_LDA(At, 1, 0); PG8_STAGE(PG8_SA(0, 1), a2 + hstep, voffA);
            PG8_WAIT_L(8); PG8_BAR; PG8_WAIT_L(0); PG8_MMA(0, 0, At, B0); PG8_BAR; PG8_SCHED;
            PG8_LDB(B1, 1, 1); PG8_STAGE(PG8_SB(1, 0), b3, voffB);
            PG8_BAR; PG8_WAIT_L(0); PG8_MMA(0, 1, At, B1); PG8_BAR;
            PG8_LDA(At, 1, 1); PG8_STAGE(PG8_SA(1, 0), a3, voffA);
            PG8_BAR; PG8_WAIT_L(0); PG8_MMA(1, 0, At, B0); PG8_BAR; PG8_SCHED;
            PG8_STAGE(PG8_SB(1, 1), b3 + hstep, voffB);
            PG8_WAIT_V(6); PG8_BAR; PG8_MMA(1, 1, At, B1); PG8_BAR;
            }
        }
        if constexpr (ALIGN_EPI) { if (wr == 0) PG8_BAR; }
        if constexpr (!Epi::AFTER_DRAIN) { E(acc, cur, wr, wc, fr, fq); S.done(cur); }
        if (!has_next) break;
#pragma unroll
        for (int a = 0; a < 2; ++a)
#pragma unroll
            for (int b = 0; b < 2; ++b)
#pragma unroll
                for (int m = 0; m < 4; ++m)
#pragma unroll
                    for (int n = 0; n < 2; ++n) acc[a][b][m][n] = (f32x4){0.f, 0.f, 0.f, 0.f};
        cur = nxt; cA = nA; cB = nB; ++ui;
        if constexpr (ALIGN_EPI) { if (wr == 1) PG8_BAR; }
    }
    PG8_WAIT_V(0);
    if constexpr (!ALIGN_EPI) { if (wr == 0) PG8_BAR; }
    PG8_BAR;
    if constexpr (Epi::AFTER_DRAIN) { E.fused(acc, cur, wr, wc, fr, fq, lds, wid, lane); S.done(cur); }
#undef PG8_SA
#undef PG8_SB
#undef PG8_STAGE
#undef PG8_LDA
#undef PG8_LDB
#undef PG8_MMA
#undef PG8_WAIT_V
#undef PG8_WAIT_L
#undef PG8_BAR
#undef PG8_SCHED
}
}

constexpr int NWAVES = 8;
constexpr int NB = 4, SEQ = 8192, D = 1024, M = NB * SEQ, FF = 4096, NMEM = 256;
constexpr int ZE = 3328, ZO = 1280;
constexpr int ZQL = 0, ZCKV = 1024, ZQI = 1152, ZKI = 1664, ZWI = 1728, ZQB = 1792, ZKB = 2304, ZVB = 2816;
constexpr int OQ = 0, OKK = 1024, OVV = 1152;
constexpr int EVC = 2760;
constexpr int HCE = 1536, HCO = 1024;
constexpr float EPS = 1e-6f;
constexpr float LOG2E = 1.4426950408889634f;

constexpr size_t MiB = 1u << 20;
constexpr size_t WS_CTL = 0, CTL_ZERO_BYTES = 1 * MiB;
constexpr size_t WS_WGT = 1 * MiB;
constexpr size_t WO_WIN = 0, WO_WOUT = 6 * MiB + MiB / 2, WO_WQ = 9 * MiB + MiB / 2, WO_WKV = 10 * MiB, WO_WO = 11 * MiB, WO_W1 = 11 * MiB + MiB / 2, WO_W2 = 19 * MiB + MiB / 2;
constexpr size_t WS_MEMN = 33 * MiB, WS_KVM = 35 * MiB, WS_CKVN = 36 * MiB, WS_QX = 44 * MiB, WS_OX = 60 * MiB, WS_HC = 76 * MiB, WS_ZS = 172 * MiB;
constexpr size_t WS_Z = WS_ZS, WS_SCR = WS_ZS + 208 * MiB, WS_U = WS_ZS, WS_Y = WS_ZS + 272 * MiB, WS_END = WS_ZS + 336 * MiB;
static_assert(WS_END == 508 * MiB, "ws map");
constexpr size_t WS_RS = 29 * MiB;
constexpr size_t XB_OFF = 64 * MiB;
constexpr size_t WS_FT = WS_ZS;
constexpr int CW_BAR = 4096;

constexpr int RING_OFF = 0, RING_BYTES = 131072;
constexpr int LDSCTL_OFF = RING_BYTES, MISC_OFF = LDSCTL_OFF + 320;
constexpr int LDS_BYTES = 147456;

#define GAS __attribute__((address_space(1)))
#define LAS __attribute__((address_space(3)))
typedef unsigned short bf16;
typedef unsigned v4u __attribute__((ext_vector_type(4)));
typedef unsigned v2u __attribute__((ext_vector_type(2)));
typedef float f32x4 __attribute__((ext_vector_type(4)));
typedef GAS unsigned gu32;
#define RLX_AGENT __ATOMIC_RELAXED, __HIP_MEMORY_SCOPE_AGENT
#define LDS_WAIT() asm volatile("s_waitcnt lgkmcnt(0)" ::: "memory")
#define VM_WAIT() asm volatile("s_waitcnt vmcnt(0)" ::: "memory")
__device__ __forceinline__ unsigned f2bf(float f) { unsigned u = __builtin_bit_cast(unsigned, f); return (u + 0x7fffu + ((u >> 16) & 1u)) >> 16; }
__device__ __forceinline__ unsigned pk2(float lo, float hi) { return f2bf(lo) | (f2bf(hi) << 16); }
__device__ __forceinline__ float bflo(unsigned w) { return __builtin_bit_cast(float, w << 16); }
__device__ __forceinline__ float bfhi(unsigned w) { return __builtin_bit_cast(float, w & 0xffff0000u); }
__device__ __forceinline__ float bf2f(unsigned short u) { return __builtin_bit_cast(float, (unsigned)u << 16); }
__device__ __forceinline__ float wave_sum(float v) {
#pragma unroll
    for (int o = 1; o < 64; o <<= 1) v += __shfl_xor(v, o);
    return v;
}
__device__ __forceinline__ float wave_max(float v) {
#pragma unroll
    for (int o = 1; o < 64; o <<= 1) v = fmaxf(v, __shfl_xor(v, o));
    return v;
}
__device__ __forceinline__ int t5_bucket(int rel) {
    const int n = rel < 0 ? -rel : rel;
    const int b = n < 8 ? n : 8 + (n >= 15) + (n >= 27) + (n >= 50) + (n >= 91) + (n >= 166) + (n >= 305) + (n >= 559);
    return b + (rel > 0 ? 16 : 0);
}
#define XB_TMO      128
#define XB_XCNT(j)  (256  + 64 * (j))
#define XB_XSUB(j)  (1280 + 64 * (j))
#define XB_XGEN(j)  (2304 + 64 * (j))
#define XB_TOP      3328
#define XB_TOPGEN   3392
#define XCD_BAR_WORDS 3456
#define XB_SPIN_CAP (1u << 25)

__device__ __forceinline__ unsigned xb_ld(unsigned* p)              { return __hip_atomic_load(p, __ATOMIC_RELAXED, __HIP_MEMORY_SCOPE_AGENT); }
__device__ __forceinline__ unsigned xb_add(unsigned* p, unsigned v) { return __hip_atomic_fetch_add(p, v, __ATOMIC_RELAXED, __HIP_MEMORY_SCOPE_AGENT); }
__device__ __forceinline__ unsigned xb_xcc_id() { return (unsigned)__builtin_amdgcn_s_getreg((3 << 11) | 20) & 0xFu; }
#define XB_SPIN(cond, bar) do { unsigned _sp = 0; while (cond) { __builtin_amdgcn_s_sleep(1); \
    if ((++_sp & 255u) == 0u) { if (xb_ld(&(bar)[XB_TMO])) break; if (_sp > XB_SPIN_CAP) { atomicAdd(&(bar)[XB_TMO], 1u); break; } } } } while (0)

struct XcdBarrier {
    unsigned* bar; unsigned x;
    volatile LAS unsigned* st;
};

__device__ __forceinline__ XcdBarrier xcd_barrier_post(unsigned* bar, volatile LAS unsigned* st) {
    XcdBarrier b; b.bar = bar; b.x = xb_xcc_id(); b.st = st;
    if (threadIdx.x == 0) (void)xb_add(&bar[XB_XCNT(b.x)], 1u);
    return b;
}
__device__ __forceinline__ void xcd_barrier_complete(unsigned* bar, unsigned x, unsigned& nloc, unsigned& nx) {
    const unsigned G = gridDim.x * gridDim.y * gridDim.z;
    unsigned sum, cnt, mine, sp = 0u;
    for (;;) {
        sum = 0u; cnt = 0u; mine = 0u;
#pragma unroll
        for (unsigned j = 0; j < 16; ++j) { const unsigned c = xb_ld(&bar[XB_XCNT(j)]); sum += c; cnt += (c > 0u) ? 1u : 0u; mine = (j == x) ? c : mine; }
        if (sum == G) break;
        __builtin_amdgcn_s_sleep(1);
        if ((++sp & 255u) == 0u) { if (xb_ld(&bar[XB_TMO])) break; if (sp > XB_SPIN_CAP) { atomicAdd(&bar[XB_TMO], 1u); break; } }
    }
    nloc = mine > 0u ? mine : 1u; nx = cnt > 0u ? cnt : 1u;
}

__device__ __forceinline__ void xcd_barrier(const XcdBarrier& b) {
    asm volatile("s_waitcnt vmcnt(0)" ::: "memory");
    __syncthreads();
    if (threadIdx.x == 0) {
        unsigned* bar = b.bar;
        __builtin_amdgcn_s_waitcnt(0);
        unsigned nloc = b.st[0], nx = b.st[1];
        if (nloc == 0u) { xcd_barrier_complete(bar, b.x, nloc, nx); b.st[0] = nloc; b.st[1] = nx; }
        const unsigned old = xb_add(&bar[XB_XSUB(b.x)], 1u);
        const unsigned gen = old / nloc;
        if (old + 1u == (gen + 1u) * nloc) {
            __builtin_amdgcn_fence(__ATOMIC_RELEASE, "agent");
            asm volatile("s_waitcnt vmcnt(0)" ::: "memory");
            const unsigned og = xb_add(&bar[XB_TOP], 1u);
            const unsigned tg = og / nx;
            if (og + 1u == (tg + 1u) * nx) xb_add(&bar[XB_TOPGEN], 1u);
            else XB_SPIN(xb_ld(&bar[XB_TOPGEN]) == tg, bar);
            __builtin_amdgcn_fence(__ATOMIC_ACQUIRE, "agent");
            xb_add(&bar[XB_XGEN(b.x)], 1u);
            asm volatile("s_waitcnt vmcnt(0)" ::: "memory");
        } else {
            XB_SPIN(xb_ld(&bar[XB_XGEN(b.x)]) == gen, bar);
            __builtin_amdgcn_fence(__ATOMIC_ACQUIRE, "agent");
            asm volatile("s_waitcnt vmcnt(0)" ::: "memory");
        }
    }
    __syncthreads();
}
#ifndef PROBE_MASK
#define PROBE_MASK 0
#endif
#define REP(k) for (int rep_ = 0; rep_ < (((PROBE_MASK) >> (k)) & 1) + 1; ++rep_)

struct Frame {
    LAS unsigned char* lds;
    volatile LAS unsigned* MISC;
    int tid, lane, wave, vcu, G;
};
#define KIN(i) ((const float*)karg64_c<(i) * 8>())
#define KOUT() ((float*)karg64_c<160>())
#define KWS() ((unsigned char*)karg64_c<168>())
template <int OFF> __device__ __forceinline__ unsigned long long karg64_c() { unsigned long long p; asm volatile("s_load_dwordx2 %0, %1, %2\n\ts_waitcnt lgkmcnt(0)" : "=s"(p) : "s"(__builtin_amdgcn_kernarg_segment_ptr()), "n"(OFF)); return p; }
__device__ __forceinline__ bool refresh(Frame& F) { int t_ = threadIdx.x; asm volatile("" : "+v"(t_)); F.tid = t_; F.lane = t_ & 63; return true; }
enum { I_X = 0, I_MEM, I_TAB, I_NG, I_EWIN, I_EKVN, I_EUK, I_EUV, I_ELAM, I_ESUB, I_EWOUT, I_OWIN, I_OSINK, I_OWOUT, I_XWQ, I_XWKV, I_XWO, I_XMN, I_W1, I_W2 };

__device__ __forceinline__ void tr_item(const float* src, int spitch, int scol0, bf16* dst, int dpitch, int drow0, int dcol0, int nblk, LAS float* scr, int item, int lane, const float* gk = nullptr) {
    const int kb = item / nblk, nb = item % nblk, k0 = 64 * kb, n0 = 32 * nb;
#pragma unroll 8
    for (int i = 0; i < 32; ++i) { const int kk = 2 * i + (lane >> 5); scr[kk * 33 + (lane & 31)] = ((const GAS float*)src)[(size_t)(k0 + kk) * spitch + scol0 + n0 + (lane & 31)] * (gk ? ((const GAS float*)gk)[k0 + kk] : 1.f); }
    LDS_WAIT(); asm volatile("" ::: "memory");
    const int c = lane & 7;
#pragma unroll
    for (int j = 0; j < 4; ++j) { const int n = (lane >> 3) + 8 * j; const LAS float* s = scr + (8 * c) * 33 + n;
        v4u o; o.x = pk2(s[0 * 33], s[1 * 33]); o.y = pk2(s[2 * 33], s[3 * 33]); o.z = pk2(s[4 * 33], s[5 * 33]); o.w = pk2(s[6 * 33], s[7 * 33]);
        *(GAS v4u*)(dst + (size_t)(drow0 + n0 + n) * dpitch + dcol0 + k0 + 8 * c) = o; }
    LDS_WAIT(); asm volatile("" ::: "memory");
}
__device__ __forceinline__ void fuse_qlat_item(const float* win, const float* wuk, bf16* dst, int item, int lane, const float* gk) {
    const int h = item >> 6, k0 = (item & 63) * 16;
    float a0[16], a1[16];
#pragma unroll
    for (int k = 0; k < 16; ++k) { a0[k] = 0.f; a1[k] = 0.f; }
    for (int d = 0; d < 64; ++d) {
        const float u0 = ((const GAS float*)wuk)[(size_t)(h * 64 + d) * 128 + 2 * lane], u1 = ((const GAS float*)wuk)[(size_t)(h * 64 + d) * 128 + 2 * lane + 1];
#pragma unroll
        for (int k = 0; k < 16; ++k) { const float w = ((const GAS float*)win)[(size_t)(k0 + k) * EVC + h * 64 + d]; a0[k] += w * u0; a1[k] += w * u1; }
    }
#pragma unroll
    for (int k = 0; k < 16; ++k) { const float gg = ((const GAS float*)gk)[k0 + k]; a0[k] *= gg; a1[k] *= gg; }
    v4u o0, o1, p0, p1;
    o0.x = pk2(a0[0], a0[1]); o0.y = pk2(a0[2], a0[3]); o0.z = pk2(a0[4], a0[5]); o0.w = pk2(a0[6], a0[7]);
    o1.x = pk2(a0[8], a0[9]); o1.y = pk2(a0[10], a0[11]); o1.z = pk2(a0[12], a0[13]); o1.w = pk2(a0[14], a0[15]);
    p0.x = pk2(a1[0], a1[1]); p0.y = pk2(a1[2], a1[3]); p0.z = pk2(a1[4], a1[5]); p0.w = pk2(a1[6], a1[7]);
    p1.x = pk2(a1[8], a1[9]); p1.y = pk2(a1[10], a1[11]); p1.z = pk2(a1[12], a1[13]); p1.w = pk2(a1[14], a1[15]);
    GAS v4u* r0 = (GAS v4u*)(dst + (size_t)(h * 128 + 2 * lane) * 1024 + k0); GAS v4u* r1 = (GAS v4u*)(dst + (size_t)(h * 128 + 2 * lane + 1) * 1024 + k0);
    r0[0] = o0; r0[1] = o1; r1[0] = p0; r1[1] = p1;
}
__device__ __forceinline__ void fuse_ov_item(const float* wuv, const float* wout, bf16* dst, int item, int lane) {
    const int h = item >> 6, n0 = (item & 63) * 16;
    float a0[16], a1[16];
#pragma unroll
    for (int k = 0; k < 16; ++k) { a0[k] = 0.f; a1[k] = 0.f; }
    for (int d = 0; d < 64; ++d) {
        const float u0 = ((const GAS float*)wuv)[(size_t)(h * 128 + 2 * lane) * 64 + d], u1 = ((const GAS float*)wuv)[(size_t)(h * 128 + 2 * lane + 1) * 64 + d];
#pragma unroll
        for (int k = 0; k < 16; ++k) { const float w = ((const GAS float*)wout)[(size_t)(h * 64 + d) * 1024 + n0 + k]; a0[k] += w * u0; a1[k] += w * u1; }
    }
#pragma unroll
    for (int k = 0; k < 16; ++k) *(GAS unsigned*)(dst + (size_t)(n0 + k) * HCE + h * 128 + 2 * lane) = pk2(a0[k], a1[k]);
}
__device__ __forceinline__ void widx_item(const float* win, bf16* dst, int item, int lane, const float* gk) {
    const int k = item * 64 + lane; const float gg = ((const GAS float*)gk)[k];
    for (int n = 0; n < 64; ++n) { const float v = n < 8 ? ((const GAS float*)win)[(size_t)k * EVC + 1216 + n] * gg : 0.f; ((GAS bf16*)dst)[(size_t)(ZWI + n) * 1024 + k] = (bf16)f2bf(v); }
}

__device__ __forceinline__ void convert_weights(Frame& F, int l) {
    LAS float* scr = (LAS float*)(F.lds + RING_OFF + F.wave * 16384);
    const int gw = F.vcu * NWAVES + F.wave, NGW = F.G * NWAVES;
    bf16* WIN = (bf16*)(KWS() + WS_WGT + WO_WIN); bf16* WOUT = (bf16*)(KWS() + WS_WGT + WO_WOUT); bf16* WQ = (bf16*)(KWS() + WS_WGT + WO_WQ); bf16* WKV = (bf16*)(KWS() + WS_WGT + WO_WKV);
    bf16* WO = (bf16*)(KWS() + WS_WGT + WO_WO); bf16* W1 = (bf16*)(KWS() + WS_WGT + WO_W1); bf16* W2 = (bf16*)(KWS() + WS_WGT + WO_W2);
    const float* wq = KIN(I_XWQ) + (size_t)l * 1024 * 256; const float* wkv = KIN(I_XWKV) + (size_t)l * 1024 * 512; const float* wo = KIN(I_XWO) + (size_t)l * 256 * 1024;
    const float* w1 = KIN(I_W1) + (size_t)l * 1024 * 4096; const float* w2 = KIN(I_W2) + (size_t)l * 4096 * 1024;
    constexpr int N_Q = 16 * 8, N_KV = 16 * 16, N_O = 4 * 32, N_1 = 16 * 128, N_2 = 64 * 32;
    const float* g0 = KIN(I_NG) + (size_t)l * 6 * D; const float* g2 = g0 + 2 * D; const float* g4 = g0 + 4 * D;
    if ((l & 1) == 0) {
        const int e = l >> 1;
        const float* win = KIN(I_EWIN) + (size_t)e * 1024 * EVC; const float* wout = KIN(I_EWOUT) + (size_t)e * 1024 * 1024;
        const float* wuk = KIN(I_EUK) + (size_t)e * 8 * 64 * 128; const float* wuv = KIN(I_EUV) + (size_t)e * 8 * 128 * 64;
        constexpr int A0 = 512, A1 = 16 * 4, A2 = 16 * 16, A3 = 16 * 2, A4 = 16 * 48, A5 = 16, A6 = 512, A7 = 8 * 32;
        constexpr int TOT = A0 + A1 + A2 + A3 + A4 + A5 + A6 + A7 + N_Q + N_KV + N_O + N_1 + N_2;
        for (int it = gw; it < TOT; it += NGW) {
            int r = it;
            if (r < A0) { fuse_qlat_item(win, wuk, WIN, r, F.lane, g0); continue; } r -= A0;
            if (r < A1) { tr_item(win, EVC, 512, WIN, 1024, ZCKV, 0, 4, scr, r, F.lane, g0); continue; } r -= A1;
            if (r < A2) { tr_item(win, EVC, 640, WIN, 1024, ZQI, 0, 16, scr, r, F.lane, g0); continue; } r -= A2;
            if (r < A3) { tr_item(win, EVC, 1152, WIN, 1024, ZKI, 0, 2, scr, r, F.lane, g0); continue; } r -= A3;
            if (r < A4) { tr_item(win, EVC, 1224, WIN, 1024, ZQB, 0, 48, scr, r, F.lane, g0); continue; } r -= A4;
            if (r < A5) { widx_item(win, WIN, r, F.lane, g0); continue; } r -= A5;
            if (r < A6) { fuse_ov_item(wuv, wout, WOUT, r, F.lane); continue; } r -= A6;
            if (r < A7) { tr_item(wout + (size_t)512 * 1024, 1024, 0, WOUT, HCE, 0, 1024, 32, scr, r, F.lane); continue; } r -= A7;
            if (r < N_Q) { tr_item(wq, 256, 0, WQ, 1024, 0, 0, 8, scr, r, F.lane, g2); continue; } r -= N_Q;
            if (r < N_KV) { tr_item(wkv, 512, 0, WKV, 1024, 0, 0, 16, scr, r, F.lane); continue; } r -= N_KV;
            if (r < N_O) { tr_item(wo, 1024, 0, WO, 256, 0, 0, 32, scr, r, F.lane); continue; } r -= N_O;
            if (r < N_1) { tr_item(w1, 4096, 0, W1, 1024, 0, 0, 128, scr, r, F.lane, g4); continue; } r -= N_1;
            tr_item(w2, 1024, 0, W2, 4096, 0, 0, 32, scr, r, F.lane);
        }
    } else {
        const int o = l >> 1;
        const float* win = KIN(I_OWIN) + (size_t)o * 1024 * ZO; const float* wout = KIN(I_OWOUT) + (size_t)o * 1024 * 1024;
        constexpr int B0 = 16 * 40, B1 = 16 * 32;
        constexpr int TOT = B0 + B1 + N_Q + N_KV + N_O + N_1 + N_2;
        for (int it = gw; it < TOT; it += NGW) {
            int r = it;
            if (r < B0) { tr_item(win, ZO, 0, WIN, 1024, 0, 0, 40, scr, r, F.lane, g0); continue; } r -= B0;
            if (r < B1) { tr_item(wout, 1024, 0, WOUT, 1024, 0, 0, 32, scr, r, F.lane); continue; } r -= B1;
            if (r < N_Q) { tr_item(wq, 256, 0, WQ, 1024, 0, 0, 8, scr, r, F.lane, g2); continue; } r -= N_Q;
            if (r < N_KV) { tr_item(wkv, 512, 0, WKV, 1024, 0, 0, 16, scr, r, F.lane); continue; } r -= N_KV;
            if (r < N_O) { tr_item(wo, 1024, 0, WO, 256, 0, 0, 32, scr, r, F.lane); continue; } r -= N_O;
            if (r < N_1) { tr_item(w1, 4096, 0, W1, 1024, 0, 0, 128, scr, r, F.lane, g4); continue; } r -= N_1;
            tr_item(w2, 1024, 0, W2, 4096, 0, 0, 32, scr, r, F.lane);
        }
    }
}

__device__ __forceinline__ void row_first(int lane, const float* xin, float* xout, const float* g, bf16* h) {
    const GAS f32x4* xr = (const GAS f32x4*)xin + lane; f32x4 v[4]; float ss = 0.f;
#pragma unroll
    for (int j = 0; j < 4; ++j) { v[j] = xr[64 * j]; ss += (v[j].x * v[j].x + v[j].y * v[j].y) + (v[j].z * v[j].z + v[j].w * v[j].w); }
    const float r = 1.f / sqrtf(wave_sum(ss) * (1.f / 1024.f) + EPS);
    const GAS f32x4* gr = (const GAS f32x4*)g + lane; GAS v2u* ho = (GAS v2u*)h + lane;
#pragma unroll
    for (int j = 0; j < 4; ++j) {
        if (xout) ((GAS f32x4*)xout + lane)[64 * j] = v[j];
        const f32x4 gg = gr[64 * j]; v2u o; o.x = pk2(v[j].x * r * gg.x, v[j].y * r * gg.y); o.y = pk2(v[j].z * r * gg.z, v[j].w * r * gg.w); ho[64 * j] = o; }
}
__device__ __forceinline__ void row_mid(int lane, const bf16* y, float* x, const float* ga, const float* gb, bf16* h) {
    const GAS v2u* yr = (const GAS v2u*)y + lane; GAS f32x4* xr = (GAS f32x4*)x + lane; f32x4 yv[4], xv[4]; float ss = 0.f;
#pragma unroll
    for (int j = 0; j < 4; ++j) { const v2u w = yr[64 * j]; yv[j] = (f32x4){bflo(w.x), bfhi(w.x), bflo(w.y), bfhi(w.y)}; xv[j] = xr[64 * j];
        ss += (yv[j].x * yv[j].x + yv[j].y * yv[j].y) + (yv[j].z * yv[j].z + yv[j].w * yv[j].w); }
    const float r1 = 1.f / sqrtf(wave_sum(ss) * (1.f / 1024.f) + EPS);
    const GAS f32x4* gar = (const GAS f32x4*)ga + lane; float s2 = 0.f;
#pragma unroll
    for (int j = 0; j < 4; ++j) { const f32x4 gg = gar[64 * j]; xv[j].x += yv[j].x * r1 * gg.x; xv[j].y += yv[j].y * r1 * gg.y; xv[j].z += yv[j].z * r1 * gg.z; xv[j].w += yv[j].w * r1 * gg.w;
        xr[64 * j] = xv[j]; s2 += (xv[j].x * xv[j].x + xv[j].y * xv[j].y) + (xv[j].z * xv[j].z + xv[j].w * xv[j].w); }
    if (gb) {
        const float r2 = 1.f / sqrtf(wave_sum(s2) * (1.f / 1024.f) + EPS);
        const GAS f32x4* gbr = (const GAS f32x4*)gb + lane; GAS v2u* ho = (GAS v2u*)h + lane;
#pragma unroll
        for (int j = 0; j < 4; ++j) { const f32x4 gg = gbr[64 * j]; v2u o; o.x = pk2(xv[j].x * r2 * gg.x, xv[j].y * r2 * gg.y); o.y = pk2(xv[j].z * r2 * gg.z, xv[j].w * r2 * gg.w); ho[64 * j] = o; }
    }
}
__device__ __forceinline__ void thin_first(Frame& F) {
    const int gw = F.vcu * NWAVES + F.wave, NGW = F.G * NWAVES, lane = F.lane; bf16* xb = (bf16*)((unsigned char*)KOUT() + XB_OFF); float* rs = (float*)(KWS() + WS_RS);
    const float* xin = KIN(I_X);
    for (int m = gw; m < M; m += NGW) {
        const GAS f32x4* xr = (const GAS f32x4*)(xin + (size_t)m * D) + lane; f32x4 v[4]; float ss = 0.f;
#pragma unroll
        for (int j = 0; j < 4; ++j) { v[j] = xr[64 * j]; ss += (v[j].x * v[j].x + v[j].y * v[j].y) + (v[j].z * v[j].z + v[j].w * v[j].w); }
        const float r = 1.f / sqrtf(wave_sum(ss) * (1.f / 1024.f) + EPS);
        GAS v2u* xo = (GAS v2u*)(xb + (size_t)m * D) + lane;
#pragma unroll
        for (int j = 0; j < 4; ++j) { v2u o; o.x = pk2(v[j].x, v[j].y); o.y = pk2(v[j].z, v[j].w); xo[64 * j] = o; }
        if (lane == 0) ((GAS float*)rs)[m] = r;
    }
}
template <bool FINAL> __device__ __forceinline__ void thin_mid(Frame& F, const float* ga) {
    const int gw = F.vcu * NWAVES + F.wave, NGW = F.G * NWAVES, lane = F.lane; bf16* xb = (bf16*)((unsigned char*)KOUT() + XB_OFF); float* rs = (float*)(KWS() + WS_RS);
    const bf16* y = (const bf16*)(KWS() + WS_Y); float* outp = KOUT(); float* ft = (float*)(KWS() + WS_FT);
    f32x4 g4[4];
#pragma unroll
    for (int j = 0; j < 4; ++j) g4[j] = ((const GAS f32x4*)ga + lane)[64 * j];
    for (int m0 = gw; m0 < M; m0 += 2 * NGW) {
        v2u yw[2][4], xw[2][4];
#pragma unroll
        for (int a = 0; a < 2; ++a) { const int m = m0 + a * NGW;
#pragma unroll
            for (int j = 0; j < 4; ++j) { yw[a][j] = ((const GAS v2u*)(y + (size_t)m * D) + lane)[64 * j]; xw[a][j] = ((const GAS v2u*)(xb + (size_t)m * D) + lane)[64 * j]; } }
#pragma unroll
        for (int a = 0; a < 2; ++a) { const int m = m0 + a * NGW;
            f32x4 yv[4], xv[4]; float ss = 0.f;
#pragma unroll
            for (int j = 0; j < 4; ++j) { yv[j] = (f32x4){bflo(yw[a][j].x), bfhi(yw[a][j].x), bflo(yw[a][j].y), bfhi(yw[a][j].y)}; xv[j] = (f32x4){bflo(xw[a][j].x), bfhi(xw[a][j].x), bflo(xw[a][j].y), bfhi(xw[a][j].y)};
                ss += (yv[j].x * yv[j].x + yv[j].y * yv[j].y) + (yv[j].z * yv[j].z + yv[j].w * yv[j].w); }
            const float r1 = 1.f / sqrtf(wave_sum(ss) * (1.f / 1024.f) + EPS); float s2 = 0.f;
#pragma unroll
            for (int j = 0; j < 4; ++j) { xv[j].x += yv[j].x * r1 * g4[j].x; xv[j].y += yv[j].y * r1 * g4[j].y; xv[j].z += yv[j].z * r1 * g4[j].z; xv[j].w += yv[j].w * r1 * g4[j].w;
                s2 += (xv[j].x * xv[j].x + xv[j].y * xv[j].y) + (xv[j].z * xv[j].z + xv[j].w * xv[j].w); }
            if (FINAL) { GAS f32x4* fo = (GAS f32x4*)(m < M / 2 ? outp + (size_t)m * D : ft + (size_t)(m - M / 2) * D) + lane;
#pragma unroll
                for (int j = 0; j < 4; ++j) fo[64 * j] = xv[j];
            } else { GAS v2u* xo = (GAS v2u*)(xb + (size_t)m * D) + lane;
#pragma unroll
                for (int j = 0; j < 4; ++j) { v2u o; o.x = pk2(xv[j].x, xv[j].y); o.y = pk2(xv[j].z, xv[j].w); xo[64 * j] = o; }
                const float r2 = 1.f / sqrtf(wave_sum(s2) * (1.f / 1024.f) + EPS);
                if (lane == 0) ((GAS float*)rs)[m] = r2; }
        }
    }
}
__device__ __forceinline__ void final_copy(Frame& F) {
    const GAS f32x4* src = (const GAS f32x4*)(KWS() + WS_FT); GAS f32x4* dst = (GAS f32x4*)(KOUT() + (size_t)(M / 2) * D);
    const size_t n4 = (size_t)(M / 2) * D / 4, stride = (size_t)F.G * NWAVES * 64;
    for (size_t i = (size_t)(F.vcu * NWAVES + F.wave) * 64 + F.lane; i < n4; i += stride) dst[i] = src[i];
}
__device__ __forceinline__ void thin_memn(Frame& F, const float* g) {
    const int gw = F.vcu * NWAVES + F.wave, NGW = F.G * NWAVES; bf16* mn = (bf16*)(KWS() + WS_MEMN);
    for (int m = NGW - 1 - gw; m < NB * NMEM; m += NGW) row_first(F.lane, KIN(I_MEM) + (size_t)m * D, nullptr, g, mn + (size_t)m * D);
}
__device__ __forceinline__ void thin_ckvn(Frame& F, const float* akvn) {
    const int gw = F.vcu * NWAVES + F.wave, NGW = F.G * NWAVES; const bf16* z = (const bf16*)(KWS() + WS_Z); bf16* ck = (bf16*)(KWS() + WS_CKVN);
    const float g0 = ((const GAS float*)akvn)[2 * F.lane], g1 = ((const GAS float*)akvn)[2 * F.lane + 1];
    for (int m = gw; m < M; m += NGW) {
        const unsigned w = *((const GAS unsigned*)(z + (size_t)m * ZE + ZCKV) + F.lane); const float a = bflo(w), b = bfhi(w);
        const float r = 1.f / sqrtf(wave_sum(a * a + b * b) * (1.f / 128.f) + EPS);
        *((GAS unsigned*)(ck + (size_t)m * 128) + F.lane) = pk2(a * r * g0, b * r * g1);
    }
}

#define UNPK8(dst, off, VV) do { dst[(off) + 0] = bflo((VV).x); dst[(off) + 1] = bfhi((VV).x); dst[(off) + 2] = bflo((VV).y); dst[(off) + 3] = bfhi((VV).y); \
    dst[(off) + 4] = bflo((VV).z); dst[(off) + 5] = bfhi((VV).z); dst[(off) + 6] = bflo((VV).w); dst[(off) + 7] = bfhi((VV).w); } while (0)
#define DOT8(q, off, VV) ((q[(off) + 0] * bflo((VV).x) + q[(off) + 1] * bfhi((VV).x)) + (q[(off) + 2] * bflo((VV).y) + q[(off) + 3] * bfhi((VV).y)) + \
    (q[(off) + 4] * bflo((VV).z) + q[(off) + 5] * bfhi((VV).z)) + (q[(off) + 6] * bflo((VV).w) + q[(off) + 7] * bfhi((VV).w)))
#define AXPY8(acc, off, al, p, VV) do { acc[(off) + 0] = acc[(off) + 0] * (al) + (p) * bflo((VV).x); acc[(off) + 1] = acc[(off) + 1] * (al) + (p) * bfhi((VV).x); \
    acc[(off) + 2] = acc[(off) + 2] * (al) + (p) * bflo((VV).y); acc[(off) + 3] = acc[(off) + 3] * (al) + (p) * bfhi((VV).y); \
    acc[(off) + 4] = acc[(off) + 4] * (al) + (p) * bflo((VV).z); acc[(off) + 5] = acc[(off) + 5] * (al) + (p) * bfhi((VV).z); \
    acc[(off) + 6] = acc[(off) + 6] * (al) + (p) * bflo((VV).w); acc[(off) + 7] = acc[(off) + 7] * (al) + (p) * bfhi((VV).w); } while (0)

__device__ __forceinline__ void xattn_naive(Frame& F) {
    LAS v4u* Ks = (LAS v4u*)(F.lds); LAS v4u* Vs = (LAS v4u*)(F.lds + 32768);
    const bf16* kvm = (const bf16*)(KWS() + WS_KVM); const bf16* qx = (const bf16*)(KWS() + WS_QX); bf16* ox = (bf16*)(KWS() + WS_OX);
    for (int u = F.vcu; u < 256; u += F.G) {
        const int b = u >> 6, h = (u >> 4) & 3, blk = u & 15;
        __syncthreads();
        for (int i = F.tid; i < 2048; i += 512) { const int key = i >> 3, c = i & 7;
            const GAS v4u* src = (const GAS v4u*)(kvm + (size_t)(b * NMEM + key) * 512 + h * 64) + c; Ks[i] = src[0]; Vs[i] = src[32]; }
        __syncthreads();
        const size_t token = (size_t)b * SEQ + blk * 512 + F.tid;
        float q[64], acc[64];
        { const GAS v4u* qp = (const GAS v4u*)(qx + token * 256 + h * 64);
#pragma unroll
          for (int c = 0; c < 8; ++c) { const v4u w = qp[c]; UNPK8(q, 8 * c, w); } }
#pragma unroll
        for (int d = 0; d < 64; ++d) acc[d] = 0.f;
        float m = -1e30f, l = 0.f;
        for (int key = 0; key < NMEM; ++key) {
            float s = 0.f;
#pragma unroll
            for (int c = 0; c < 8; ++c) { const v4u w = Ks[key * 8 + c]; s += DOT8(q, 8 * c, w); }
            s *= 0.125f;
            const float mn = fmaxf(m, s), al = __expf(m - mn), p = __expf(s - mn); l = l * al + p; m = mn;
#pragma unroll
            for (int c = 0; c < 8; ++c) { const v4u w = Vs[key * 8 + c]; AXPY8(acc, 8 * c, al, p, w); }
        }
        const float inv = 1.f / l;
        GAS v4u* op = (GAS v4u*)(ox + token * 256 + h * 64);
#pragma unroll
        for (int c = 0; c < 8; ++c) { v4u o; o.x = pk2(acc[8 * c] * inv, acc[8 * c + 1] * inv); o.y = pk2(acc[8 * c + 2] * inv, acc[8 * c + 3] * inv);
            o.z = pk2(acc[8 * c + 4] * inv, acc[8 * c + 5] * inv); o.w = pk2(acc[8 * c + 6] * inv, acc[8 * c + 7] * inv); op[c] = o; }
    }
}

__device__ __forceinline__ void swa_naive(Frame& F, int o) {
    LAS v4u* Ks = (LAS v4u*)(F.lds); LAS v4u* Vs = (LAS v4u*)(F.lds + 24576); LAS float* lut = (LAS float*)(F.lds + 49152);
    const bf16* z = (const bf16*)(KWS() + WS_Z); bf16* hc = (bf16*)(KWS() + WS_HC);
    const float* tab = KIN(I_TAB); const float* sinks = KIN(I_OSINK) + o * 16;
    for (int u = F.vcu; u < NB * 128 * 2; u += F.G) {
        const int b = u >> 8, c = (u >> 1) & 127, kvh = u & 1;
        __syncthreads();
        const int jmin = c >= 2 ? 0 : (2 - c) * 64;
        for (int i = F.tid; i < 192 * 8; i += 512) { const int j = i >> 3, cc = i & 7;
            if (j >= jmin) { const size_t kt = (size_t)b * SEQ + (c - 2) * 64 + j;
                Ks[i] = *((const GAS v4u*)(z + kt * ZO + OKK + kvh * 64) + cc); Vs[i] = *((const GAS v4u*)(z + kt * ZO + OVV + kvh * 64) + cc); } }
        for (int i = F.tid; i < 8 * 256; i += 512) { const int g = i >> 8, r = i & 255; lut[i] = r < 255 ? ((const GAS float*)tab)[t5_bucket(r - 191) * 28 + 12 + kvh * 8 + g] : 0.f; }
        __syncthreads();
        const int g = F.wave, head = kvh * 8 + g, qi = F.lane;
        const size_t token = (size_t)b * SEQ + c * 64 + qi;
        float q[64], acc[64];
        { const GAS v4u* qp = (const GAS v4u*)(z + token * ZO + OQ + head * 64);
#pragma unroll
          for (int cc = 0; cc < 8; ++cc) { const v4u w = qp[cc]; UNPK8(q, 8 * cc, w); } }
#pragma unroll
        for (int d = 0; d < 64; ++d) acc[d] = 0.f;
        float m = ((const GAS float*)sinks)[head], l = 1.f;
        for (int j = jmin; j < 192; ++j) {
            float s = 0.f;
#pragma unroll
            for (int cc = 0; cc < 8; ++cc) { const v4u w = Ks[j * 8 + cc]; s += DOT8(q, 8 * cc, w); }
            s = s * 0.125f + lut[g * 256 + j + 63 - qi];
            const float mn = fmaxf(m, s), al = __expf(m - mn), p = __expf(s - mn); l = l * al + p; m = mn;
#pragma unroll
            for (int cc = 0; cc < 8; ++cc) { const v4u w = Vs[j * 8 + cc]; AXPY8(acc, 8 * cc, al, p, w); }
        }
        const float inv = 1.f / l;
        GAS v4u* op = (GAS v4u*)(hc + token * HCO + head * 64);
#pragma unroll
        for (int cc = 0; cc < 8; ++cc) { v4u ov; ov.x = pk2(acc[8 * cc] * inv, acc[8 * cc + 1] * inv); ov.y = pk2(acc[8 * cc + 2] * inv, acc[8 * cc + 3] * inv);
            ov.z = pk2(acc[8 * cc + 4] * inv, acc[8 * cc + 5] * inv); ov.w = pk2(acc[8 * cc + 6] * inv, acc[8 * cc + 7] * inv); op[cc] = ov; }
    }
}

constexpr int DLUT = 832, DLUT_OFF = 767;
__device__ __forceinline__ void diff_naive(Frame& F, int e, float lam_init) {
    LAS v4u* Ks = (LAS v4u*)(F.lds); LAS v4u* Vs = (LAS v4u*)(F.lds + 16384); LAS float* lut = (LAS float*)(F.lds + 32768); LAS float* xb = (LAS float*)(F.lds + 36864);
    LAS float* xs = (LAS float*)(F.lds + 36864 + 256 * 65 * 4);
    const bf16* z = (const bf16*)(KWS() + WS_Z); bf16* hc = (bf16*)(KWS() + WS_HC);
    const float* tab = KIN(I_TAB); const float* lamv = KIN(I_ELAM) + e * 256; const float* subln = KIN(I_ESUB) + e * 128;
    float lam;
    { const float a = ((const GAS float*)lamv)[F.lane] * ((const GAS float*)lamv)[64 + F.lane], b2 = ((const GAS float*)lamv)[128 + F.lane] * ((const GAS float*)lamv)[192 + F.lane];
      lam = __expf(wave_sum(a)) - __expf(wave_sum(b2)) + lam_init; }
    for (int u = F.vcu; u < NB * 4 * 64; u += F.G) {
        const int b = u >> 8, h = (u >> 6) & 3, qb = u & 63;
        const int mm = F.tid >> 8, half = (F.tid >> 7) & 1, qi = F.tid & 127, t = qb * 128 + qi, ct = t >> 6;
        const size_t token = (size_t)b * SEQ + t;
        __syncthreads();
        for (int i = F.tid; i < DLUT; i += 512) lut[i] = ((const GAS float*)tab)[t5_bucket(i - DLUT_OFF) * 28 + 8 + h];
        float acc[64]; v4u qpk[8];
        { const GAS v4u* qp = (const GAS v4u*)(z + token * ZE + ZQB + h * 128 + mm * 64);
#pragma unroll
          for (int c = 0; c < 8; ++c) qpk[c] = qp[c]; }
#pragma unroll
        for (int d = 0; d < 64; ++d) acc[d] = 0.f;
        float m = -1e30f, l = 0.f;
        const int ntile = 2 * qb + 2;
        for (int tile = 0; tile < ntile; ++tile) {
            __syncthreads();
            for (int i = F.tid; i < 1024; i += 512) { const int key = i >> 4, c = i & 15; const size_t kt = (size_t)b * SEQ + tile * 64 + key;
                Ks[i] = *((const GAS v4u*)(z + kt * ZE + ZKB + h * 128) + c); Vs[i] = *((const GAS v4u*)(z + kt * ZE + ZVB + h * 128) + c); }
            __syncthreads();
            if (tile <= ct) {
                for (int key = 0; key < 64; ++key) {
                    float s = 0.f;
#pragma unroll
                    for (int c = 0; c < 8; ++c) { const v4u w = Ks[key * 16 + mm * 8 + c]; float qq[8]; UNPK8(qq, 0, qpk[c]); s += DOT8(qq, 0, w); }
                    int rel = tile * 64 + key - t; rel = rel < -DLUT_OFF ? -DLUT_OFF : rel;
                    s = s * 0.125f + lut[rel + DLUT_OFF];
                    const float mn = fmaxf(m, s), al = __expf(m - mn), p = __expf(s - mn); l = l * al + p; m = mn;
#pragma unroll
                    for (int c = 0; c < 8; ++c) { const v4u w = Vs[key * 16 + half * 8 + c]; AXPY8(acc, 8 * c, al, p, w); }
                }
            }
        }
        const float inv = 1.f / l;
#pragma unroll
        for (int d = 0; d < 64; ++d) acc[d] *= inv;
        __syncthreads();
        if (mm == 1) {
#pragma unroll
            for (int d = 0; d < 64; ++d) xb[(half * 128 + qi) * 65 + d] = acc[d]; }
        __syncthreads();
        float ss = 0.f;
        if (mm == 0) {
#pragma unroll
            for (int d = 0; d < 64; ++d) { acc[d] -= lam * xb[(half * 128 + qi) * 65 + d]; ss += acc[d] * acc[d]; }
            xs[half * 128 + qi] = ss; }
        __syncthreads();
        if (mm == 0) {
            ss += xs[(half ^ 1) * 128 + qi];
            const float rr = (1.f / sqrtf(ss * (1.f / 128.f) + EPS)) * (1.f - lam_init);
            GAS v4u* op = (GAS v4u*)(hc + token * HCE + 1024 + h * 128 + half * 64);
#pragma unroll
            for (int c = 0; c < 8; ++c) { const GAS f32x4* sg = (const GAS f32x4*)(subln + half * 64 + 8 * c); const f32x4 g0 = sg[0], g1 = sg[1]; v4u ov;
                ov.x = pk2(acc[8 * c] * rr * g0.x, acc[8 * c + 1] * rr * g0.y); ov.y = pk2(acc[8 * c + 2] * rr * g0.z, acc[8 * c + 3] * rr * g0.w);
                ov.z = pk2(acc[8 * c + 4] * rr * g1.x, acc[8 * c + 5] * rr * g1.y); ov.w = pk2(acc[8 * c + 6] * rr * g1.z, acc[8 * c + 7] * rr * g1.w); op[c] = ov; }
        }
    }
}

typedef short bf16x8_t __attribute__((ext_vector_type(8)));
typedef float f32x16 __attribute__((ext_vector_type(16)));
typedef short v4i16_t __attribute__((ext_vector_type(4)));
constexpr int DK_STR = 272, DV_STR = 320, DSTG = 64 * DK_STR + 64 * DV_STR, D_LUTOFF = 2 * DSTG;
static_assert(D_LUTOFF + DLUT * 4 <= RING_BYTES, "diff LDS map");
__device__ __forceinline__ unsigned cvtpk(float lo, float hi) { unsigned r; asm("v_cvt_pk_bf16_f32 %0, %1, %2" : "=v"(r) : "v"(lo), "v"(hi)); return r; }
__device__ __forceinline__ bf16x8_t vtr8(const LAS unsigned char* p0, const LAS unsigned char* p1) {
    const v4i16_t a = __builtin_amdgcn_ds_read_tr16_b64_v4i16((LAS v4i16_t*)p0), b = __builtin_amdgcn_ds_read_tr16_b64_v4i16((LAS v4i16_t*)p1);
    return (bf16x8_t){a[0], a[1], a[2], a[3], b[0], b[1], b[2], b[3]};
}
__device__ __forceinline__ void diff_mfma(Frame& F, int e, float lam_init) {
    LAS unsigned char* L = F.lds; LAS float* lut = (LAS float*)(L + D_LUTOFF); LAS float* xbuf = (LAS float*)L;
    const bf16* z = (const bf16*)(KWS() + WS_Z); bf16* hc = (bf16*)(KWS() + WS_HC);
    const float* tab = KIN(I_TAB); const float* lamv = KIN(I_ELAM) + e * 256; const float* subln = KIN(I_ESUB) + e * 128;
    const int w = F.wave, lane = F.lane, r32 = lane & 31, hi = lane >> 5, mm = w >> 2, wq = w & 3;
    float lam;
    { const float a = ((const GAS float*)lamv)[lane] * ((const GAS float*)lamv)[64 + lane], b2 = ((const GAS float*)lamv)[128 + lane] * ((const GAS float*)lamv)[192 + lane];
      lam = __expf(wave_sum(a)) - __expf(wave_sum(b2)) + lam_init; }
    constexpr float C2 = 0.125f * LOG2E;
    const int bh = F.vcu >> 4, su = F.vcu & 15, b = bh >> 2, h = bh & 3;
#pragma unroll 1
    for (int rr = 0; rr < 4; ++rr) {
        const int qb = rr == 0 ? su : rr == 1 ? 31 - su : rr == 2 ? 32 + su : 63 - su;
        const int q0 = qb * 128 + wq * 32, cw = q0 >> 6, NT = 2 * qb + 2, tq = q0 + r32;
        __syncthreads();
        for (int i = F.tid; i < DLUT; i += 512) lut[i] = ((const GAS float*)tab)[t5_bucket(i - DLUT_OFF) * 28 + 8 + h] * LOG2E;
        bf16x8_t qf[4];
        { const bf16* qrow = z + ((size_t)b * SEQ + tq) * ZE + ZQB + h * 128 + mm * 64 + 8 * hi;
#pragma unroll
          for (int ks = 0; ks < 4; ++ks) qf[ks] = *(const GAS bf16x8_t*)(qrow + 16 * ks); }
        const int k0i = F.tid >> 4, c0 = F.tid & 15;
        const bf16* ksrc = z + ((size_t)b * SEQ + k0i) * ZE + ZKB + h * 128 + c0 * 8;
        const bf16* vsrc = z + ((size_t)b * SEQ + k0i) * ZE + ZVB + h * 128 + c0 * 8;
        const int kdst = k0i * DK_STR + c0 * 16, vdst = 64 * DK_STR + k0i * DV_STR + c0 * 16;
        v4u pk0, pk1, pv0, pv1;
        pk0 = *(const GAS v4u*)(ksrc); pk1 = *(const GAS v4u*)(ksrc + (size_t)32 * ZE); pv0 = *(const GAS v4u*)(vsrc); pv1 = *(const GAS v4u*)(vsrc + (size_t)32 * ZE);
        *(LAS v4u*)(L + kdst) = pk0; *(LAS v4u*)(L + kdst + 32 * DK_STR) = pk1; *(LAS v4u*)(L + vdst) = pv0; *(LAS v4u*)(L + vdst + 32 * DV_STR) = pv1;
        __syncthreads();
        f32x16 o[4];
#pragma unroll
        for (int i = 0; i < 4; ++i)
#pragma unroll
            for (int r = 0; r < 16; ++r) o[i][r] = 0.f;
        float m_run = -1e30f, l_run = 0.f;
        const int ka = r32 * DK_STR + (mm * 64 + 8 * hi) * 2;
        const int va = (4 * hi + ((lane & 15) >> 2)) * DV_STR + (16 * ((lane >> 4) & 1) + 4 * (lane & 3)) * 2;
#pragma unroll 1
        for (int t = 0; t < NT; ++t) {
            const int stg = (t & 1) * DSTG;
            if (t + 1 < NT) { const size_t off = (size_t)(t + 1) * 64 * ZE;
                pk0 = *(const GAS v4u*)(ksrc + off); pk1 = *(const GAS v4u*)(ksrc + off + (size_t)32 * ZE); pv0 = *(const GAS v4u*)(vsrc + off); pv1 = *(const GAS v4u*)(vsrc + off + (size_t)32 * ZE); }
            if (t <= cw) {
                const LAS unsigned char* Kb = L + stg + ka; const LAS unsigned char* Vb = L + stg + 64 * DK_STR + va;
                f32x16 s0, s1;
#pragma unroll
                for (int r = 0; r < 16; ++r) { s0[r] = 0.f; s1[r] = 0.f; }
#pragma unroll
                for (int ks = 0; ks < 4; ++ks) { const bf16x8_t a0 = *(const LAS bf16x8_t*)(Kb + ks * 32), a1 = *(const LAS bf16x8_t*)(Kb + 32 * DK_STR + ks * 32);
                    s0 = __builtin_amdgcn_mfma_f32_32x32x16_bf16(a0, qf[ks], s0, 0, 0, 0); s1 = __builtin_amdgcn_mfma_f32_32x32x16_bf16(a1, qf[ks], s1, 0, 0, 0); }
                if (64 * t + 622 > q0) {
                    const LAS float* lp = lut + (64 * t - tq + DLUT_OFF + 4 * hi);
#pragma unroll
                    for (int r = 0; r < 16; ++r) { const int ko = (r & 3) + 8 * (r >> 2); s0[r] = s0[r] * C2 + lp[ko]; s1[r] = s1[r] * C2 + lp[ko + 32]; }
                } else { const float bf = lut[0];
#pragma unroll
                    for (int r = 0; r < 16; ++r) { s0[r] = s0[r] * C2 + bf; s1[r] = s1[r] * C2 + bf; } }
                float mx = fmaxf(s0[0], s1[0]);
#pragma unroll
                for (int r = 1; r < 16; ++r) mx = fmaxf(mx, fmaxf(s0[r], s1[r]));
                mx = fmaxf(mx, __shfl_xor(mx, 32));
                if (__any(mx > m_run)) { const float mn = fmaxf(m_run, mx), al = __builtin_amdgcn_exp2f(m_run - mn); m_run = mn; l_run *= al;
#pragma unroll
                    for (int i = 0; i < 4; ++i)
#pragma unroll
                        for (int r = 0; r < 16; ++r) o[i][r] *= al; }
                float ps = 0.f;
#pragma unroll
                for (int r = 0; r < 16; ++r) { s0[r] = __builtin_amdgcn_exp2f(s0[r] - m_run); s1[r] = __builtin_amdgcn_exp2f(s1[r] - m_run); ps += s0[r] + s1[r]; }
                l_run += ps;
                bf16x8_t pf[4];
#pragma unroll
                for (int k2 = 0; k2 < 2; ++k2) {
                    v4u a; a.x = cvtpk(s0[8 * k2], s0[8 * k2 + 1]); a.y = cvtpk(s0[8 * k2 + 2], s0[8 * k2 + 3]); a.z = cvtpk(s0[8 * k2 + 4], s0[8 * k2 + 5]); a.w = cvtpk(s0[8 * k2 + 6], s0[8 * k2 + 7]);
                    v4u c; c.x = cvtpk(s1[8 * k2], s1[8 * k2 + 1]); c.y = cvtpk(s1[8 * k2 + 2], s1[8 * k2 + 3]); c.z = cvtpk(s1[8 * k2 + 4], s1[8 * k2 + 5]); c.w = cvtpk(s1[8 * k2 + 6], s1[8 * k2 + 7]);
                    pf[k2] = __builtin_bit_cast(bf16x8_t, a); pf[2 + k2] = __builtin_bit_cast(bf16x8_t, c); }
#pragma unroll
                for (int blk = 0; blk < 4; ++blk)
#pragma unroll
                    for (int kk = 0; kk < 4; ++kk) {
                        const LAS unsigned char* vp = Vb + kk * 16 * DV_STR + blk * 64;
                        const bf16x8_t vf = vtr8(vp, vp + 8 * DV_STR);
                        o[blk] = __builtin_amdgcn_mfma_f32_32x32x16_bf16(vf, pf[kk], o[blk], 0, 0, 0); }
            }
            if (t + 1 < NT) { const int s2 = ((t + 1) & 1) * DSTG;
                *(LAS v4u*)(L + s2 + kdst) = pk0; *(LAS v4u*)(L + s2 + kdst + 32 * DK_STR) = pk1; *(LAS v4u*)(L + s2 + vdst) = pv0; *(LAS v4u*)(L + s2 + vdst + 32 * DV_STR) = pv1; }
            __syncthreads();
        }
        const float linv = 1.f / (l_run + __shfl_xor(l_run, 32));
        if (mm == 1) {
#pragma unroll
            for (int blk = 0; blk < 4; ++blk)
#pragma unroll
                for (int r = 0; r < 16; ++r) xbuf[(wq * 64 + blk * 16 + r) * 64 + lane] = o[blk][r] * linv; }
        __syncthreads();
        if (mm == 0) {
            float ss = 0.f;
#pragma unroll
            for (int blk = 0; blk < 4; ++blk)
#pragma unroll
                for (int r = 0; r < 16; ++r) { const float d = o[blk][r] * linv - lam * xbuf[(wq * 64 + blk * 16 + r) * 64 + lane]; o[blk][r] = d; ss += d * d; }
            ss += __shfl_xor(ss, 32);
            const float rn = (1.f / sqrtf(ss * (1.f / 128.f) + EPS)) * (1.f - lam_init);
            bf16* orow = hc + ((size_t)b * SEQ + tq) * HCE + 1024 + h * 128 + 4 * hi;
#pragma unroll
            for (int blk = 0; blk < 4; ++blk)
#pragma unroll
                for (int a = 0; a < 4; ++a) { const f32x4 g = *(const GAS f32x4*)(subln + 32 * blk + 8 * a + 4 * hi); v2u ov;
                    ov.x = pk2(o[blk][4 * a] * rn * g.x, o[blk][4 * a + 1] * rn * g.y); ov.y = pk2(o[blk][4 * a + 2] * rn * g.z, o[blk][4 * a + 3] * rn * g.w);
                    *(GAS v2u*)(orow + 32 * blk + 8 * a) = ov; }
        }
    }
}

template <int NBLK, int KSTR, int VSTR, bool BIAS>
__device__ __forceinline__ void attn_step64(const LAS unsigned char* Kb, const LAS unsigned char* Vb, const bf16x8_t (&qf)[4], const LAS float* lp, f32x16 (&o)[NBLK], float& m_run, float& l_run) {
    constexpr float C2 = 0.125f * LOG2E;
    f32x16 s0, s1;
#pragma unroll
    for (int r = 0; r < 16; ++r) { s0[r] = 0.f; s1[r] = 0.f; }
#pragma unroll
    for (int ks = 0; ks < 4; ++ks) { const bf16x8_t a0 = *(const LAS bf16x8_t*)(Kb + ks * 32), a1 = *(const LAS bf16x8_t*)(Kb + 32 * KSTR + ks * 32);
        s0 = __builtin_amdgcn_mfma_f32_32x32x16_bf16(a0, qf[ks], s0, 0, 0, 0); s1 = __builtin_amdgcn_mfma_f32_32x32x16_bf16(a1, qf[ks], s1, 0, 0, 0); }
    if (BIAS) {
#pragma unroll
        for (int r = 0; r < 16; ++r) { const int ko = (r & 3) + 8 * (r >> 2); s0[r] = s0[r] * C2 + lp[ko]; s1[r] = s1[r] * C2 + lp[ko + 32]; }
    } else {
#pragma unroll
        for (int r = 0; r < 16; ++r) { s0[r] *= C2; s1[r] *= C2; } }
    float mx = fmaxf(s0[0], s1[0]);
#pragma unroll
    for (int r = 1; r < 16; ++r) mx = fmaxf(mx, fmaxf(s0[r], s1[r]));
    mx = fmaxf(mx, __shfl_xor(mx, 32));
    if (__any(mx > m_run)) { const float mn = fmaxf(m_run, mx), al = __builtin_amdgcn_exp2f(m_run - mn); m_run = mn; l_run *= al;
#pragma unroll
        for (int i = 0; i < NBLK; ++i)
#pragma unroll
            for (int r = 0; r < 16; ++r) o[i][r] *= al; }
    float ps = 0.f;
#pragma unroll
    for (int r = 0; r < 16; ++r) { s0[r] = __builtin_amdgcn_exp2f(s0[r] - m_run); s1[r] = __builtin_amdgcn_exp2f(s1[r] - m_run); ps += s0[r] + s1[r]; }
    l_run += ps;
    bf16x8_t pf[4];
#pragma unroll
    for (int k2 = 0; k2 < 2; ++k2) {
        v4u a; a.x = cvtpk(s0[8 * k2], s0[8 * k2 + 1]); a.y = cvtpk(s0[8 * k2 + 2], s0[8 * k2 + 3]); a.z = cvtpk(s0[8 * k2 + 4], s0[8 * k2 + 5]); a.w = cvtpk(s0[8 * k2 + 6], s0[8 * k2 + 7]);
        v4u c; c.x = cvtpk(s1[8 * k2], s1[8 * k2 + 1]); c.y = cvtpk(s1[8 * k2 + 2], s1[8 * k2 + 3]); c.z = cvtpk(s1[8 * k2 + 4], s1[8 * k2 + 5]); c.w = cvtpk(s1[8 * k2 + 6], s1[8 * k2 + 7]);
        pf[k2] = __builtin_bit_cast(bf16x8_t, a); pf[2 + k2] = __builtin_bit_cast(bf16x8_t, c); }
#pragma unroll
    for (int blk = 0; blk < NBLK; ++blk)
#pragma unroll
        for (int kk = 0; kk < 4; ++kk) { const LAS unsigned char* vp = Vb + kk * 16 * VSTR + blk * 64; const bf16x8_t vf = vtr8(vp, vp + 8 * VSTR);
            o[blk] = __builtin_amdgcn_mfma_f32_32x32x16_bf16(vf, pf[kk], o[blk], 0, 0, 0); }
}
constexpr int A_KSTR = 144, A_VSTR = 192;

__device__ __forceinline__ void xattn_mfma(Frame& F) {
    LAS unsigned char* L = F.lds; constexpr int KOFF = 0, VOFF = 256 * A_KSTR;
    const bf16* kvm = (const bf16*)(KWS() + WS_KVM); const bf16* qx = (const bf16*)(KWS() + WS_QX); bf16* ox = (bf16*)(KWS() + WS_OX);
    const int w = F.wave, lane = F.lane, r32 = lane & 31, hi = lane >> 5;
    for (int u = F.vcu; u < NB * 4 * 32; u += F.G) {
        const int b = u >> 7, h = (u >> 5) & 3, blk = u & 31;
        __syncthreads();
        for (int i = F.tid; i < 2048; i += 512) { const int key = i >> 3, c = i & 7;
            const GAS v4u* src = (const GAS v4u*)(kvm + (size_t)(b * NMEM + key) * 512 + h * 64) + c;
            *(LAS v4u*)(L + KOFF + key * A_KSTR + c * 16) = src[0]; *(LAS v4u*)(L + VOFF + key * A_VSTR + c * 16) = src[32]; }
        const size_t token = (size_t)b * SEQ + blk * 256 + w * 32 + r32;
        bf16x8_t qf[4];
#pragma unroll
        for (int ks = 0; ks < 4; ++ks) qf[ks] = *(const GAS bf16x8_t*)(qx + token * 256 + h * 64 + 16 * ks + 8 * hi);
        __syncthreads();
        f32x16 o[2];
#pragma unroll
        for (int i = 0; i < 2; ++i)
#pragma unroll
            for (int r = 0; r < 16; ++r) o[i][r] = 0.f;
        float m_run = -1e30f, l_run = 0.f;
        const LAS unsigned char* Kb = L + KOFF + r32 * A_KSTR + 16 * hi;
        const LAS unsigned char* Vb = L + VOFF + (4 * hi + ((lane & 15) >> 2)) * A_VSTR + (16 * ((lane >> 4) & 1) + 4 * (lane & 3)) * 2;
#pragma unroll 1
        for (int t = 0; t < 4; ++t) attn_step64<2, A_KSTR, A_VSTR, false>(Kb + t * 64 * A_KSTR, Vb + t * 64 * A_VSTR, qf, nullptr, o, m_run, l_run);
        const float inv = 1.f / (l_run + __shfl_xor(l_run, 32));
        bf16* orow = ox + token * 256 + h * 64 + 4 * hi;
#pragma unroll
        for (int bk = 0; bk < 2; ++bk)
#pragma unroll
            for (int a = 0; a < 4; ++a) { v2u ov; ov.x = pk2(o[bk][4 * a] * inv, o[bk][4 * a + 1] * inv); ov.y = pk2(o[bk][4 * a + 2] * inv, o[bk][4 * a + 3] * inv); *(GAS v2u*)(orow + 32 * bk + 8 * a) = ov; }
    }
}

__device__ __forceinline__ void swa_mfma(Frame& F, int oi) {
    LAS unsigned char* L = F.lds; constexpr int KOFF = 0, VOFF = 192 * A_KSTR, LOFF = VOFF + 192 * A_VSTR;
    LAS float* lut = (LAS float*)(L + LOFF);
    const bf16* z = (const bf16*)(KWS() + WS_Z); bf16* hc = (bf16*)(KWS() + WS_HC);
    const float* tab = KIN(I_TAB); const float* sinks = KIN(I_OSINK) + oi * 16;
    const int w = F.wave, lane = F.lane, r32 = lane & 31, hi = lane >> 5;
    for (int u = F.vcu; u < NB * 128 * 2; u += F.G) {
        const int b = u >> 8, c = (u >> 1) & 127, kvh = u & 1;
        __syncthreads();
        const int jmin = c >= 2 ? 0 : (2 - c) * 64;
        for (int i = F.tid; i < 192 * 8; i += 512) { const int j = i >> 3, cc = i & 7;
            if (j >= jmin) { const size_t kt = (size_t)b * SEQ + (c - 2) * 64 + j;
                *(LAS v4u*)(L + KOFF + j * A_KSTR + cc * 16) = *((const GAS v4u*)(z + kt * ZO + OKK + kvh * 64) + cc);
                *(LAS v4u*)(L + VOFF + j * A_VSTR + cc * 16) = *((const GAS v4u*)(z + kt * ZO + OVV + kvh * 64) + cc); } }
        for (int i = F.tid; i < 8 * 256; i += 512) { const int g = i >> 8, r = i & 255; lut[i] = r < 255 ? ((const GAS float*)tab)[t5_bucket(r - 191) * 28 + 12 + kvh * 8 + g] * LOG2E : 0.f; }
        __syncthreads();
        const int head = kvh * 8 + w;
        const float sk = ((const GAS float*)sinks)[head] * LOG2E;
#pragma unroll 1
        for (int qb2 = 0; qb2 < 2; ++qb2) {
            const int qi = qb2 * 32 + r32; const size_t token = (size_t)b * SEQ + c * 64 + qi;
            bf16x8_t qf[4];
#pragma unroll
            for (int ks = 0; ks < 4; ++ks) qf[ks] = *(const GAS bf16x8_t*)(z + token * ZO + OQ + head * 64 + 16 * ks + 8 * hi);
            f32x16 o[2];
#pragma unroll
            for (int i = 0; i < 2; ++i)
#pragma unroll
                for (int r = 0; r < 16; ++r) o[i][r] = 0.f;
            float m_run = sk, l_run = hi == 0 ? 1.f : 0.f;
            const LAS unsigned char* Kb = L + KOFF + r32 * A_KSTR + 16 * hi;
            const LAS unsigned char* Vb = L + VOFF + (4 * hi + ((lane & 15) >> 2)) * A_VSTR + (16 * ((lane >> 4) & 1) + 4 * (lane & 3)) * 2;
#pragma unroll 1
            for (int t = (c >= 2 ? 0 : 2 - c); t < 3; ++t)
                attn_step64<2, A_KSTR, A_VSTR, true>(Kb + t * 64 * A_KSTR, Vb + t * 64 * A_VSTR, qf, lut + w * 256 + 64 * t + 4 * hi + 63 - qi, o, m_run, l_run);
            const float inv = 1.f / (l_run + __shfl_xor(l_run, 32));
            bf16* orow = hc + token * HCO + head * 64 + 4 * hi;
#pragma unroll
            for (int bk = 0; bk < 2; ++bk)
#pragma unroll
                for (int a = 0; a < 4; ++a) { v2u ov; ov.x = pk2(o[bk][4 * a] * inv, o[bk][4 * a + 1] * inv); ov.y = pk2(o[bk][4 * a + 2] * inv, o[bk][4 * a + 3] * inv); *(GAS v2u*)(orow + 32 * bk + 8 * a) = ov; }
        }
    }
}

constexpr int TOPK = 256, CANDMAX = 512;
constexpr int DL_SEL = 0;
constexpr int DL_CNT = 16384;
constexpr int DL_WI2 = 16384 + 256;
constexpr int DL_W = 17408;
constexpr int DL_QI = DL_W;
constexpr int DL_WI = DL_W + 32768;
constexpr int DL_HIST = DL_W;
constexpr int DL_CAND = DL_W + 65536;
constexpr int DL_FB = 0;
constexpr int DL_QL = DL_W;
constexpr int DL_P = DL_W + 32768;
static_assert(DL_CAND + 8 * 704 * 8 <= RING_BYTES && DL_P + 65536 <= RING_BYTES, "DSA LDS map");

__device__ __forceinline__ unsigned fkey(float f) { const unsigned u = __builtin_bit_cast(unsigned, f); return (u & 0x80000000u) ? ~u : (u | 0x80000000u); }

__device__ __forceinline__ void indexer_naive(Frame& F, int b, int t0, int N, float* scr) {
    LAS float* qi = (LAS float*)(F.lds + DL_QI); LAS float* wi = (LAS float*)(F.lds + DL_WI);
    const bf16* z = (const bf16*)(KWS() + WS_Z);
    for (int i = F.tid; i < 16 * 64; i += 512) { const int q = i >> 6, c = i & 63;
        const v4u w = *((const GAS v4u*)(z + ((size_t)b * SEQ + t0 + q) * ZE + ZQI) + c); float v[8]; UNPK8(v, 0, w);
#pragma unroll
        for (int k = 0; k < 8; ++k) qi[q * 512 + c * 8 + k] = v[k]; }
    if (F.tid < 128) { const int q = F.tid >> 3, hh = F.tid & 7; wi[F.tid] = bf2f(((const GAS bf16*)z)[((size_t)b * SEQ + t0 + q) * ZE + ZWI + hh]); }
    __syncthreads();
    for (int s = F.tid; s < N; s += 512) {
        float k[64];
        { const GAS v4u* kp = (const GAS v4u*)(z + ((size_t)b * SEQ + s) * ZE + ZKI);
#pragma unroll
          for (int c = 0; c < 8; ++c) { const v4u w = kp[c]; UNPK8(k, 8 * c, w); } }
        for (int q = 0; q < 16; ++q) {
            float acc = 0.f;
#pragma unroll
            for (int hh = 0; hh < 8; ++hh) {
                const LAS f32x4* qp = (const LAS f32x4*)(qi + q * 512 + hh * 64); float dsum = 0.f;
#pragma unroll
                for (int c = 0; c < 16; ++c) { const f32x4 qq = qp[c]; dsum += (qq.x * k[4 * c] + qq.y * k[4 * c + 1]) + (qq.z * k[4 * c + 2] + qq.w * k[4 * c + 3]); }
                acc = fmaf(wi[q * 8 + hh], fmaxf(dsum, 0.f), acc);
            }
            ((GAS float*)scr)[(size_t)q * SEQ + s] = acc;
        }
    }
}

__device__ __forceinline__ void indexer_mfma(Frame& F, int b, int t0, int N, float* scr, LAS unsigned* hist16) {
    const int w = F.wave, lane = F.lane, n = lane & 31, hi = lane >> 5, g = w & 3, kp = w >> 2;
    const bf16* z = (const bf16*)(KWS() + WS_Z);
    bf16x8_t af[4];
    { const bf16* qrow = z + ((size_t)b * SEQ + t0 + 4 * g + (n >> 3)) * ZE + ZQI + (n & 7) * 64 + 8 * hi;
#pragma unroll
      for (int ks = 0; ks < 4; ++ks) af[ks] = *(const GAS bf16x8_t*)(qrow + 16 * ks); }
    float wv[16];
#pragma unroll
    for (int r = 0; r < 16; ++r) wv[r] = bf2f(((const GAS bf16*)z)[((size_t)b * SEQ + t0 + 4 * g + (r >> 2)) * ZE + ZWI + 4 * hi + (r & 3)]);
    const bf16* kbase = z + ((size_t)b * SEQ + n) * ZE + ZKI + 8 * hi;
    const int nsub = N >> 5;
    bf16x8_t bfr[4], bnx[4];
    int j = kp;
    if (j < nsub) {
#pragma unroll
        for (int ks = 0; ks < 4; ++ks) bfr[ks] = *(const GAS bf16x8_t*)(kbase + (size_t)(32 * j) * ZE + 16 * ks); }
    float* sbase = scr + (size_t)(4 * g + 2 * hi) * SEQ + n;
    LAS unsigned* hq = hist16 + (4 * g + 2 * hi) * 1024;
#pragma unroll 1
    for (; j < nsub; j += 2) {
        const int jn = j + 2;
        if (jn < nsub) {
#pragma unroll
            for (int ks = 0; ks < 4; ++ks) bnx[ks] = *(const GAS bf16x8_t*)(kbase + (size_t)(32 * jn) * ZE + 16 * ks); }
        f32x16 c;
#pragma unroll
        for (int r = 0; r < 16; ++r) c[r] = 0.f;
#pragma unroll
        for (int ks = 0; ks < 4; ++ks) c = __builtin_amdgcn_mfma_f32_32x32x16_bf16(af[ks], bfr[ks], c, 0, 0, 0);
        float tot[4];
#pragma unroll
        for (int qi = 0; qi < 4; ++qi) { float p = 0.f;
#pragma unroll
            for (int i = 0; i < 4; ++i) p = fmaf(wv[4 * qi + i], fmaxf(c[4 * qi + i], 0.f), p);
            tot[qi] = p + __shfl_xor(p, 32); }
        const float sa = hi ? tot[2] : tot[0], sb = hi ? tot[3] : tot[1];
        ((GAS float*)sbase)[32 * j] = sa; ((GAS float*)sbase)[32 * j + SEQ] = sb;
        { const unsigned ba = fkey(sa) >> 21, bb = fkey(sb) >> 21;
          __hip_atomic_fetch_add(hq + (ba >> 1), 1u << (16 * (ba & 1)), __ATOMIC_RELAXED, __HIP_MEMORY_SCOPE_WORKGROUP);
          __hip_atomic_fetch_add(hq + 1024 + (bb >> 1), 1u << (16 * (bb & 1)), __ATOMIC_RELAXED, __HIP_MEMORY_SCOPE_WORKGROUP); }
#pragma unroll
        for (int ks = 0; ks < 4; ++ks) bfr[ks] = bnx[ks];
    }
}

__device__ __forceinline__ void indexer_mfma2(Frame& F, int b, int t0, int N, float* scr, LAS unsigned* hist16) {
    const int w = F.wave, lane = F.lane, n = lane & 31, hi = lane >> 5;
    const bf16* z = (const bf16*)(KWS() + WS_Z);
    bf16x8_t af[4][4]; const LAS f32x4* wl = (const LAS f32x4*)(F.lds + DL_WI2) + hi;
#pragma unroll
    for (int g = 0; g < 4; ++g) {
        const bf16* qrow = z + ((size_t)b * SEQ + t0 + 4 * g + (n >> 3)) * ZE + ZQI + (n & 7) * 64 + 8 * hi;
#pragma unroll
        for (int ks = 0; ks < 4; ++ks) af[g][ks] = *(const GAS bf16x8_t*)(qrow + 16 * ks);
    }
    const bf16* kbase = z + ((size_t)b * SEQ + n) * ZE + ZKI + 8 * hi;
    const int nsub = N >> 5;
    bf16x8_t bfr[4], bnx[4];
    int j = w;
    if (j < nsub) {
#pragma unroll
        for (int ks = 0; ks < 4; ++ks) bfr[ks] = *(const GAS bf16x8_t*)(kbase + (size_t)(32 * j) * ZE + 16 * ks); }
    float* sbase = scr + (size_t)(2 * hi) * SEQ + n;
    LAS unsigned* hq = hist16 + (2 * hi) * 1024;
#pragma unroll 1
    for (; j < nsub; j += 8) {
        const int jn = j + 8;
        if (jn < nsub) {
#pragma unroll
            for (int ks = 0; ks < 4; ++ks) bnx[ks] = *(const GAS bf16x8_t*)(kbase + (size_t)(32 * jn) * ZE + 16 * ks); }
#pragma unroll
        for (int g = 0; g < 4; ++g) {
            f32x16 c;
#pragma unroll
            for (int r = 0; r < 16; ++r) c[r] = 0.f;
#pragma unroll
            for (int ks = 0; ks < 4; ++ks) c = __builtin_amdgcn_mfma_f32_32x32x16_bf16(af[g][ks], bfr[ks], c, 0, 0, 0);
            float tot[4];
#pragma unroll
            for (int qi = 0; qi < 4; ++qi) { float p = 0.f; const f32x4 wq4 = wl[(4 * g + qi) * 2];
                p = fmaf(wq4.x, fmaxf(c[4 * qi], 0.f), p); p = fmaf(wq4.y, fmaxf(c[4 * qi + 1], 0.f), p);
                p = fmaf(wq4.z, fmaxf(c[4 * qi + 2], 0.f), p); p = fmaf(wq4.w, fmaxf(c[4 * qi + 3], 0.f), p);
                tot[qi] = p + __shfl_xor(p, 32); }
            const float sa = hi ? tot[2] : tot[0], sb = hi ? tot[3] : tot[1];
            ((GAS float*)sbase)[(size_t)(4 * g) * SEQ + 32 * j] = sa; ((GAS float*)sbase)[(size_t)(4 * g + 1) * SEQ + 32 * j] = sb;
            { const unsigned ba = fkey(sa) >> 21, bb = fkey(sb) >> 21;
              __hip_atomic_fetch_add(hq + (4 * g) * 1024 + (ba >> 1), 1u << (16 * (ba & 1)), __ATOMIC_RELAXED, __HIP_MEMORY_SCOPE_WORKGROUP);
              __hip_atomic_fetch_add(hq + (4 * g + 1) * 1024 + (bb >> 1), 1u << (16 * (bb & 1)), __ATOMIC_RELAXED, __HIP_MEMORY_SCOPE_WORKGROUP); }
        }
#pragma unroll
        for (int ks = 0; ks < 4; ++ks) bfr[ks] = bnx[ks];
    }
}

__device__ __forceinline__ int find_bin(LAS unsigned* hist, int lane, unsigned target, unsigned& above) {
    unsigned ls = 0;
#pragma unroll 8
    for (int j = 0; j < 32; ++j) ls += hist[32 * lane + j];
    unsigned suf = ls;
#pragma unroll
    for (int o = 1; o < 64; o <<= 1) { const unsigned t = __shfl_down(suf, o); if (lane + o < 64) suf += t; }
    const unsigned long long mk = __ballot(suf >= target);
    const int L = 63 - __builtin_clzll(mk);
    unsigned cum = __shfl(suf, L) - __shfl(ls, L);
    int bsel = 32 * L;
    for (int j = 31; j >= 0; --j) { const unsigned c = hist[32 * L + j]; if (cum + c >= target) { bsel = 32 * L + j; break; } cum += c; }
    above = cum; return bsel;
}

__device__ __forceinline__ int select_topk(const float* row, int N, LAS int* sel, LAS unsigned* hist, LAS unsigned long long* cand, int lane) {
    if (N <= TOPK) { for (int i = lane; i < N; i += 64) sel[i] = i; LDS_WAIT(); return N; }
    const GAS float* r = (const GAS float*)row;
    const unsigned long long lt = (1ull << lane) - 1ull;
    for (int i = lane; i < 2048; i += 64) hist[i] = 0u;
    LDS_WAIT();
    for (int i = lane; i < N; i += 64) { const unsigned u = fkey(r[i]); __hip_atomic_fetch_add(hist + (u >> 21), 1u, __ATOMIC_RELAXED, __HIP_MEMORY_SCOPE_WORKGROUP); }
    LDS_WAIT();
    unsigned above; const unsigned b0 = (unsigned)find_bin(hist, lane, TOPK, above);
    unsigned need = TOPK - above;
    unsigned nsel = 0, nc = 0;
    for (int i0 = 0; i0 < N; i0 += 64) { const int i = i0 + lane; const unsigned u = fkey(r[i]); const unsigned bin = u >> 21;
        const bool ab = bin > b0, eq = bin == b0; const unsigned long long ma = __ballot(ab), me = __ballot(eq);
        { const unsigned pa = nsel + __builtin_popcountll(ma & lt); if (ab && pa < TOPK) sel[pa] = i; }
        const unsigned pe = nc + __builtin_popcountll(me & lt);
        if (eq && pe < CANDMAX) cand[pe] = ((unsigned long long)u << 32) | (unsigned)i;
        nsel += __builtin_popcountll(ma); nc += __builtin_popcountll(me); }
    LDS_WAIT();
    if (nc <= CANDMAX) {
        for (unsigned ci = lane; ci < nc; ci += 64) { const unsigned long long me = cand[ci]; const unsigned ui = (unsigned)(me >> 32), ii = (unsigned)me; unsigned rank = 0;
            for (unsigned j = 0; j < nc; ++j) { const unsigned long long o = cand[j]; const unsigned uj = (unsigned)(o >> 32), ij = (unsigned)o; rank += (uj > ui || (uj == ui && ij < ii)) ? 1u : 0u; }
            if (rank < need && above + rank < TOPK) sel[above + rank] = (int)ii; }
    } else {
        for (int i = lane; i < 2048; i += 64) hist[i] = 0u;
        LDS_WAIT();
        for (int i = lane; i < N; i += 64) { const unsigned u = fkey(r[i]); if ((u >> 21) == b0) __hip_atomic_fetch_add(hist + ((u >> 10) & 0x7ffu), 1u, __ATOMIC_RELAXED, __HIP_MEMORY_SCOPE_WORKGROUP); }
        LDS_WAIT();
        unsigned ab1; const unsigned b1 = (unsigned)find_bin(hist, lane, need, ab1); const unsigned need1 = need - ab1;
        const unsigned pre = (b0 << 11) | b1;
        for (int i = lane; i < 2048; i += 64) hist[i] = 0u;
        LDS_WAIT();
        for (int i = lane; i < N; i += 64) { const unsigned u = fkey(r[i]); if ((u >> 10) == pre) __hip_atomic_fetch_add(hist + (u & 0x3ffu), 1u, __ATOMIC_RELAXED, __HIP_MEMORY_SCOPE_WORKGROUP); }
        LDS_WAIT();
        unsigned ab2; const unsigned b2 = (unsigned)find_bin(hist, lane, need1, ab2); const unsigned need2 = need1 - ab2;
        const unsigned ustar = (pre << 10) | b2;
        unsigned pos = above, neq = 0;
        for (int i0 = 0; i0 < N; i0 += 64) { const int i = i0 + lane; const unsigned u = fkey(r[i]); const bool inb = (u >> 21) == b0;
            const bool gt = inb && u > ustar, eq = inb && u == ustar; const unsigned long long mg = __ballot(gt), me = __ballot(eq);
            const unsigned re = neq + __builtin_popcountll(me & lt);
            const bool take_eq = eq && re < need2; const unsigned long long mt = __ballot(take_eq);
            const unsigned long long mall = mg | mt;
            { const unsigned pp = pos + __builtin_popcountll(mall & lt); if ((gt || take_eq) && pp < TOPK) sel[pp] = i; }
            pos += __builtin_popcountll(mall); neq += __builtin_popcountll(me); }
    }
    LDS_WAIT();
    return TOPK;
}

__device__ __forceinline__ int find_bin16(const LAS unsigned* h16, int lane, unsigned target, unsigned& above) {
    unsigned ls = 0;
#pragma unroll
    for (int j = 0; j < 16; ++j) { const unsigned wv = h16[16 * lane + j]; ls += (wv & 0xffffu) + (wv >> 16); }
    unsigned suf = ls;
#pragma unroll
    for (int o = 1; o < 64; o <<= 1) { const unsigned t = __shfl_down(suf, o); if (lane + o < 64) suf += t; }
    const unsigned long long mk = __ballot(suf >= target);
    const int L = mk ? 63 - __builtin_clzll(mk) : 0;
    unsigned cum = __shfl(suf, L) - __shfl(ls, L);
    int bsel = 32 * L;
    for (int j = 31; j >= 0; --j) { const unsigned wv = h16[16 * L + (j >> 1)]; const unsigned c = (j & 1) ? (wv >> 16) : (wv & 0xffffu); if (cum + c >= target) { bsel = 32 * L + j; break; } cum += c; }
    above = cum; return bsel;
}
__device__ __forceinline__ unsigned lane_prefix(unsigned long long m) { return __builtin_amdgcn_mbcnt_hi((unsigned)(m >> 32), __builtin_amdgcn_mbcnt_lo((unsigned)m, 0u)); }
constexpr int LISTMAX = 704;
__device__ __forceinline__ int select_topk2(const float* row, int N, LAS int* sel, LAS unsigned* h16, LAS unsigned long long* cand, int lane) {
    if (N <= TOPK) { for (int i = lane; i < N; i += 64) sel[i] = i; LDS_WAIT(); return N; }
    const GAS float* r = (const GAS float*)row;
    const unsigned long long lt = (1ull << lane) - 1ull;
    unsigned above; const unsigned b0 = (unsigned)find_bin16(h16, lane, TOPK, above);
    const unsigned need = TOPK - above;
    unsigned nl = 0;
    float v[16], vn[16];
#pragma unroll
    for (int k = 0; k < 16; ++k) { const int i = 64 * k + lane; v[k] = i < N ? r[i] : -INFINITY; }
#pragma unroll 1
    for (int i0 = 0; i0 < N; i0 += 1024) {
        if (i0 + 1024 < N) {
#pragma unroll
            for (int k = 0; k < 16; ++k) { const int i = i0 + 1024 + 64 * k + lane; vn[k] = i < N ? r[i] : -INFINITY; } }
#pragma unroll
        for (int k = 0; k < 16; ++k) { const unsigned u = fkey(v[k]); const bool ge = (u >> 21) >= b0; const unsigned long long mg = __ballot(ge);
            const unsigned pp = nl + lane_prefix(mg);
            if (ge && pp < LISTMAX) cand[pp] = ((unsigned long long)u << 32) | (unsigned)(i0 + 64 * k + lane);
            nl += __builtin_popcountll(mg); }
#pragma unroll
        for (int k = 0; k < 16; ++k) v[k] = vn[k];
    }
    LDS_WAIT();
    if (nl <= LISTMAX) {
        unsigned cu[11], cidx[11];
#pragma unroll
        for (int k = 0; k < 11; ++k) { const unsigned ci = lane + 64 * k; const unsigned long long me = ci < nl ? cand[ci] : 0ull; cu[k] = (unsigned)(me >> 32); cidx[k] = (unsigned)me; }
        unsigned ustar = b0 << 21;
#pragma unroll 1
        for (int bit = 20; bit >= 0; --bit) { const unsigned trial = ustar | (1u << bit); unsigned c = 0;
#pragma unroll
            for (int k = 0; k < 11; ++k) c += __builtin_popcountll(__ballot(cu[k] >= trial));
            if (c >= TOPK) ustar = trial; }
        unsigned cgt = 0;
#pragma unroll
        for (int k = 0; k < 11; ++k) cgt += __builtin_popcountll(__ballot(cu[k] > ustar));
        const unsigned need_eq = TOPK - cgt;
        unsigned pos = 0, neq = 0;
#pragma unroll
        for (int k = 0; k < 11; ++k) { const bool gt = cu[k] > ustar, eq = cu[k] == ustar;
            const unsigned long long me = __ballot(eq); const unsigned re = neq + lane_prefix(me); const bool take = gt || (eq && re < need_eq);
            const unsigned long long mt = __ballot(take); const unsigned pp = pos + lane_prefix(mt);
            if (take && pp < TOPK) sel[pp] = (int)cidx[k];
            pos += __builtin_popcountll(mt); neq += __builtin_popcountll(me); }
    } else {
        { unsigned ns = 0;
          for (int i0 = 0; i0 < N; i0 += 64) { const int i = i0 + lane; const bool ab = (fkey(r[i]) >> 21) > b0; const unsigned long long ma = __ballot(ab);
              const unsigned pa = ns + lane_prefix(ma); if (ab && pa < TOPK) sel[pa] = i; ns += __builtin_popcountll(ma); } }
        for (int i = lane; i < 1024; i += 64) h16[i] = 0u;
        LDS_WAIT();
        for (int i = lane; i < N; i += 64) { const unsigned u = fkey(r[i]); if ((u >> 21) == b0) { const unsigned bb = (u >> 10) & 0x7ffu; __hip_atomic_fetch_add(h16 + (bb >> 1), 1u << (16 * (bb & 1)), __ATOMIC_RELAXED, __HIP_MEMORY_SCOPE_WORKGROUP); } }
        LDS_WAIT();
        unsigned ab1; const unsigned b1 = (unsigned)find_bin16(h16, lane, need, ab1); const unsigned need1 = need - ab1;
        const unsigned pre = (b0 << 11) | b1;
        for (int i = lane; i < 1024; i += 64) h16[i] = 0u;
        LDS_WAIT();
        for (int i = lane; i < N; i += 64) { const unsigned u = fkey(r[i]); if ((u >> 10) == pre) { const unsigned bb = u & 0x3ffu; __hip_atomic_fetch_add(h16 + (bb >> 1), 1u << (16 * (bb & 1)), __ATOMIC_RELAXED, __HIP_MEMORY_SCOPE_WORKGROUP); } }
        LDS_WAIT();
        unsigned ab2; const unsigned b2 = (unsigned)find_bin16(h16, lane, need1, ab2); const unsigned need2 = need1 - ab2;
        const unsigned ustar = (pre << 10) | b2;
        unsigned pos = above, neq = 0;
        for (int i0 = 0; i0 < N; i0 += 64) { const int i = i0 + lane; const unsigned u = fkey(r[i]); const bool inb = (u >> 21) == b0;
            const bool gt = inb && u > ustar, eq = inb && u == ustar; const unsigned long long mg = __ballot(gt), me = __ballot(eq);
            const unsigned re = neq + __builtin_popcountll(me & lt);
            const bool take_eq = eq && re < need2; const unsigned long long mt = __ballot(take_eq);
            const unsigned long long mall = mg | mt;
            { const unsigned pp = pos + __builtin_popcountll(mall & lt); if ((gt || take_eq) && pp < TOPK) sel[pp] = i; }
            pos += __builtin_popcountll(mall); neq += __builtin_popcountll(me); }
    }
    LDS_WAIT();
    return TOPK;
}

__device__ __forceinline__ void sparse_naive(Frame& F, int b, int t, const LAS int* sel, int cnt, LAS float* qlw, LAS float* Pw, int lane) {
    const bf16* z = (const bf16*)(KWS() + WS_Z); const bf16* ck = (const bf16*)(KWS() + WS_CKVN) + (size_t)b * SEQ * 128; bf16* hc = (bf16*)(KWS() + WS_HC);
    const float* tab = KIN(I_TAB);
    const size_t token = (size_t)b * SEQ + t;
    { const GAS v4u* qp = (const GAS v4u*)(z + token * ZE + ZQL) + 2 * lane; const v4u w0 = qp[0], w1 = qp[1]; float v[16]; UNPK8(v, 0, w0); UNPK8(v, 8, w1);
#pragma unroll
      for (int k = 0; k < 16; ++k) qlw[16 * lane + k] = v[k]; }
    LDS_WAIT();
    float s[4][8];
#pragma unroll
    for (int kk = 0; kk < 4; ++kk) {
        const int j = lane + 64 * kk; const bool valid = j < cnt; const int key = valid ? sel[j] : 0;
        float acc[8];
#pragma unroll
        for (int hh = 0; hh < 8; ++hh) acc[hh] = 0.f;
        const GAS v4u* cp = (const GAS v4u*)(ck + (size_t)key * 128);
        for (int ch = 0; ch < 16; ++ch) { const v4u w = cp[ch]; float c8[8]; UNPK8(c8, 0, w);
#pragma unroll
            for (int hh = 0; hh < 8; ++hh) { const LAS f32x4* qq = (const LAS f32x4*)(qlw + hh * 128 + ch * 8); const f32x4 a = qq[0], bq = qq[1];
                acc[hh] += (a.x * c8[0] + a.y * c8[1]) + (a.z * c8[2] + a.w * c8[3]) + (bq.x * c8[4] + bq.y * c8[5]) + (bq.z * c8[6] + bq.w * c8[7]); } }
        const int bk = t5_bucket(key - t);
#pragma unroll
        for (int hh = 0; hh < 8; ++hh) s[kk][hh] = valid ? acc[hh] * 0.125f + ((const GAS float*)tab)[bk * 28 + hh] : -1e30f;
    }
#pragma unroll
    for (int hh = 0; hh < 8; ++hh) {
        const float mx = wave_max(fmaxf(fmaxf(s[0][hh], s[1][hh]), fmaxf(s[2][hh], s[3][hh])));
        float p[4], sum = 0.f;
#pragma unroll
        for (int kk = 0; kk < 4; ++kk) { p[kk] = __expf(s[kk][hh] - mx); sum += p[kk]; }
        const float inv = 1.f / wave_sum(sum);
#pragma unroll
        for (int kk = 0; kk < 4; ++kk) Pw[(lane + 64 * kk) * 8 + hh] = p[kk] * inv;
    }
    LDS_WAIT();
    float o0[8], o1[8];
#pragma unroll
    for (int hh = 0; hh < 8; ++hh) { o0[hh] = 0.f; o1[hh] = 0.f; }
    for (int j = 0; j < cnt; ++j) {
        const int key = sel[j]; const unsigned w = *((const GAS unsigned*)(ck + (size_t)key * 128) + lane); const float c0 = bflo(w), c1 = bfhi(w);
        const LAS f32x4* pp = (const LAS f32x4*)(Pw + j * 8); const f32x4 pa = pp[0], pb = pp[1];
        o0[0] += pa.x * c0; o1[0] += pa.x * c1; o0[1] += pa.y * c0; o1[1] += pa.y * c1; o0[2] += pa.z * c0; o1[2] += pa.z * c1; o0[3] += pa.w * c0; o1[3] += pa.w * c1;
        o0[4] += pb.x * c0; o1[4] += pb.x * c1; o0[5] += pb.y * c0; o1[5] += pb.y * c1; o0[6] += pb.z * c0; o1[6] += pb.z * c1; o0[7] += pb.w * c0; o1[7] += pb.w * c1;
    }
#pragma unroll
    for (int hh = 0; hh < 8; ++hh) *((GAS unsigned*)(hc + token * HCE + hh * 128) + lane) = pk2(o0[hh], o1[hh]);
    LDS_WAIT();
}

constexpr int DL_IMG = DL_W, IMG_STR = 288, IMG_BYTES = 32 * IMG_STR, DL_TABA = DL_W + 8 * IMG_BYTES;
static_assert(DL_TABA + 1024 <= RING_BYTES, "sparse LDS map");
__device__ __forceinline__ void sparse_mfma(Frame& F, int b, int t, LAS int* sel, int cnt, LAS unsigned char* img, const LAS float* tabA, int lane) {
    const bf16* z = (const bf16*)(KWS() + WS_Z); const bf16* ck = (const bf16*)(KWS() + WS_CKVN) + (size_t)b * SEQ * 128; bf16* hc = (bf16*)(KWS() + WS_HC);
    const int hd = lane & 15, g = lane >> 4; const size_t token = (size_t)b * SEQ + t;
    constexpr float C2A = 0.125f * LOG2E;
    bf16x8_t qf[4];
#pragma unroll
    for (int ks = 0; ks < 4; ++ks) { qf[ks] = *(const GAS bf16x8_t*)(z + token * ZE + ZQL + (hd & 7) * 128 + 32 * ks + 8 * g); if (hd >= 8) qf[ks] = (bf16x8_t){0, 0, 0, 0, 0, 0, 0, 0}; }
    f32x4 o[8];
#pragma unroll
    for (int mt = 0; mt < 8; ++mt) o[mt] = (f32x4){0.f, 0.f, 0.f, 0.f};
    float m_run = -1e30f, l_run = 0.f;
    v4u gb[8], gc[8];
    const int nblk = cnt >> 5;
    for (int jj = lane; jj < cnt; jj += 64) { const int key = sel[jj]; sel[jj] = key | (t5_bucket(key - t) << 16); }
    LDS_WAIT();
    const GAS unsigned char* ckb = (const GAS unsigned char*)ck;
#pragma unroll
    for (int k = 0; k < 8; ++k) { const unsigned key = sel[4 * k + g] & 0xffff; gb[k] = *(const GAS v4u*)(ckb + ((key << 8) + (hd << 4))); }
#pragma unroll
    for (int k = 0; k < 8; ++k) { const unsigned key = sel[32 + 4 * k + g] & 0xffff; gc[k] = *(const GAS v4u*)(ckb + ((key << 8) + (hd << 4))); }
#pragma unroll 1
    for (int blk = 0; blk < nblk; ++blk) {
#pragma unroll
        for (int k = 0; k < 8; ++k) *(LAS v4u*)(img + (4 * k + g) * IMG_STR + hd * 16) = gb[k];
#pragma unroll
        for (int k = 0; k < 8; ++k) gb[k] = gc[k];
        if (blk + 2 < nblk) {
#pragma unroll
            for (int k = 0; k < 8; ++k) { const unsigned key = sel[(blk + 2) * 32 + 4 * k + g] & 0xffff; gc[k] = *(const GAS v4u*)(ckb + ((key << 8) + (hd << 4))); } }
        f32x4 s[2];
#pragma unroll
        for (int tau = 0; tau < 2; ++tau) { s[tau] = (f32x4){0.f, 0.f, 0.f, 0.f};
#pragma unroll
            for (int ks = 0; ks < 4; ++ks) { const bf16x8_t a = *(const LAS bf16x8_t*)(img + (16 * tau + hd) * IMG_STR + (32 * ks + 8 * g) * 2);
                s[tau] = __builtin_amdgcn_mfma_f32_16x16x32_bf16(a, qf[ks], s[tau], 0, 0, 0); } }
        float x[8]; float mx = -1e30f;
#pragma unroll
        for (int tau = 0; tau < 2; ++tau)
#pragma unroll
            for (int i = 0; i < 4; ++i) { const int bk = sel[blk * 32 + 16 * tau + 4 * g + i] >> 16;
                x[4 * tau + i] = s[tau][i] * C2A + tabA[bk * 8 + (hd & 7)]; mx = fmaxf(mx, x[4 * tau + i]); }
        mx = fmaxf(mx, __shfl_xor(mx, 16)); mx = fmaxf(mx, __shfl_xor(mx, 32));
        if (__any(mx > m_run)) { const float mn = fmaxf(m_run, mx), al = __builtin_amdgcn_exp2f(m_run - mn); m_run = mn; l_run *= al;
#pragma unroll
            for (int mt = 0; mt < 8; ++mt) o[mt] *= al; }
        float ps = 0.f;
#pragma unroll
        for (int i = 0; i < 8; ++i) { x[i] = __builtin_amdgcn_exp2f(x[i] - m_run); ps += x[i]; }
        l_run += ps;
        v4u pw; pw.x = cvtpk(x[0], x[1]); pw.y = cvtpk(x[2], x[3]); pw.z = cvtpk(x[4], x[5]); pw.w = cvtpk(x[6], x[7]);
        const bf16x8_t pf = __builtin_bit_cast(bf16x8_t, pw);
        const LAS unsigned char* vb = img + (4 * g + (hd >> 2)) * IMG_STR + (4 * (hd & 3)) * 2;
#pragma unroll
        for (int mt = 0; mt < 8; ++mt) { const bf16x8_t vf = vtr8(vb + mt * 32, vb + mt * 32 + 16 * IMG_STR); o[mt] = __builtin_amdgcn_mfma_f32_16x16x32_bf16(vf, pf, o[mt], 0, 0, 0); }
    }
    float l = l_run; l += __shfl_xor(l, 16); l += __shfl_xor(l, 32);
    const float inv = 1.f / l;
    if (hd < 8) {
        bf16* orow = hc + token * HCE + hd * 128 + 4 * g;
#pragma unroll
        for (int mt = 0; mt < 8; ++mt) { v2u ov; ov.x = pk2(o[mt][0] * inv, o[mt][1] * inv); ov.y = pk2(o[mt][2] * inv, o[mt][3] * inv); *(GAS v2u*)(orow + 16 * mt) = ov; }
    }
    LDS_WAIT();
}

__device__ __forceinline__ void dsa_phase(Frame& F) {
    float* scr = (float*)(KWS() + WS_SCR) + (size_t)blockIdx.x * 16 * SEQ;
    LAS int* selA = (LAS int*)(F.lds + DL_SEL); LAS int* cntA = (LAS int*)(F.lds + DL_CNT);
    const int NU = NB * 128 * 4;
    for (int ui = F.vcu; ui < NU; ui += F.G) {
        const int rr = ui / F.G, v = ui % F.G;
        const int b = (v * NB) / F.G, j = v % (F.G / NB);
        const int half = rr >> 2, sub = rr & 3;
        const int c = (F.G / NB == 64) ? (half == 0 ? j : 127 - j) : 0;
        const int t0 = c * 64 + sub * 16, N = 64 * (c + 1);
        __syncthreads();
        for (int i = F.tid; i < 16 * 1024; i += 512) ((LAS unsigned*)(F.lds + DL_HIST))[i] = 0u;
        if (F.tid < 128) ((LAS float*)(F.lds + DL_WI2))[F.tid] = bf2f(((const GAS bf16*)(KWS() + WS_Z))[((size_t)b * SEQ + t0 + (F.tid >> 3)) * ZE + ZWI + (F.tid & 7)]);
        __syncthreads();
        indexer_mfma2(F, b, t0, N, scr, (LAS unsigned*)(F.lds + DL_HIST));
        VM_WAIT(); __syncthreads();
#pragma unroll 1
        REP(6) for (int r2 = 0; r2 < 2; ++r2) { const int q = F.wave + 8 * r2;
            const int cnt = select_topk2(scr + (size_t)q * SEQ, N, selA + q * 256, (LAS unsigned*)(F.lds + DL_HIST) + q * 1024, (LAS unsigned long long*)(F.lds + DL_CAND) + F.wave * LISTMAX, F.lane);
            if (F.lane == 0) cntA[q] = cnt; }
        __syncthreads();
        if (F.tid < 256) ((LAS float*)(F.lds + DL_TABA))[F.tid] = ((const GAS float*)KIN(I_TAB))[(F.tid >> 3) * 28 + (F.tid & 7)] * LOG2E;
        __syncthreads();
#pragma unroll 1
        REP(7) for (int r2 = 0; r2 < 2; ++r2) { const int q = F.wave + 8 * r2;
            sparse_mfma(F, b, t0 + q, selA + q * 256, cntA[q], F.lds + DL_IMG + F.wave * IMG_BYTES, (const LAS float*)(F.lds + DL_TABA), F.lane); }
    }
}

#ifndef MK_MULTI
#define MK_MULTI 0
#endif
constexpr int N_PHASES = 1 + 2 * (4 + 8) + 2 * (3 + 8) + 1;
struct Args { const float* in[20]; float* out; unsigned char* ws; int ph_lo, ph_hi; };
static_assert(sizeof(Args) == 22 * 8 + 8, "Args has no padding");

#define XBP ((unsigned char*)KOUT() + XB_OFF)
#define RSP ((const float*)(KWS() + WS_RS))
#define GEMM_CALL(ACTV, Aptr, Bptr, Mv, Nv, Kv, Optr, LDC, CID, RS_) do { \
    pg8::Gemm g_{(const pg8::bf16_t*)(Aptr), (const pg8::bf16_t*)(Bptr), (Mv), (Nv), (Kv)}; pg8::StaticOrder S_; S_.init((Mv), (Nv), F.G, (CID)); \
    pg8::EpiAct<ACTV> E_{(pg8::bf16_t*)(Optr), (LDC), (RS_)}; \
    pg8::gemm_phase<pg8::EpiAct<ACTV>, pg8::StaticOrder, true, true>(F.lds + RING_OFF, g_, S_, E_); } while (0)

__global__ void __launch_bounds__(NWAVES * 64, 2) mk_fwd(Args args) {
    extern __shared__ __attribute__((aligned(16))) unsigned char lds[];
    Frame F;
    F.lds = (LAS unsigned char*)lds;
    F.MISC = (volatile LAS unsigned*)(F.lds + MISC_OFF);
    F.tid = threadIdx.x; F.lane = F.tid & 63; F.wave = __builtin_amdgcn_readfirstlane(F.tid >> 6);
    F.G = gridDim.x; { const int bx = blockIdx.x; F.vcu = (F.G % 8 == 0) ? (bx % 8) * (F.G / 8) + bx / 8 : bx; }
    for (int u = F.tid; u < (LDS_BYTES - LDSCTL_OFF) / 4; u += NWAVES * 64) ((LAS unsigned*)(F.lds + LDSCTL_OFF))[u] = 0u;
    __syncthreads();
#if MK_MULTI
    XcdBarrier bar; bar.bar = (unsigned*)(((gu32*)KWS()) + CW_BAR); bar.x = 0; bar.st = nullptr;
#else
    XcdBarrier bar = xcd_barrier_post((unsigned*)(((gu32*)KWS()) + CW_BAR), F.MISC + 8);
#endif
    const int lo = args.ph_lo, hi = args.ph_hi;
    int pid = 0;
#define PH_ON (pid >= lo && pid < hi && refresh(F))
#if MK_MULTI
#define PH_END do { ++pid; } while (0)
#else
#define PH_END do { if (pid >= lo && pid + 1 < hi) xcd_barrier(bar); ++pid; } while (0)
#endif

    if (PH_ON) { convert_weights(F, 0); thin_first(F); }
    PH_END;

#pragma unroll 1
    for (int l = 0; l < 4; ++l) {
        const float* g = KIN(I_NG) + (size_t)l * 6 * D;
        if ((l & 1) == 0) {
            const int e = l >> 1; const float lam_init = e == 0 ? 0.20000000000000007f : 0.4707130183435842f;
            if (PH_ON) { REP(0) GEMM_CALL(0, XBP, KWS() + WS_WGT + WO_WIN, M, ZE, D, KWS() + WS_Z, ZE, (int)blockIdx.x, RSP); }
            PH_END;
            if (PH_ON) { REP(5) thin_ckvn(F, KIN(I_EKVN) + e * 128); }
            PH_END;
            if (PH_ON) { REP(1) diff_mfma(F, e, lam_init); REP(2) dsa_phase(F); }
            PH_END;
            if (PH_ON) { REP(0) GEMM_CALL(0, KWS() + WS_HC, KWS() + WS_WGT + WO_WOUT, M, D, HCE, KWS() + WS_Y, D, (int)blockIdx.x, nullptr); }
            PH_END;
        } else {
            const int o = l >> 1;
            if (PH_ON) { REP(0) GEMM_CALL(0, XBP, KWS() + WS_WGT + WO_WIN, M, ZO, D, KWS() + WS_Z, ZO, (int)blockIdx.x, RSP); }
            PH_END;
            if (PH_ON) { REP(3) swa_mfma(F, o); }
            PH_END;
            if (PH_ON) { REP(0) GEMM_CALL(0, KWS() + WS_HC, KWS() + WS_WGT + WO_WOUT, M, D, HCO, KWS() + WS_Y, D, (int)blockIdx.x, nullptr); }
            PH_END;
        }
        if (PH_ON) { thin_mid<false>(F, g + 1 * D); thin_memn(F, KIN(I_XMN) + (size_t)l * D); }
        PH_END;
        if (PH_ON) { REP(0) GEMM_CALL(0, XBP, KWS() + WS_WGT + WO_WQ, M, 256, D, KWS() + WS_QX, 256, (int)blockIdx.x, RSP); REP(0) GEMM_CALL(0, KWS() + WS_MEMN, KWS() + WS_WGT + WO_WKV, NB * NMEM, 512, D, KWS() + WS_KVM, 512, (int)((blockIdx.x + 128) % F.G), nullptr); }
        PH_END;
        if (PH_ON) { REP(3) xattn_mfma(F); }
        PH_END;
        if (PH_ON) { REP(0) GEMM_CALL(0, KWS() + WS_OX, KWS() + WS_WGT + WO_WO, M, D, 256, KWS() + WS_Y, D, (int)blockIdx.x, nullptr); }
        PH_END;
        if (PH_ON) { thin_mid<false>(F, g + 3 * D); }
        PH_END;
        if (PH_ON) { REP(0) GEMM_CALL(2, XBP, KWS() + WS_WGT + WO_W1, M, FF, D, KWS() + WS_U, FF, (int)blockIdx.x, RSP); }
        PH_END;
        if (PH_ON) { REP(0) GEMM_CALL(0, KWS() + WS_U, KWS() + WS_WGT + WO_W2, M, D, FF, KWS() + WS_Y, D, (int)blockIdx.x, nullptr); }
        PH_END;
        if (PH_ON) { if (l < 3) { thin_mid<false>(F, g + 5 * D); REP(4) convert_weights(F, l + 1); } else thin_mid<true>(F, g + 5 * D); }
        PH_END;
    }
    if (PH_ON) { final_copy(F); }
    PH_END;
}

extern "C" void kernel_launch(void* const* d_in, const int* in_sizes, int n_in, void* d_out, int out_size, void* d_ws, size_t ws_size, hipStream_t stream) {
    static int grid = 0;
    if (grid == 0) {
        if (n_in != 20 || out_size != M * D || ws_size < WS_END) { fprintf(stderr, "kernel_launch: unexpected shapes: n_in %d out %d ws %zu (need %zu)\n", n_in, out_size, ws_size, (size_t)WS_END); grid = -1; return; }
        int dev = 0, cus = 0, per_cu = 0;
        if (hipGetDevice(&dev) != hipSuccess || hipDeviceGetAttribute(&cus, hipDeviceAttributeMultiprocessorCount, dev) != hipSuccess) { grid = -1; return; }
        if (hipFuncSetAttribute((const void*)mk_fwd, hipFuncAttributeMaxDynamicSharedMemorySize, LDS_BYTES) != hipSuccess) { fprintf(stderr, "kernel_launch: hipFuncSetAttribute failed\n"); grid = -1; return; }
        if (hipOccupancyMaxActiveBlocksPerMultiprocessor(&per_cu, (const void*)mk_fwd, NWAVES * 64, LDS_BYTES) != hipSuccess || per_cu < 1)
            fprintf(stderr, "kernel_launch: note: occupancy query reports %d workgroups per CU\n", per_cu);
        (void)hipGetLastError();
        grid = cus;
        if (grid != 256) { fprintf(stderr, "kernel_launch: built for 256 CUs, device has %d\n", cus); grid = -1; return; }
    }
    if (grid < 0) return;
    if (hipMemsetAsync((char*)d_ws + WS_CTL, 0, CTL_ZERO_BYTES, stream) != hipSuccess) return;
    Args a{};
    for (int i = 0; i < 20; ++i) a.in[i] = (const float*)d_in[i];
    a.out = (float*)d_out; a.ws = (unsigned char*)d_ws;
#if MK_MULTI
    for (int p = 0; p < N_PHASES; ++p) { a.ph_lo = p; a.ph_hi = p + 1; hipLaunchKernelGGL(mk_fwd, dim3(grid), dim3(NWAVES * 64), LDS_BYTES, stream, a); }
#else
    a.ph_lo = 0; a.ph_hi = N_PHASES; hipLaunchKernelGGL(mk_fwd, dim3(grid), dim3(NWAVES * 64), LDS_BYTES, stream, a);
#endif
}
```

```cpp
#include <hip/hip_runtime.h>
#include <cstdio>
#include <cstdint>
namespace pg8 {
#define PG8_LAS __attribute__((address_space(3)))
typedef unsigned short bf16_t;
typedef short bf16x8 __attribute__((ext_vector_type(8)));
typedef float f32x4 __attribute__((ext_vector_type(4)));
typedef unsigned u32x4 __attribute__((ext_vector_type(4)));
constexpr int BM = 256, BK = 64, HALF = 128, HTB = HALF * BK * 2  , STAGE_BYTES = 8 * HTB, NXCD = 8, WGM = 8;

__host__ __device__ __forceinline__ int lds_byte(int r, int c) { const int st = (r >> 4) * 2 + (c >> 5), rr = r & 15, cc = c & 31, ob = rr * 64 + cc * 2; return st * 1024 + (ob ^ (((ob >> 9) & 1) << 5)); }
__host__ __device__ __forceinline__ void stage_rc(int b, int& R, int& C) { const int st = b / 1024, sb = b % 1024, swz = sb ^ (((sb >> 9) & 1) << 5); R = (st >> 1) * 16 + swz / 64; C = (st & 1) * 32 + (swz % 64) / 2; }
__host__ __device__ __forceinline__ int perm32(int rho) { const int n = rho >> 4, i = rho & 15; return 8 * (i >> 2) + 4 * n + (i & 3); }

struct Unit { int pm, pn; };
struct Gemm { const bf16_t* A; const bf16_t* Bt; int M, N, K; };

struct StaticOrder {
    int nM, nN, nwg, G, c;
    __host__ __device__ void init(int M, int N, int G_, int c_) { nM = M / BM; nN = N / BM; nwg = nM * nN; G = G_; c = c_; }
    __host__ __device__ bool next(int i, Unit& u) const {
        const long L = (long)i * G + c; if (L >= nwg) return false;
        int wgid = (int)L; { const int q = nwg / NXCD, r = nwg % NXCD, xcd = wgid % NXCD, off = wgid / NXCD; wgid = (xcd < r ? xcd * (q + 1) : r * (q + 1) + (xcd - r) * q) + off; }
        const int nig = WGM * nN, gid = wgid / nig, fm = gid * WGM, gsz = (nM - fm) < WGM ? (nM - fm) : WGM;
        u.pm = fm + ((wgid % nig) % gsz); u.pn = (wgid % nig) / gsz; return true;
    }
    __device__ __forceinline__ void a_ready(const Unit&) const {}
    __device__ __forceinline__ void done(const Unit&) const {}
};


__device__ __forceinline__ unsigned cvt_pk_bf16(float lo, float hi) { unsigned r; asm volatile("v_cvt_pk_bf16_f32 %0, %1, %2" : "=v"(r) : "v"(lo), "v"(hi)); return r; }
template <int ACT  > struct EpiAct {
    static constexpr bool PERM = true, AFTER_DRAIN = false;
    bf16_t* O; int ldc; const float* rs;
    __device__ __forceinline__ void operator()(const f32x4 (&acc)[2][2][4][2], const Unit& u, int wr, int wc, int fr, int fq) const {
        const int row0 = u.pm * BM + wr * 64 + fr; const int col0 = u.pn * BM + wc * 32 + 8 * fq;
#pragma unroll
        for (int ai = 0; ai < 2; ++ai)
#pragma unroll
            for (int m = 0; m < 4; ++m) { bf16_t* rowp = O + (size_t)(row0 + ai * HALF + m * 16) * ldc + col0; const float rsc = rs ? rs[row0 + ai * HALF + m * 16] : 1.f;
#pragma unroll
                for (int bj = 0; bj < 2; ++bj) { f32x4 v0 = acc[ai][bj][m][0] * rsc, v1 = acc[ai][bj][m][1] * rsc;
                    if (ACT == 2) {
#pragma unroll
                        for (int i = 0; i < 4; ++i) { float a = v0[i] > 0.f ? v0[i] : 0.f; v0[i] = a * a; float b = v1[i] > 0.f ? v1[i] : 0.f; v1[i] = b * b; }
                    }
                    u32x4 w; w.x = cvt_pk_bf16(v0[0], v0[1]); w.y = cvt_pk_bf16(v0[2], v0[3]); w.z = cvt_pk_bf16(v1[0], v1[1]); w.w = cvt_pk_bf16(v1[2], v1[3]);
                    *(u32x4*)(rowp + bj * HALF) = w; } }
    }
};
template <class Epi, class Sched, bool ALIGN_EPI = false, bool SP2 = false>
__device__ __forceinline__ void gemm_phase(PG8_LAS unsigned char* lds, const Gemm g, const Sched& S, const Epi& E, int tid_in) {
    int tid_ = tid_in; asm volatile("" : "+v"(tid_)); const int tid = tid_, wid = __builtin_amdgcn_readfirstlane(tid >> 6), lane = tid & 63, wr = wid >> 2, wc = wid & 3, fr = lane & 15, fq = lane >> 4;
    const int K = g.K, nt = K / BK;
    unsigned voffA[2], voffB[2];
#pragma unroll
    for (int i = 0; i < 2; ++i) { int R, C; stage_rc(tid * 16 + i * 8192, R, C); const int Rb = Epi::PERM ? ((R & ~31) + perm32(R & 31)) : R;
        voffA[i] = (unsigned)(R * K + C) * 2u; voffB[i] = (unsigned)(Rb * K + C) * 2u; }
    const size_t kstep = (size_t)(BK * 2);
    const size_t hstep = (size_t)HALF * K * 2;
    const size_t tstep = 2 * hstep;
    const unsigned ldsw = (unsigned)wid * 1024u;
    const int aoff = lds_byte(wr * 64 + fr, fq * 8), boff = lds_byte(wc * 32 + fr, fq * 8);
#define PG8_SA(b, h) (((b) * 2 + (h)) * HTB)
#define PG8_SB(b, h) ((4 + (b) * 2 + (h)) * HTB)
#define PG8_STAGE(bufoff, gbase, voff) do { _Pragma("unroll") for (int _i = 0; _i < 2; ++_i) \
        __builtin_amdgcn_global_load_lds((const unsigned*)((const char*)(gbase) + (voff)[_i]), (PG8_LAS unsigned*)(lds + (bufoff) + ldsw + _i * 8192), 16, 0, 0); } while (0)
#define PG8_LDA(dst, b, h) do { _Pragma("unroll") for (int m = 0; m < 4; ++m) _Pragma("unroll") for (int k = 0; k < 2; ++k) dst[m][k] = *(const PG8_LAS bf16x8*)(lds + PG8_SA(b, h) + aoff + m * 2048 + k * 1024); } while (0)
#define PG8_LDB(dst, b, h) do { _Pragma("unroll") for (int n = 0; n < 2; ++n) _Pragma("unroll") for (int k = 0; k < 2; ++k) dst[n][k] = *(const PG8_LAS bf16x8*)(lds + PG8_SB(b, h) + boff + n * 2048 + k * 1024); } while (0)
#define PG8_MMA(ai, bj, At, Bt) do { __builtin_amdgcn_s_setprio(1); _Pragma("unroll") for (int m = 0; m < 4; ++m) _Pragma("unroll") for (int n = 0; n < 2; ++n) _Pragma("unroll") for (int k = 0; k < 2; ++k) \
        acc[ai][bj][m][n] = __builtin_amdgcn_mfma_f32_16x16x32_bf16(Bt[n][k], At[m][k], acc[ai][bj][m][n], 0, 0, 0); __builtin_amdgcn_s_setprio(0); } while (0)
#define PG8_WAIT_V(n) asm volatile("s_waitcnt vmcnt(" #n ")" ::: "memory")
#define PG8_WAIT_L(n) asm volatile("s_waitcnt lgkmcnt(" #n ")" ::: "memory")
#define PG8_BAR __builtin_amdgcn_s_barrier()
#define PG8_SCHED __builtin_amdgcn_sched_barrier(0)
    Unit cur, nxt; int ui = 0;
    if (!S.next(0, cur)) return;
    f32x4 acc[2][2][4][2];
#pragma unroll
    for (int a = 0; a < 2; ++a)
#pragma unroll
        for (int b = 0; b < 2; ++b)
#pragma unroll
            for (int m = 0; m < 4; ++m)
#pragma unroll
                for (int n = 0; n < 2; ++n) acc[a][b][m][n] = (f32x4){0.f, 0.f, 0.f, 0.f};
    bf16x8 At[4][2], B0[2][2], B1[2][2];
    const char* cA = (const char*)g.A + (size_t)cur.pm * tstep; const char* cB = (const char*)g.Bt + (size_t)cur.pn * tstep;
    S.a_ready(cur);
    if constexpr (SP2) {
        PG8_STAGE(PG8_SB(0, 0), cB, voffB); PG8_STAGE(PG8_SB(0, 1), cB + hstep, voffB); PG8_STAGE(PG8_SA(0, 0), cA, voffA); PG8_STAGE(PG8_SA(0, 1), cA + hstep, voffA);
        if (wr == 1) PG8_BAR;
        PG8_WAIT_V(2); PG8_BAR;
        PG8_STAGE(PG8_SB(1, 0), cB + kstep, voffB); PG8_STAGE(PG8_SA(1, 0), cA + kstep, voffA); PG8_STAGE(PG8_SB(1, 1), cB + hstep + kstep, voffB);
        PG8_WAIT_V(6); PG8_BAR;
    } else {
        PG8_STAGE(PG8_SB(0, 0), cB, voffB); PG8_STAGE(PG8_SA(0, 0), cA, voffA); PG8_STAGE(PG8_SB(0, 1), cB + hstep, voffB); PG8_STAGE(PG8_SA(0, 1), cA + hstep, voffA);
        if (wr == 1) PG8_BAR;
        PG8_WAIT_V(4); PG8_BAR;
        PG8_STAGE(PG8_SB(1, 0), cB + kstep, voffB); PG8_STAGE(PG8_SA(1, 0), cA + kstep, voffA); PG8_STAGE(PG8_SB(1, 1), cB + hstep + kstep, voffB);
        PG8_WAIT_V(6); PG8_BAR;
    }
    for (;;) {
        const bool has_next = S.next(ui + 1, nxt);
        const char* nA = has_next ? (const char*)g.A + (size_t)nxt.pm * tstep : cA; const char* nB = has_next ? (const char*)g.Bt + (size_t)nxt.pn * tstep : cB;
        for (int t = 0; t < nt; t += 2) {
            const bool last = (t == nt - 2);
            const char* a1 = cA + (size_t)(t + 1) * kstep;
            const char* a2 = last ? nA : cA + (size_t)(t + 2) * kstep; const char* b2 = last ? nB : cB + (size_t)(t + 2) * kstep;
            const char* a3 = a2 + kstep; const char* b3 = b2 + kstep;
            if (last && has_next) S.a_ready(nxt);
            if constexpr (SP2) {
            PG8_LDB(B0, 0, 0); PG8_LDB(B1, 0, 1); PG8_SCHED; PG8_LDA(At, 0, 0); PG8_STAGE(PG8_SA(1, 1), a1 + hstep, voffA);
            PG8_WAIT_V(8); PG8_WAIT_L(0); PG8_BAR; PG8_MMA(0, 0, At, B0); PG8_MMA(0, 1, At, B1); PG8_BAR; PG8_SCHED;
            PG8_LDA(At, 0, 1); PG8_STAGE(PG8_SB(0, 0), b2, voffB); PG8_STAGE(PG8_SB(0, 1), b2 + hstep, voffB); PG8_STAGE(PG8_SA(0, 0), a2, voffA);
            PG8_WAIT_V(8); PG8_WAIT_L(0); PG8_BAR; PG8_MMA(1, 0, At, B0); PG8_MMA(1, 1, At, B1); PG8_BAR; PG8_SCHED;
            PG8_LDB(B0, 1, 0); PG8_LDB(B1, 1, 1); PG8_SCHED; PG8_LDA(At, 1, 0); PG8_STAGE(PG8_SA(0, 1), a2 + hstep, voffA);
            PG8_WAIT_V(8); PG8_WAIT_L(0); PG8_BAR; PG8_MMA(0, 0, At, B0); PG8_MMA(0, 1, At, B1); PG8_BAR; PG8_SCHED;
            PG8_LDA(At, 1, 1); PG8_STAGE(PG8_SB(1, 0), b3, voffB); PG8_STAGE(PG8_SB(1, 1), b3 + hstep, voffB); PG8_STAGE(PG8_SA(1, 0), a3, voffA);
            PG8_WAIT_V(8); PG8_WAIT_L(0); PG8_BAR; PG8_MMA(1, 0, At, B0); PG8_MMA(1, 1, At, B1); PG8_BAR; PG8_SCHED;
            } else {
            PG8_LDB(B0, 0, 0); PG8_SCHED; PG8_LDA(At, 0, 0); PG8_STAGE(PG8_SA(1, 1), a1 + hstep, voffA);
            PG8_WAIT_L(8); PG8_BAR; PG8_WAIT_L(0); PG8_MMA(0, 0, At, B0); PG8_BAR; PG8_SCHED;
            PG8_LDB(B1, 0, 1); PG8_STAGE(PG8_SB(0, 0), b2, voffB);
            PG8_BAR; PG8_WAIT_L(0); PG8_MMA(0, 1, At, B1); PG8_BAR;
            PG8_LDA(At, 0, 1); PG8_STAGE(PG8_SA(0, 0), a2, voffA);
            PG8_BAR; PG8_WAIT_L(0); PG8_MMA(1, 0, At, B0); PG8_BAR; PG8_SCHED;
            PG8_STAGE(PG8_SB(0, 1), b2 + hstep, voffB);
            PG8_WAIT_V(6); PG8_BAR; PG8_MMA(1, 1, At, B1); PG8_BAR;
            PG8_LDB(B0, 1, 0); PG8_SCHED; PG8_LDA(At, 1, 0); PG8_STAGE(PG8_SA(0, 1), a2 + hstep, voffA);
            PG8_WAIT_L(8); PG8_BAR; PG8_WAIT_L(0); PG8_MMA(0, 0, At, B0); PG8_BAR; PG8_SCHED;
            PG8_LDB(B1, 1, 1); PG8_STAGE(PG8_SB(1, 0), b3, voffB);
            PG8_BAR; PG8_WAIT_L(0); PG8_MMA(0, 1, At, B1); PG8_BAR;
            PG8_LDA(At, 1, 1); PG8_STAGE(PG8_SA(1, 0), a3, voffA);
            PG8_BAR; PG8_WAIT_L(0); PG8_MMA(1, 0, At, B0); PG8_BAR; PG8_SCHED;
            PG8_STAGE(PG8_SB(1, 1), b3 + hstep, voffB);
            PG8_WAIT_V(6); PG8_BAR; PG8_MMA(1, 1, At, B1); PG8_BAR;
            }
        }
        if constexpr (ALIGN_EPI) { if (wr == 0) PG8_BAR; }
        if constexpr (!Epi::AFTER_DRAIN) { E(acc, cur, wr, wc, fr, fq); S.done(cur); }
        if (!has_next) break;
#pragma unroll
        for (int a = 0; a < 2; ++a)
#pragma unroll
            for (int b = 0; b < 2; ++b)
#pragma unroll
                for (int m = 0; m < 4; ++m)
#pragma unroll
                    for (int n = 0; n < 2; ++n) acc[a][b][m][n] = (f32x4){0.f, 0.f, 0.f, 0.f};
        cur = nxt; cA = nA; cB = nB; ++ui;
        if constexpr (ALIGN_EPI) { if (wr == 1) PG8_BAR; }
    }
    PG8_WAIT_V(0);
    if constexpr (!ALIGN_EPI) { if (wr == 0) PG8_BAR; }
    PG8_BAR;
    if constexpr (Epi::AFTER_DRAIN) { E.fused(acc, cur, wr, wc, fr, fq, lds, wid, lane); S.done(cur); }
#undef PG8_SA
#undef PG8_SB
#undef PG8_STAGE
#undef PG8_LDA
#undef PG8_LDB
#undef PG8_MMA
#undef PG8_WAIT_V
#undef PG8_WAIT_L
#undef PG8_BAR
#undef PG8_SCHED
}
}

constexpr int NWAVES = 8;
constexpr int NB = 4, SEQ = 8192, D = 1024, M = NB * SEQ, FF = 4096, NMEM = 256;
constexpr int ZE = 3328, ZO = 1280;
constexpr int ZQL = 0, ZCKV = 1024, ZQI = 1152, ZKI = 1664, ZWI = 1728, ZQB = 1792, ZKB = 2304, ZVB = 2816;
constexpr int OQ = 0, OKK = 1024, OVV = 1152;
constexpr int EVC = 2760;
constexpr int HCE = 1536, HCO = 1024;
constexpr float EPS = 1e-6f;
constexpr float LOG2E = 1.4426950408889634f;

constexpr size_t MiB = 1u << 20;
constexpr size_t WS_CTL = 0, CTL_ZERO_BYTES = 1 * MiB;
constexpr size_t WS_WGT = 1 * MiB;
constexpr size_t WO_WIN = 0, WO_WOUT = 6 * MiB + MiB / 2, WO_WQ = 9 * MiB + MiB / 2, WO_WKV = 10 * MiB, WO_WO = 11 * MiB, WO_W1 = 11 * MiB + MiB / 2, WO_W2 = 19 * MiB + MiB / 2;
constexpr size_t WS_MEMN = 33 * MiB, WS_KVM = 35 * MiB, WS_CKVN = 36 * MiB, WS_QX = 44 * MiB, WS_OX = 60 * MiB, WS_HC = 76 * MiB, WS_ZS = 172 * MiB;
constexpr size_t WS_Z = WS_ZS, WS_SCR = WS_ZS + 208 * MiB, WS_U = WS_ZS, WS_Y = WS_ZS + 272 * MiB, WS_END = WS_ZS + 336 * MiB;
static_assert(WS_END == 508 * MiB, "ws map");
constexpr size_t WS_RS = 29 * MiB;
constexpr size_t XB_OFF = 64 * MiB;
constexpr size_t WS_FT = WS_ZS;
constexpr int CW_BAR = 4096;

constexpr int RING_OFF = 0, RING_BYTES = 131072;
constexpr int LDSCTL_OFF = RING_BYTES, MISC_OFF = LDSCTL_OFF + 320;
constexpr int LDS_BYTES = 147456;

#define GAS __attribute__((address_space(1)))
#define LAS __attribute__((address_space(3)))
typedef unsigned short bf16;
typedef unsigned v4u __attribute__((ext_vector_type(4)));
typedef unsigned v2u __attribute__((ext_vector_type(2)));
typedef float f32x4 __attribute__((ext_vector_type(4)));
typedef GAS unsigned gu32;
#define RLX_AGENT __ATOMIC_RELAXED, __HIP_MEMORY_SCOPE_AGENT
#define LDS_WAIT() asm volatile("s_waitcnt lgkmcnt(0)" ::: "memory")
#define VM_WAIT() asm volatile("s_waitcnt vmcnt(0)" ::: "memory")
__device__ __forceinline__ unsigned f2bf(float f) { unsigned u = __builtin_bit_cast(unsigned, f); return (u + 0x7fffu + ((u >> 16) & 1u)) >> 16; }
__device__ __forceinline__ unsigned pk2(float lo, float hi) { return f2bf(lo) | (f2bf(hi) << 16); }
__device__ __forceinline__ float bflo(unsigned w) { return __builtin_bit_cast(float, w << 16); }
__device__ __forceinline__ float bfhi(unsigned w) { return __builtin_bit_cast(float, w & 0xffff0000u); }
__device__ __forceinline__ float bf2f(unsigned short u) { return __builtin_bit_cast(float, (unsigned)u << 16); }
__device__ __forceinline__ float wave_sum(float v) {
#pragma unroll
    for (int o = 1; o < 64; o <<= 1) v += __shfl_xor(v, o);
    return v;
}
__device__ __forceinline__ float wave_max(float v) {
#pragma unroll
    for (int o = 1; o < 64; o <<= 1) v = fmaxf(v, __shfl_xor(v, o));
    return v;
}
__device__ __forceinline__ int t5_bucket(int rel) {
    const int n = rel < 0 ? -rel : rel;
    const int b = n < 8 ? n : 8 + (n >= 15) + (n >= 27) + (n >= 50) + (n >= 91) + (n >= 166) + (n >= 305) + (n >= 559);
    return b + (rel > 0 ? 16 : 0);
}
#define XB_TMO      128
#define XB_XCNT(j)  (256  + 64 * (j))
#define XB_XSUB(j)  (1280 + 64 * (j))
#define XB_XGEN(j)  (2304 + 64 * (j))
#define XB_TOP      3328
#define XB_TOPGEN   3392
#define XCD_BAR_WORDS 3456
#define XB_SPIN_CAP (1u << 25)

__device__ __forceinline__ unsigned xb_ld(unsigned* p)              { return __hip_atomic_load(p, __ATOMIC_RELAXED, __HIP_MEMORY_SCOPE_AGENT); }
__device__ __forceinline__ unsigned xb_add(unsigned* p, unsigned v) { return __hip_atomic_fetch_add(p, v, __ATOMIC_RELAXED, __HIP_MEMORY_SCOPE_AGENT); }
__device__ __forceinline__ unsigned xb_xcc_id() { return (unsigned)__builtin_amdgcn_s_getreg((3 << 11) | 20) & 0xFu; }
#define XB_SPIN(cond, bar) do { unsigned _sp = 0; while (cond) { __builtin_amdgcn_s_sleep(1); \
    if ((++_sp & 255u) == 0u) { if (xb_ld(&(bar)[XB_TMO])) break; if (_sp > XB_SPIN_CAP) { atomicAdd(&(bar)[XB_TMO], 1u); break; } } } } while (0)

struct XcdBarrier {
    unsigned* bar; unsigned x;
    volatile LAS unsigned* st;
};

__device__ __forceinline__ XcdBarrier xcd_barrier_post(unsigned* bar, volatile LAS unsigned* st, bool leader) {
    XcdBarrier b; b.bar = bar; b.x = xb_xcc_id(); b.st = st;
    if (leader) (void)xb_add(&bar[XB_XCNT(b.x)], 1u);
    return b;
}
__device__ __forceinline__ void xcd_barrier_complete(unsigned* bar, unsigned x, unsigned& nloc, unsigned& nx) {
    const unsigned G = gridDim.x * gridDim.y * gridDim.z;
    unsigned sum, cnt, mine, sp = 0u;
    for (;;) {
        sum = 0u; cnt = 0u; mine = 0u;
#pragma unroll
        for (unsigned j = 0; j < 16; ++j) { const unsigned c = xb_ld(&bar[XB_XCNT(j)]); sum += c; cnt += (c > 0u) ? 1u : 0u; mine = (j == x) ? c : mine; }
        if (sum == G) break;
        __builtin_amdgcn_s_sleep(1);
        if ((++sp & 255u) == 0u) { if (xb_ld(&bar[XB_TMO])) break; if (sp > XB_SPIN_CAP) { atomicAdd(&bar[XB_TMO], 1u); break; } }
    }
    nloc = mine > 0u ? mine : 1u; nx = cnt > 0u ? cnt : 1u;
}

__device__ __forceinline__ void xcd_barrier(const XcdBarrier& b, bool leader) {
    asm volatile("s_waitcnt vmcnt(0)" ::: "memory");
    __syncthreads();
    if (leader) {
        unsigned* bar = b.bar;
        __builtin_amdgcn_s_waitcnt(0);
        unsigned nloc = b.st[0], nx = b.st[1];
        if (nloc == 0u) { xcd_barrier_complete(bar, b.x, nloc, nx); b.st[0] = nloc; b.st[1] = nx; }
        const unsigned old = xb_add(&bar[XB_XSUB(b.x)], 1u);
        const unsigned gen = old / nloc;
        if (old + 1u == (gen + 1u) * nloc) {
            __builtin_amdgcn_fence(__ATOMIC_RELEASE, "agent");
            asm volatile("s_waitcnt vmcnt(0)" ::: "memory");
            const unsigned og = xb_add(&bar[XB_TOP], 1u);
            const unsigned tg = og / nx;
            if (og + 1u == (tg + 1u) * nx) xb_add(&bar[XB_TOPGEN], 1u);
            else XB_SPIN(xb_ld(&bar[XB_TOPGEN]) == tg, bar);
            __builtin_amdgcn_fence(__ATOMIC_ACQUIRE, "agent");
            xb_add(&bar[XB_XGEN(b.x)], 1u);
            asm volatile("s_waitcnt vmcnt(0)" ::: "memory");
        } else {
            XB_SPIN(xb_ld(&bar[XB_XGEN(b.x)]) == gen, bar);
            __builtin_amdgcn_fence(__ATOMIC_ACQUIRE, "agent");
            asm volatile("s_waitcnt vmcnt(0)" ::: "memory");
        }
    }
    __syncthreads();
}
#ifndef PROBE_MASK
#define PROBE_MASK 0
#endif
#define REP(k) for (int rep_ = 0; rep_ < (((PROBE_MASK) >> (k)) & 1) + 1; ++rep_)

struct Frame {
    LAS unsigned char* lds;
    volatile LAS unsigned* MISC;
    int tid, lane, wave, vcu, G;
};
#define KIN(i) ((const float*)karg64_c<(i) * 8>())
#define KOUT() ((float*)karg64_c<160>())
#define KWS() ((unsigned char*)karg64_c<168>())
template <int OFF> __device__ __forceinline__ unsigned long long karg64_c() { unsigned long long p; asm volatile("s_load_dwordx2 %0, %1, %2\n\ts_waitcnt lgkmcnt(0)" : "=s"(p) : "s"(__builtin_amdgcn_kernarg_segment_ptr()), "n"(OFF)); return p; }
__device__ __forceinline__ int lane_id() { return (int)__builtin_amdgcn_mbcnt_hi(~0u, __builtin_amdgcn_mbcnt_lo(~0u, 0u)); }
__device__ __forceinline__ bool refresh(Frame& F) { int t_ = F.wave * 64 + lane_id(); asm volatile("" : "+v"(t_)); F.tid = t_; F.lane = t_ & 63; return true; }
#define XLEAD(F) ((F).wave == 0 && lane_id() == 0)
enum { I_X = 0, I_MEM, I_TAB, I_NG, I_EWIN, I_EKVN, I_EUK, I_EUV, I_ELAM, I_ESUB, I_EWOUT, I_OWIN, I_OSINK, I_OWOUT, I_XWQ, I_XWKV, I_XWO, I_XMN, I_W1, I_W2 };

__device__ __forceinline__ void tr_item(const float* src, int spitch, int scol0, bf16* dst, int dpitch, int drow0, int dcol0, int nblk, LAS float* scr, int item, int lane, const float* gk = nullptr) {
    const int kb = item / nblk, nb = item % nblk, k0 = 64 * kb, n0 = 32 * nb;
#pragma unroll 8
    for (int i = 0; i < 32; ++i) { const int kk = 2 * i + (lane >> 5); scr[kk * 33 + (lane & 31)] = ((const GAS float*)src)[(size_t)(k0 + kk) * spitch + scol0 + n0 + (lane & 31)] * (gk ? ((const GAS float*)gk)[k0 + kk] : 1.f); }
    LDS_WAIT(); asm volatile("" ::: "memory");
    const int c = lane & 7;
#pragma unroll
    for (int j = 0; j < 4; ++j) { const int n = (lane >> 3) + 8 * j; const LAS float* s = scr + (8 * c) * 33 + n;
        v4u o; o.x = pk2(s[0 * 33], s[1 * 33]); o.y = pk2(s[2 * 33], s[3 * 33]); o.z = pk2(s[4 * 33], s[5 * 33]); o.w = pk2(s[6 * 33], s[7 * 33]);
        *(GAS v4u*)(dst + (size_t)(drow0 + n0 + n) * dpitch + dcol0 + k0 + 8 * c) = o; }
    LDS_WAIT(); asm volatile("" ::: "memory");
}
__device__ __forceinline__ void fuse_qlat_item(const float* win, const float* wuk, bf16* dst, int item, int lane, const float* gk) {
    const int h = item >> 6, k0 = (item & 63) * 16;
    float a0[16], a1[16];
#pragma unroll
    for (int k = 0; k < 16; ++k) { a0[k] = 0.f; a1[k] = 0.f; }
    for (int d = 0; d < 64; ++d) {
        const float u0 = ((const GAS float*)wuk)[(size_t)(h * 64 + d) * 128 + 2 * lane], u1 = ((const GAS float*)wuk)[(size_t)(h * 64 + d) * 128 + 2 * lane + 1];
#pragma unroll
        for (int k = 0; k < 16; ++k) { const float w = ((const GAS float*)win)[(size_t)(k0 + k) * EVC + h * 64 + d]; a0[k] += w * u0; a1[k] += w * u1; }
    }
#pragma unroll
    for (int k = 0; k < 16; ++k) { const float gg = ((const GAS float*)gk)[k0 + k]; a0[k] *= gg; a1[k] *= gg; }
    v4u o0, o1, p0, p1;
    o0.x = pk2(a0[0], a0[1]); o0.y = pk2(a0[2], a0[3]); o0.z = pk2(a0[4], a0[5]); o0.w = pk2(a0[6], a0[7]);
    o1.x = pk2(a0[8], a0[9]); o1.y = pk2(a0[10], a0[11]); o1.z = pk2(a0[12], a0[13]); o1.w = pk2(a0[14], a0[15]);
    p0.x = pk2(a1[0], a1[1]); p0.y = pk2(a1[2], a1[3]); p0.z = pk2(a1[4], a1[5]); p0.w = pk2(a1[6], a1[7]);
    p1.x = pk2(a1[8], a1[9]); p1.y = pk2(a1[10], a1[11]); p1.z = pk2(a1[12], a1[13]); p1.w = pk2(a1[14], a1[15]);
    GAS v4u* r0 = (GAS v4u*)(dst + (size_t)(h * 128 + 2 * lane) * 1024 + k0); GAS v4u* r1 = (GAS v4u*)(dst + (size_t)(h * 128 + 2 * lane + 1) * 1024 + k0);
    r0[0] = o0; r0[1] = o1; r1[0] = p0; r1[1] = p1;
}
__device__ __forceinline__ void fuse_ov_item(const float* wuv, const float* wout, bf16* dst, int item, int lane) {
    const int h = item >> 6, n0 = (item & 63) * 16;
    float a0[16], a1[16];
#pragma unroll
    for (int k = 0; k < 16; ++k) { a0[k] = 0.f; a1[k] = 0.f; }
    for (int d = 0; d < 64; ++d) {
        const float u0 = ((const GAS float*)wuv)[(size_t)(h * 128 + 2 * lane) * 64 + d], u1 = ((const GAS float*)wuv)[(size_t)(h * 128 + 2 * lane + 1) * 64 + d];
#pragma unroll
        for (int k = 0; k < 16; ++k) { const float w = ((const GAS float*)wout)[(size_t)(h * 64 + d) * 1024 + n0 + k]; a0[k] += w * u0; a1[k] += w * u1; }
    }
#pragma unroll
    for (int k = 0; k < 16; ++k) *(GAS unsigned*)(dst + (size_t)(n0 + k) * HCE + h * 128 + 2 * lane) = pk2(a0[k], a1[k]);
}
__device__ __forceinline__ void widx_item(const float* win, bf16* dst, int item, int lane, const float* gk) {
    const int k = item * 64 + lane; const float gg = ((const GAS float*)gk)[k];
    for (int n = 0; n < 64; ++n) { const float v = n < 8 ? ((const GAS float*)win)[(size_t)k * EVC + 1216 + n] * gg : 0.f; ((GAS bf16*)dst)[(size_t)(ZWI + n) * 1024 + k] = (bf16)f2bf(v); }
}

__device__ __forceinline__ void convert_weights(Frame& F, int l) {
    LAS float* scr = (LAS float*)(F.lds + RING_OFF + F.wave * 16384);
    const int gw = F.vcu * NWAVES + F.wave, NGW = F.G * NWAVES;
    bf16* WIN = (bf16*)(KWS() + WS_WGT + WO_WIN); bf16* WOUT = (bf16*)(KWS() + WS_WGT + WO_WOUT); bf16* WQ = (bf16*)(KWS() + WS_WGT + WO_WQ); bf16* WKV = (bf16*)(KWS() + WS_WGT + WO_WKV);
    bf16* WO = (bf16*)(KWS() + WS_WGT + WO_WO); bf16* W1 = (bf16*)(KWS() + WS_WGT + WO_W1); bf16* W2 = (bf16*)(KWS() + WS_WGT + WO_W2);
    const float* wq = KIN(I_XWQ) + (size_t)l * 1024 * 256; const float* wkv = KIN(I_XWKV) + (size_t)l * 1024 * 512; const float* wo = KIN(I_XWO) + (size_t)l * 256 * 1024;
    const float* w1 = KIN(I_W1) + (size_t)l * 1024 * 4096; const float* w2 = KIN(I_W2) + (size_t)l * 4096 * 1024;
    constexpr int N_Q = 16 * 8, N_KV = 16 * 16, N_O = 4 * 32, N_1 = 16 * 128, N_2 = 64 * 32;
    const float* g0 = KIN(I_NG) + (size_t)l * 6 * D; const float* g2 = g0 + 2 * D; const float* g4 = g0 + 4 * D;
    if ((l & 1) == 0) {
        const int e = l >> 1;
        const float* win = KIN(I_EWIN) + (size_t)e * 1024 * EVC; const float* wout = KIN(I_EWOUT) + (size_t)e * 1024 * 1024;
        const float* wuk = KIN(I_EUK) + (size_t)e * 8 * 64 * 128; const float* wuv = KIN(I_EUV) + (size_t)e * 8 * 128 * 64;
        constexpr int A0 = 512, A1 = 16 * 4, A2 = 16 * 16, A3 = 16 * 2, A4 = 16 * 48, A5 = 16, A6 = 512, A7 = 8 * 32;
        constexpr int TOT = A0 + A1 + A2 + A3 + A4 + A5 + A6 + A7 + N_Q + N_KV + N_O + N_1 + N_2;
        for (int it = gw; it < TOT; it += NGW) {
            int r = it;
            if (r < A0) { fuse_qlat_item(win, wuk, WIN, r, F.lane, g0); continue; } r -= A0;
            if (r < A1) { tr_item(win, EVC, 512, WIN, 1024, ZCKV, 0, 4, scr, r, F.lane, g0); continue; } r -= A1;
            if (r < A2) { tr_item(win, EVC, 640, WIN, 1024, ZQI, 0, 16, scr, r, F.lane, g0); continue; } r -= A2;
            if (r < A3) { tr_item(win, EVC, 1152, WIN, 1024, ZKI, 0, 2, scr, r, F.lane, g0); continue; } r -= A3;
            if (r < A4) { tr_item(win, EVC, 1224, WIN, 1024, ZQB, 0, 48, scr, r, F.lane, g0); continue; } r -= A4;
            if (r < A5) { widx_item(win, WIN, r, F.lane, g0); continue; } r -= A5;
            if (r < A6) { fuse_ov_item(wuv, wout, WOUT, r, F.lane); continue; } r -= A6;
            if (r < A7) { tr_item(wout + (size_t)512 * 1024, 1024, 0, WOUT, HCE, 0, 1024, 32, scr, r, F.lane); continue; } r -= A7;
            if (r < N_Q) { tr_item(wq, 256, 0, WQ, 1024, 0, 0, 8, scr, r, F.lane, g2); continue; } r -= N_Q;
            if (r < N_KV) { tr_item(wkv, 512, 0, WKV, 1024, 0, 0, 16, scr, r, F.lane); continue; } r -= N_KV;
            if (r < N_O) { tr_item(wo, 1024, 0, WO, 256, 0, 0, 32, scr, r, F.lane); continue; } r -= N_O;
            if (r < N_1) { tr_item(w1, 4096, 0, W1, 1024, 0, 0, 128, scr, r, F.lane, g4); continue; } r -= N_1;
            tr_item(w2, 1024, 0, W2, 4096, 0, 0, 32, scr, r, F.lane);
        }
    } else {
        const int o = l >> 1;
        const float* win = KIN(I_OWIN) + (size_t)o * 1024 * ZO; const float* wout = KIN(I_OWOUT) + (size_t)o * 1024 * 1024;
        constexpr int B0 = 16 * 40, B1 = 16 * 32;
        constexpr int TOT = B0 + B1 + N_Q + N_KV + N_O + N_1 + N_2;
        for (int it = gw; it < TOT; it += NGW) {
            int r = it;
            if (r < B0) { tr_item(win, ZO, 0, WIN, 1024, 0, 0, 40, scr, r, F.lane, g0); continue; } r -= B0;
            if (r < B1) { tr_item(wout, 1024, 0, WOUT, 1024, 0, 0, 32, scr, r, F.lane); continue; } r -= B1;
            if (r < N_Q) { tr_item(wq, 256, 0, WQ, 1024, 0, 0, 8, scr, r, F.lane, g2); continue; } r -= N_Q;
            if (r < N_KV) { tr_item(wkv, 512, 0, WKV, 1024, 0, 0, 16, scr, r, F.lane); continue; } r -= N_KV;
            if (r < N_O) { tr_item(wo, 1024, 0, WO, 256, 0, 0, 32, scr, r, F.lane); continue; } r -= N_O;
            if (r < N_1) { tr_item(w1, 4096, 0, W1, 1024, 0, 0, 128, scr, r, F.lane, g4); continue; } r -= N_1;
            tr_item(w2, 1024, 0, W2, 4096, 0, 0, 32, scr, r, F.lane);
        }
    }
}

__device__ __forceinline__ void row_first(int lane, const float* xin, float* xout, const float* g, bf16* h) {
    const GAS f32x4* xr = (const GAS f32x4*)xin + lane; f32x4 v[4]; float ss = 0.f;
#pragma unroll
    for (int j = 0; j < 4; ++j) { v[j] = xr[64 * j]; ss += (v[j].x * v[j].x + v[j].y * v[j].y) + (v[j].z * v[j].z + v[j].w * v[j].w); }
    const float r = 1.f / sqrtf(wave_sum(ss) * (1.f / 1024.f) + EPS);
    const GAS f32x4* gr = (const GAS f32x4*)g + lane; GAS v2u* ho = (GAS v2u*)h + lane;
#pragma unroll
    for (int j = 0; j < 4; ++j) {
        if (xout) ((GAS f32x4*)xout + lane)[64 * j] = v[j];
        const f32x4 gg = gr[64 * j]; v2u o; o.x = pk2(v[j].x * r * gg.x, v[j].y * r * gg.y); o.y = pk2(v[j].z * r * gg.z, v[j].w * r * gg.w); ho[64 * j] = o; }
}
__device__ __forceinline__ void row_mid(int lane, const bf16* y, float* x, const float* ga, const float* gb, bf16* h) {
    const GAS v2u* yr = (const GAS v2u*)y + lane; GAS f32x4* xr = (GAS f32x4*)x + lane; f32x4 yv[4], xv[4]; float ss = 0.f;
#pragma unroll
    for (int j = 0; j < 4; ++j) { const v2u w = yr[64 * j]; yv[j] = (f32x4){bflo(w.x), bfhi(w.x), bflo(w.y), bfhi(w.y)}; xv[j] = xr[64 * j];
        ss += (yv[j].x * yv[j].x + yv[j].y * yv[j].y) + (yv[j].z * yv[j].z + yv[j].w * yv[j].w); }
    const float r1 = 1.f / sqrtf(wave_sum(ss) * (1.f / 1024.f) + EPS);
    const GAS f32x4* gar = (const GAS f32x4*)ga + lane; float s2 = 0.f;
#pragma unroll
    for (int j = 0; j < 4; ++j) { const f32x4 gg = gar[64 * j]; xv[j].x += yv[j].x * r1 * gg.x; xv[j].y += yv[j].y * r1 * gg.y; xv[j].z += yv[j].z * r1 * gg.z; xv[j].w += yv[j].w * r1 * gg.w;
        xr[64 * j] = xv[j]; s2 += (xv[j].x * xv[j].x + xv[j].y * xv[j].y) + (xv[j].z * xv[j].z + xv[j].w * xv[j].w); }
    if (gb) {
        const float r2 = 1.f / sqrtf(wave_sum(s2) * (1.f / 1024.f) + EPS);
        const GAS f32x4* gbr = (const GAS f32x4*)gb + lane; GAS v2u* ho = (GAS v2u*)h + lane;
#pragma unroll
        for (int j = 0; j < 4; ++j) { const f32x4 gg = gbr[64 * j]; v2u o; o.x = pk2(xv[j].x * r2 * gg.x, xv[j].y * r2 * gg.y); o.y = pk2(xv[j].z * r2 * gg.z, xv[j].w * r2 * gg.w); ho[64 * j] = o; }
    }
}
__device__ __forceinline__ void thin_first(Frame& F) {
    const int gw = F.vcu * NWAVES + F.wave, NGW = F.G * NWAVES, lane = F.lane; bf16* xb = (bf16*)((unsigned char*)KOUT() + XB_OFF); float* rs = (float*)(KWS() + WS_RS);
    const float* xin = KIN(I_X);
    for (int m = gw; m < M; m += NGW) {
        const GAS f32x4* xr = (const GAS f32x4*)(xin + (size_t)m * D) + lane; f32x4 v[4]; float ss = 0.f;
#pragma unroll
        for (int j = 0; j < 4; ++j) { v[j] = xr[64 * j]; ss += (v[j].x * v[j].x + v[j].y * v[j].y) + (v[j].z * v[j].z + v[j].w * v[j].w); }
        const float r = 1.f / sqrtf(wave_sum(ss) * (1.f / 1024.f) + EPS);
        GAS v2u* xo = (GAS v2u*)(xb + (size_t)m * D) + lane;
#pragma unroll
        for (int j = 0; j < 4; ++j) { v2u o; o.x = pk2(v[j].x, v[j].y); o.y = pk2(v[j].z, v[j].w); xo[64 * j] = o; }
        if (lane == 0) ((GAS float*)rs)[m] = r;
    }
}
template <bool FINAL> __device__ __forceinline__ void thin_mid(Frame& F, const float* ga) {
    const int gw = F.vcu * NWAVES + F.wave, NGW = F.G * NWAVES, lane = F.lane; bf16* xb = (bf16*)((unsigned char*)KOUT() + XB_OFF); float* rs = (float*)(KWS() + WS_RS);
    const bf16* y = (const bf16*)(KWS() + WS_Y); float* outp = KOUT(); float* ft = (float*)(KWS() + WS_FT);
    f32x4 g4[4];
#pragma unroll
    for (int j = 0; j < 4; ++j) g4[j] = ((const GAS f32x4*)ga + lane)[64 * j];
    for (int m0 = gw; m0 < M; m0 += 2 * NGW) {
        v2u yw[2][4], xw[2][4];
#pragma unroll
        for (int a = 0; a < 2; ++a) { const int m = m0 + a * NGW;
#pragma unroll
            for (int j = 0; j < 4; ++j) { yw[a][j] = ((const GAS v2u*)(y + (size_t)m * D) + lane)[64 * j]; xw[a][j] = ((const GAS v2u*)(xb + (size_t)m * D) + lane)[64 * j]; } }
#pragma unroll
        for (int a = 0; a < 2; ++a) { const int m = m0 + a * NGW;
            f32x4 yv[4], xv[4]; float ss = 0.f;
#pragma unroll
            for (int j = 0; j < 4; ++j) { yv[j] = (f32x4){bflo(yw[a][j].x), bfhi(yw[a][j].x), bflo(yw[a][j].y), bfhi(yw[a][j].y)}; xv[j] = (f32x4){bflo(xw[a][j].x), bfhi(xw[a][j].x), bflo(xw[a][j].y), bfhi(xw[a][j].y)};
                ss += (yv[j].x * yv[j].x + yv[j].y * yv[j].y) + (yv[j].z * yv[j].z + yv[j].w * yv[j].w); }
            const float r1 = 1.f / sqrtf(wave_sum(ss) * (1.f / 1024.f) + EPS); float s2 = 0.f;
#pragma unroll
            for (int j = 0; j < 4; ++j) { xv[j].x += yv[j].x * r1 * g4[j].x; xv[j].y += yv[j].y * r1 * g4[j].y; xv[j].z += yv[j].z * r1 * g4[j].z; xv[j].w += yv[j].w * r1 * g4[j].w;
                s2 += (xv[j].x * xv[j].x + xv[j].y * xv[j].y) + (xv[j].z * xv[j].z + xv[j].w * xv[j].w); }
            if (FINAL) { GAS f32x4* fo = (GAS f32x4*)(m < M / 2 ? outp + (size_t)m * D : ft + (size_t)(m - M / 2) * D) + lane;
#pragma unroll
                for (int j = 0; j < 4; ++j) fo[64 * j] = xv[j];
            } else { GAS v2u* xo = (GAS v2u*)(xb + (size_t)m * D) + lane;
#pragma unroll
                for (int j = 0; j < 4; ++j) { v2u o; o.x = pk2(xv[j].x, xv[j].y); o.y = pk2(xv[j].z, xv[j].w); xo[64 * j] = o; }
                const float r2 = 1.f / sqrtf(wave_sum(s2) * (1.f / 1024.f) + EPS);
                if (lane == 0) ((GAS float*)rs)[m] = r2; }
        }
    }
}
__device__ __forceinline__ void final_copy(Frame& F) {
    const GAS f32x4* src = (const GAS f32x4*)(KWS() + WS_FT); GAS f32x4* dst = (GAS f32x4*)(KOUT() + (size_t)(M / 2) * D);
    const size_t n4 = (size_t)(M / 2) * D / 4, stride = (size_t)F.G * NWAVES * 64;
    for (size_t i = (size_t)(F.vcu * NWAVES + F.wave) * 64 + F.lane; i < n4; i += stride) dst[i] = src[i];
}
__device__ __forceinline__ void thin_memn(Frame& F, const float* g) {
    const int gw = F.vcu * NWAVES + F.wave, NGW = F.G * NWAVES; bf16* mn = (bf16*)(KWS() + WS_MEMN);
    for (int m = NGW - 1 - gw; m < NB * NMEM; m += NGW) row_first(F.lane, KIN(I_MEM) + (size_t)m * D, nullptr, g, mn + (size_t)m * D);
}
__device__ __forceinline__ void thin_ckvn(Frame& F, const float* akvn) {
    const int gw = F.vcu * NWAVES + F.wave, NGW = F.G * NWAVES; const bf16* z = (const bf16*)(KWS() + WS_Z); bf16* ck = (bf16*)(KWS() + WS_CKVN);
    const float g0 = ((const GAS float*)akvn)[2 * F.lane], g1 = ((const GAS float*)akvn)[2 * F.lane + 1];
    for (int m = gw; m < M; m += NGW) {
        const unsigned w = *((const GAS unsigned*)(z + (size_t)m * ZE + ZCKV) + F.lane); const float a = bflo(w), b = bfhi(w);
        const float r = 1.f / sqrtf(wave_sum(a * a + b * b) * (1.f / 128.f) + EPS);
        *((GAS unsigned*)(ck + (size_t)m * 128) + F.lane) = pk2(a * r * g0, b * r * g1);
    }
}

#define UNPK8(dst, off, VV) do { dst[(off) + 0] = bflo((VV).x); dst[(off) + 1] = bfhi((VV).x); dst[(off) + 2] = bflo((VV).y); dst[(off) + 3] = bfhi((VV).y); \
    dst[(off) + 4] = bflo((VV).z); dst[(off) + 5] = bfhi((VV).z); dst[(off) + 6] = bflo((VV).w); dst[(off) + 7] = bfhi((VV).w); } while (0)
#define DOT8(q, off, VV) ((q[(off) + 0] * bflo((VV).x) + q[(off) + 1] * bfhi((VV).x)) + (q[(off) + 2] * bflo((VV).y) + q[(off) + 3] * bfhi((VV).y)) + \
    (q[(off) + 4] * bflo((VV).z) + q[(off) + 5] * bfhi((VV).z)) + (q[(off) + 6] * bflo((VV).w) + q[(off) + 7] * bfhi((VV).w)))
#define AXPY8(acc, off, al, p, VV) do { acc[(off) + 0] = acc[(off) + 0] * (al) + (p) * bflo((VV).x); acc[(off) + 1] = acc[(off) + 1] * (al) + (p) * bfhi((VV).x); \
    acc[(off) + 2] = acc[(off) + 2] * (al) + (p) * bflo((VV).y); acc[(off) + 3] = acc[(off) + 3] * (al) + (p) * bfhi((VV).y); \
    acc[(off) + 4] = acc[(off) + 4] * (al) + (p) * bflo((VV).z); acc[(off) + 5] = acc[(off) + 5] * (al) + (p) * bfhi((VV).z); \
    acc[(off) + 6] = acc[(off) + 6] * (al) + (p) * bflo((VV).w); acc[(off) + 7] = acc[(off) + 7] * (al) + (p) * bfhi((VV).w); } while (0)

__device__ __forceinline__ void xattn_naive(Frame& F) {
    LAS v4u* Ks = (LAS v4u*)(F.lds); LAS v4u* Vs = (LAS v4u*)(F.lds + 32768);
    const bf16* kvm = (const bf16*)(KWS() + WS_KVM); const bf16* qx = (const bf16*)(KWS() + WS_QX); bf16* ox = (bf16*)(KWS() + WS_OX);
    for (int u = F.vcu; u < 256; u += F.G) {
        const int b = u >> 6, h = (u >> 4) & 3, blk = u & 15;
        __syncthreads();
        for (int i = F.tid; i < 2048; i += 512) { const int key = i >> 3, c = i & 7;
            const GAS v4u* src = (const GAS v4u*)(kvm + (size_t)(b * NMEM + key) * 512 + h * 64) + c; Ks[i] = src[0]; Vs[i] = src[32]; }
        __syncthreads();
        const size_t token = (size_t)b * SEQ + blk * 512 + F.tid;
        float q[64], acc[64];
        { const GAS v4u* qp = (const GAS v4u*)(qx + token * 256 + h * 64);
#pragma unroll
          for (int c = 0; c < 8; ++c) { const v4u w = qp[c]; UNPK8(q, 8 * c, w); } }
#pragma unroll
        for (int d = 0; d < 64; ++d) acc[d] = 0.f;
        float m = -1e30f, l = 0.f;
        for (int key = 0; key < NMEM; ++key) {
            float s = 0.f;
#pragma unroll
            for (int c = 0; c < 8; ++c) { const v4u w = Ks[key * 8 + c]; s += DOT8(q, 8 * c, w); }
            s *= 0.125f;
            const float mn = fmaxf(m, s), al = __expf(m - mn), p = __expf(s - mn); l = l * al + p; m = mn;
#pragma unroll
            for (int c = 0; c < 8; ++c) { const v4u w = Vs[key * 8 + c]; AXPY8(acc, 8 * c, al, p, w); }
        }
        const float inv = 1.f / l;
        GAS v4u* op = (GAS v4u*)(ox + token * 256 + h * 64);
#pragma unroll
        for (int c = 0; c < 8; ++c) { v4u o; o.x = pk2(acc[8 * c] * inv, acc[8 * c + 1] * inv); o.y = pk2(acc[8 * c + 2] * inv, acc[8 * c + 3] * inv);
            o.z = pk2(acc[8 * c + 4] * inv, acc[8 * c + 5] * inv); o.w = pk2(acc[8 * c + 6] * inv, acc[8 * c + 7] * inv); op[c] = o; }
    }
}

__device__ __forceinline__ void swa_naive(Frame& F, int o) {
    LAS v4u* Ks = (LAS v4u*)(F.lds); LAS v4u* Vs = (LAS v4u*)(F.lds + 24576); LAS float* lut = (LAS float*)(F.lds + 49152);
    const bf16* z = (const bf16*)(KWS() + WS_Z); bf16* hc = (bf16*)(KWS() + WS_HC);
    const float* tab = KIN(I_TAB); const float* sinks = KIN(I_OSINK) + o * 16;
    for (int u = F.vcu; u < NB * 128 * 2; u += F.G) {
        const int b = u >> 8, c = (u >> 1) & 127, kvh = u & 1;
        __syncthreads();
        const int jmin = c >= 2 ? 0 : (2 - c) * 64;
        for (int i = F.tid; i < 192 * 8; i += 512) { const int j = i >> 3, cc = i & 7;
            if (j >= jmin) { const size_t kt = (size_t)b * SEQ + (c - 2) * 64 + j;
                Ks[i] = *((const GAS v4u*)(z + kt * ZO + OKK + kvh * 64) + cc); Vs[i] = *((const GAS v4u*)(z + kt * ZO + OVV + kvh * 64) + cc); } }
        for (int i = F.tid; i < 8 * 256; i += 512) { const int g = i >> 8, r = i & 255; lut[i] = r < 255 ? ((const GAS float*)tab)[t5_bucket(r - 191) * 28 + 12 + kvh * 8 + g] : 0.f; }
        __syncthreads();
        const int g = F.wave, head = kvh * 8 + g, qi = F.lane;
        const size_t token = (size_t)b * SEQ + c * 64 + qi;
        float q[64], acc[64];
        { const GAS v4u* qp = (const GAS v4u*)(z + token * ZO + OQ + head * 64);
#pragma unroll
          for (int cc = 0; cc < 8; ++cc) { const v4u w = qp[cc]; UNPK8(q, 8 * cc, w); } }
#pragma unroll
        for (int d = 0; d < 64; ++d) acc[d] = 0.f;
        float m = ((const GAS float*)sinks)[head], l = 1.f;
        for (int j = jmin; j < 192; ++j) {
            float s = 0.f;
#pragma unroll
            for (int cc = 0; cc < 8; ++cc) { const v4u w = Ks[j * 8 + cc]; s += DOT8(q, 8 * cc, w); }
            s = s * 0.125f + lut[g * 256 + j + 63 - qi];
            const float mn = fmaxf(m, s), al = __expf(m - mn), p = __expf(s - mn); l = l * al + p; m = mn;
#pragma unroll
            for (int cc = 0; cc < 8; ++cc) { const v4u w = Vs[j * 8 + cc]; AXPY8(acc, 8 * cc, al, p, w); }
        }
        const float inv = 1.f / l;
        GAS v4u* op = (GAS v4u*)(hc + token * HCO + head * 64);
#pragma unroll
        for (int cc = 0; cc < 8; ++cc) { v4u ov; ov.x = pk2(acc[8 * cc] * inv, acc[8 * cc + 1] * inv); ov.y = pk2(acc[8 * cc + 2] * inv, acc[8 * cc + 3] * inv);
            ov.z = pk2(acc[8 * cc + 4] * inv, acc[8 * cc + 5] * inv); ov.w = pk2(acc[8 * cc + 6] * inv, acc[8 * cc + 7] * inv); op[cc] = ov; }
    }
}

constexpr int DLUT = 832, DLUT_OFF = 767;
__device__ __forceinline__ void diff_naive(Frame& F, int e, float lam_init) {
    LAS v4u* Ks = (LAS v4u*)(F.lds); LAS v4u* Vs = (LAS v4u*)(F.lds + 16384); LAS float* lut = (LAS float*)(F.lds + 32768); LAS float* xb = (LAS float*)(F.lds + 36864);
    LAS float* xs = (LAS float*)(F.lds + 36864 + 256 * 65 * 4);
    const bf16* z = (const bf16*)(KWS() + WS_Z); bf16* hc = (bf16*)(KWS() + WS_HC);
    const float* tab = KIN(I_TAB); const float* lamv = KIN(I_ELAM) + e * 256; const float* subln = KIN(I_ESUB) + e * 128;
    float lam;
    { const float a = ((const GAS float*)lamv)[F.lane] * ((const GAS float*)lamv)[64 + F.lane], b2 = ((const GAS float*)lamv)[128 + F.lane] * ((const GAS float*)lamv)[192 + F.lane];
      lam = __expf(wave_sum(a)) - __expf(wave_sum(b2)) + lam_init; }
    for (int u = F.vcu; u < NB * 4 * 64; u += F.G) {
        const int b = u >> 8, h = (u >> 6) & 3, qb = u & 63;
        const int mm = F.tid >> 8, half = (F.tid >> 7) & 1, qi = F.tid & 127, t = qb * 128 + qi, ct = t >> 6;
        const size_t token = (size_t)b * SEQ + t;
        __syncthreads();
        for (int i = F.tid; i < DLUT; i += 512) lut[i] = ((const GAS float*)tab)[t5_bucket(i - DLUT_OFF) * 28 + 8 + h];
        float acc[64]; v4u qpk[8];
        { const GAS v4u* qp = (const GAS v4u*)(z + token * ZE + ZQB + h * 128 + mm * 64);
#pragma unroll
          for (int c = 0; c < 8; ++c) qpk[c] = qp[c]; }
#pragma unroll
        for (int d = 0; d < 64; ++d) acc[d] = 0.f;
        float m = -1e30f, l = 0.f;
        const int ntile = 2 * qb + 2;
        for (int tile = 0; tile < ntile; ++tile) {
            __syncthreads();
            for (int i = F.tid; i < 1024; i += 512) { const int key = i >> 4, c = i & 15; const size_t kt = (size_t)b * SEQ + tile * 64 + key;
                Ks[i] = *((const GAS v4u*)(z + kt * ZE + ZKB + h * 128) + c); Vs[i] = *((const GAS v4u*)(z + kt * ZE + ZVB + h * 128) + c); }
            __syncthreads();
            if (tile <= ct) {
                for (int key = 0; key < 64; ++key) {
                    float s = 0.f;
#pragma unroll
                    for (int c = 0; c < 8; ++c) { const v4u w = Ks[key * 16 + mm * 8 + c]; float qq[8]; UNPK8(qq, 0, qpk[c]); s += DOT8(qq, 0, w); }
                    int rel = tile * 64 + key - t; rel = rel < -DLUT_OFF ? -DLUT_OFF : rel;
                    s = s * 0.125f + lut[rel + DLUT_OFF];
                    const float mn = fmaxf(m, s), al = __expf(m - mn), p = __expf(s - mn); l = l * al + p; m = mn;
#pragma unroll
                    for (int c = 0; c < 8; ++c) { const v4u w = Vs[key * 16 + half * 8 + c]; AXPY8(acc, 8 * c, al, p, w); }
                }
            }
        }
        const float inv = 1.f / l;
#pragma unroll
        for (int d = 0; d < 64; ++d) acc[d] *= inv;
        __syncthreads();
        if (mm == 1) {
#pragma unroll
            for (int d = 0; d < 64; ++d) xb[(half * 128 + qi) * 65 + d] = acc[d]; }
        __syncthreads();
        float ss = 0.f;
        if (mm == 0) {
#pragma unroll
            for (int d = 0; d < 64; ++d) { acc[d] -= lam * xb[(half * 128 + qi) * 65 + d]; ss += acc[d] * acc[d]; }
            xs[half * 128 + qi] = ss; }
        __syncthreads();
        if (mm == 0) {
            ss += xs[(half ^ 1) * 128 + qi];
            const float rr = (1.f / sqrtf(ss * (1.f / 128.f) + EPS)) * (1.f - lam_init);
            GAS v4u* op = (GAS v4u*)(hc + token * HCE + 1024 + h * 128 + half * 64);
#pragma unroll
            for (int c = 0; c < 8; ++c) { const GAS f32x4* sg = (const GAS f32x4*)(subln + half * 64 + 8 * c); const f32x4 g0 = sg[0], g1 = sg[1]; v4u ov;
                ov.x = pk2(acc[8 * c] * rr * g0.x, acc[8 * c + 1] * rr * g0.y); ov.y = pk2(acc[8 * c + 2] * rr * g0.z, acc[8 * c + 3] * rr * g0.w);
                ov.z = pk2(acc[8 * c + 4] * rr * g1.x, acc[8 * c + 5] * rr * g1.y); ov.w = pk2(acc[8 * c + 6] * rr * g1.z, acc[8 * c + 7] * rr * g1.w); op[c] = ov; }
        }
    }
}

typedef short bf16x8_t __attribute__((ext_vector_type(8)));
typedef float f32x16 __attribute__((ext_vector_type(16)));
typedef short v4i16_t __attribute__((ext_vector_type(4)));
constexpr int DK_STR = 272, DV_STR = 320, DSTG = 64 * DK_STR + 64 * DV_STR, D_LUTOFF = 2 * DSTG, D_QOFF = D_LUTOFF + 3328;
static_assert(D_QOFF + 32768 <= RING_BYTES, "diff LDS map");
__device__ __forceinline__ unsigned cvtpk(float lo, float hi) { unsigned r; asm("v_cvt_pk_bf16_f32 %0, %1, %2" : "=v"(r) : "v"(lo), "v"(hi)); return r; }
__device__ __forceinline__ bf16x8_t vtr8(const LAS unsigned char* p0, const LAS unsigned char* p1) {
    const v4i16_t a = __builtin_amdgcn_ds_read_tr16_b64_v4i16((LAS v4i16_t*)p0), b = __builtin_amdgcn_ds_read_tr16_b64_v4i16((LAS v4i16_t*)p1);
    return (bf16x8_t){a[0], a[1], a[2], a[3], b[0], b[1], b[2], b[3]};
}
__device__ __forceinline__ void diff_mfma(Frame& F, int e) {
    const float lam_init = __builtin_bit_cast(float, (unsigned)__builtin_amdgcn_readfirstlane(e == 0 ? 0x3e4ccccd : 0x3ef1014c));
    LAS unsigned char* L = F.lds; LAS float* lut = (LAS float*)(L + D_LUTOFF); LAS float* xbuf = (LAS float*)L;
    const bf16* z = (const bf16*)(KWS() + WS_Z); bf16* hc = (bf16*)(KWS() + WS_HC);
    const float* tab = KIN(I_TAB); const float* lamv = KIN(I_ELAM) + e * 256; const float* subln = KIN(I_ESUB) + e * 128;
    const int w = F.wave, lane = F.lane, r32 = lane & 31, hi = lane >> 5, mm = w >> 2, wq = w & 3;
    float lam;
    { const float a = ((const GAS float*)lamv)[lane] * ((const GAS float*)lamv)[64 + lane], b2 = ((const GAS float*)lamv)[128 + lane] * ((const GAS float*)lamv)[192 + lane];
      lam = __expf(wave_sum(a)) - __expf(wave_sum(b2)) + lam_init; }
    constexpr float C2 = 0.125f * LOG2E;
    const int bh = F.vcu >> 4, su = F.vcu & 15, b = bh >> 2, h = bh & 3;
#pragma unroll 1
    for (int rr = 0; rr < 4; ++rr) {
        const int qb = rr == 0 ? su : rr == 1 ? 31 - su : rr == 2 ? 32 + su : 63 - su;
        const int q0 = qb * 128 + wq * 32, cw = q0 >> 6, NT = 2 * qb + 2, tq = q0 + r32;
        __syncthreads();
        for (int i = F.tid; i < DLUT; i += 512) lut[i] = ((const GAS float*)tab)[t5_bucket(i - DLUT_OFF) * 28 + 8 + h] * LOG2E;
        LAS bf16x8_t* qlds = (LAS bf16x8_t*)(L + D_QOFF) + w * 256 + lane;
        { const bf16* qrow = z + ((size_t)b * SEQ + tq) * ZE + ZQB + h * 128 + mm * 64 + 8 * hi;
#pragma unroll
          for (int ks = 0; ks < 4; ++ks) qlds[ks * 64] = *(const GAS bf16x8_t*)(qrow + 16 * ks); }
        const int k0i = F.tid >> 4, c0 = F.tid & 15;
        const bf16* ksrc = z + ((size_t)b * SEQ + k0i) * ZE + ZKB + h * 128 + c0 * 8;
        const bf16* vsrc = z + ((size_t)b * SEQ + k0i) * ZE + ZVB + h * 128 + c0 * 8;
        const int kdst = k0i * DK_STR + c0 * 16, vdst = 64 * DK_STR + k0i * DV_STR + c0 * 16;
        v4u pk0, pk1, pv0, pv1;
        pk0 = *(const GAS v4u*)(ksrc); pk1 = *(const GAS v4u*)(ksrc + (size_t)32 * ZE); pv0 = *(const GAS v4u*)(vsrc); pv1 = *(const GAS v4u*)(vsrc + (size_t)32 * ZE);
        *(LAS v4u*)(L + kdst) = pk0; *(LAS v4u*)(L + kdst + 32 * DK_STR) = pk1; *(LAS v4u*)(L + vdst) = pv0; *(LAS v4u*)(L + vdst + 32 * DV_STR) = pv1;
        __syncthreads();
        f32x16 o[4];
#pragma unroll
        for (int i = 0; i < 4; ++i)
#pragma unroll
            for (int r = 0; r < 16; ++r) o[i][r] = 0.f;
        float m_run = -1e30f, l_run = 0.f;
        const int ka = r32 * DK_STR + (mm * 64 + 8 * hi) * 2;
        const int va = (4 * hi + ((lane & 15) >> 2)) * DV_STR + (16 * ((lane >> 4) & 1) + 4 * (lane & 3)) * 2;
#pragma unroll 1
        for (int t = 0; t < NT; ++t) {
            const int stg = (t & 1) * DSTG;
            if (t + 1 < NT) { const size_t off = (size_t)(t + 1) * 64 * ZE;
                pk0 = *(const GAS v4u*)(ksrc + off); pk1 = *(const GAS v4u*)(ksrc + off + (size_t)32 * ZE); pv0 = *(const GAS v4u*)(vsrc + off); pv1 = *(const GAS v4u*)(vsrc + off + (size_t)32 * ZE); }
            if (t <= cw) {
                const LAS unsigned char* Kb = L + stg + ka; const LAS unsigned char* Vb = L + stg + 64 * DK_STR + va;
                f32x16 s0, s1; bf16x8_t qf[4];
#pragma unroll
                for (int ks = 0; ks < 4; ++ks) qf[ks] = qlds[ks * 64];
#pragma unroll
                for (int r = 0; r < 16; ++r) { s0[r] = 0.f; s1[r] = 0.f; }
#pragma unroll
                for (int ks = 0; ks < 4; ++ks) { const bf16x8_t a0 = *(const LAS bf16x8_t*)(Kb + ks * 32), a1 = *(const LAS bf16x8_t*)(Kb + 32 * DK_STR + ks * 32);
                    s0 = __builtin_amdgcn_mfma_f32_32x32x16_bf16(a0, qf[ks], s0, 0, 0, 0); s1 = __builtin_amdgcn_mfma_f32_32x32x16_bf16(a1, qf[ks], s1, 0, 0, 0); }
                if (64 * t + 622 > q0) {
                    const LAS float* lp = lut + (64 * t - tq + DLUT_OFF + 4 * hi);
#pragma unroll
                    for (int r = 0; r < 16; ++r) { const int ko = (r & 3) + 8 * (r >> 2); s0[r] = s0[r] * C2 + lp[ko]; s1[r] = s1[r] * C2 + lp[ko + 32]; }
                } else { const float bf = lut[0];
#pragma unroll
                    for (int r = 0; r < 16; ++r) { s0[r] = s0[r] * C2 + bf; s1[r] = s1[r] * C2 + bf; } }
                float mx = fmaxf(s0[0], s1[0]);
#pragma unroll
                for (int r = 1; r < 16; ++r) mx = fmaxf(mx, fmaxf(s0[r], s1[r]));
                mx = fmaxf(mx, __shfl_xor(mx, 32));
                if (__any(mx > m_run)) { const float mn = fmaxf(m_run, mx), al = __builtin_amdgcn_exp2f(m_run - mn); m_run = mn; l_run *= al;
#pragma unroll
                    for (int i = 0; i < 4; ++i)
#pragma unroll
                        for (int r = 0; r < 16; ++r) o[i][r] *= al; }
                float ps = 0.f;
#pragma unroll
                for (int r = 0; r < 16; ++r) { s0[r] = __builtin_amdgcn_exp2f(s0[r] - m_run); s1[r] = __builtin_amdgcn_exp2f(s1[r] - m_run); ps += s0[r] + s1[r]; }
                l_run += ps;
                bf16x8_t pf[4];
#pragma unroll
                for (int k2 = 0; k2 < 2; ++k2) {
                    v4u a; a.x = cvtpk(s0[8 * k2], s0[8 * k2 + 1]); a.y = cvtpk(s0[8 * k2 + 2], s0[8 * k2 + 3]); a.z = cvtpk(s0[8 * k2 + 4], s0[8 * k2 + 5]); a.w = cvtpk(s0[8 * k2 + 6], s0[8 * k2 + 7]);
                    v4u c; c.x = cvtpk(s1[8 * k2], s1[8 * k2 + 1]); c.y = cvtpk(s1[8 * k2 + 2], s1[8 * k2 + 3]); c.z = cvtpk(s1[8 * k2 + 4], s1[8 * k2 + 5]); c.w = cvtpk(s1[8 * k2 + 6], s1[8 * k2 + 7]);
                    pf[k2] = __builtin_bit_cast(bf16x8_t, a); pf[2 + k2] = __builtin_bit_cast(bf16x8_t, c); }
#pragma unroll
                for (int blk = 0; blk < 4; ++blk)
#pragma unroll
                    for (int kk = 0; kk < 4; ++kk) {
                        const LAS unsigned char* vp = Vb + kk * 16 * DV_STR + blk * 64;
                        const bf16x8_t vf = vtr8(vp, vp + 8 * DV_STR);
                        o[blk] = __builtin_amdgcn_mfma_f32_32x32x16_bf16(vf, pf[kk], o[blk], 0, 0, 0); }
            }
            if (t + 1 < NT) { const int s2 = ((t + 1) & 1) * DSTG;
                *(LAS v4u*)(L + s2 + kdst) = pk0; *(LAS v4u*)(L + s2 + kdst + 32 * DK_STR) = pk1; *(LAS v4u*)(L + s2 + vdst) = pv0; *(LAS v4u*)(L + s2 + vdst + 32 * DV_STR) = pv1; }
            __syncthreads();
        }
        const float linv = 1.f / (l_run + __shfl_xor(l_run, 32));
        if (mm == 1) {
#pragma unroll
            for (int blk = 0; blk < 4; ++blk)
#pragma unroll
                for (int r = 0; r < 16; ++r) xbuf[(wq * 64 + blk * 16 + r) * 64 + lane] = o[blk][r] * linv; }
        __syncthreads();
        if (mm == 0) {
            float ss = 0.f;
#pragma unroll
            for (int blk = 0; blk < 4; ++blk)
#pragma unroll
                for (int r = 0; r < 16; ++r) { const float d = o[blk][r] * linv - lam * xbuf[(wq * 64 + blk * 16 + r) * 64 + lane]; o[blk][r] = d; ss += d * d; }
            ss += __shfl_xor(ss, 32);
            const float rn = (1.f / sqrtf(ss * (1.f / 128.f) + EPS)) * (1.f - lam_init);
            bf16* orow = hc + ((size_t)b * SEQ + tq) * HCE + 1024 + h * 128 + 4 * hi;
#pragma unroll
            for (int blk = 0; blk < 4; ++blk)
#pragma unroll
                for (int a = 0; a < 4; ++a) { const f32x4 g = *(const GAS f32x4*)(subln + 32 * blk + 8 * a + 4 * hi); v2u ov;
                    ov.x = pk2(o[blk][4 * a] * rn * g.x, o[blk][4 * a + 1] * rn * g.y); ov.y = pk2(o[blk][4 * a + 2] * rn * g.z, o[blk][4 * a + 3] * rn * g.w);
                    *(GAS v2u*)(orow + 32 * blk + 8 * a) = ov; }
        }
    }
}

template <int NBLK, int KSTR, int VSTR, bool BIAS>
__device__ __forceinline__ void attn_step64(const LAS unsigned char* Kb, const LAS unsigned char* Vb, const bf16x8_t (&qf)[4], const LAS float* lp, f32x16 (&o)[NBLK], float& m_run, float& l_run) {
    constexpr float C2 = 0.125f * LOG2E;
    f32x16 s0, s1;
#pragma unroll
    for (int r = 0; r < 16; ++r) { s0[r] = 0.f; s1[r] = 0.f; }
#pragma unroll
    for (int ks = 0; ks < 4; ++ks) { const bf16x8_t a0 = *(const LAS bf16x8_t*)(Kb + ks * 32), a1 = *(const LAS bf16x8_t*)(Kb + 32 * KSTR + ks * 32);
        s0 = __builtin_amdgcn_mfma_f32_32x32x16_bf16(a0, qf[ks], s0, 0, 0, 0); s1 = __builtin_amdgcn_mfma_f32_32x32x16_bf16(a1, qf[ks], s1, 0, 0, 0); }
    if (BIAS) {
#pragma unroll
        for (int r = 0; r < 16; ++r) { const int ko = (r & 3) + 8 * (r >> 2); s0[r] = s0[r] * C2 + lp[ko]; s1[r] = s1[r] * C2 + lp[ko + 32]; }
    } else {
#pragma unroll
        for (int r = 0; r < 16; ++r) { s0[r] *= C2; s1[r] *= C2; } }
    float mx = fmaxf(s0[0], s1[0]);
#pragma unroll
    for (int r = 1; r < 16; ++r) mx = fmaxf(mx, fmaxf(s0[r], s1[r]));
    mx = fmaxf(mx, __shfl_xor(mx, 32));
    if (__any(mx > m_run)) { const float mn = fmaxf(m_run, mx), al = __builtin_amdgcn_exp2f(m_run - mn); m_run = mn; l_run *= al;
#pragma unroll
        for (int i = 0; i < NBLK; ++i)
#pragma unroll
            for (int r = 0; r < 16; ++r) o[i][r] *= al; }
    float ps = 0.f;
#pragma unroll
    for (int r = 0; r < 16; ++r) { s0[r] = __builtin_amdgcn_exp2f(s0[r] - m_run); s1[r] = __builtin_amdgcn_exp2f(s1[r] - m_run); ps += s0[r] + s1[r]; }
    l_run += ps;
    bf16x8_t pf[4];
#pragma unroll
    for (int k2 = 0; k2 < 2; ++k2) {
        v4u a; a.x = cvtpk(s0[8 * k2], s0[8 * k2 + 1]); a.y = cvtpk(s0[8 * k2 + 2], s0[8 * k2 + 3]); a.z = cvtpk(s0[8 * k2 + 4], s0[8 * k2 + 5]); a.w = cvtpk(s0[8 * k2 + 6], s0[8 * k2 + 7]);
        v4u c; c.x = cvtpk(s1[8 * k2], s1[8 * k2 + 1]); c.y = cvtpk(s1[8 * k2 + 2], s1[8 * k2 + 3]); c.z = cvtpk(s1[8 * k2 + 4], s1[8 * k2 + 5]); c.w = cvtpk(s1[8 * k2 + 6], s1[8 * k2 + 7]);
        pf[k2] = __builtin_bit_cast(bf16x8_t, a); pf[2 + k2] = __builtin_bit_cast(bf16x8_t, c); }
#pragma unroll
    for (int blk = 0; blk < NBLK; ++blk)
#pragma unroll
        for (int kk = 0; kk < 4; ++kk) { const LAS unsigned char* vp = Vb + kk * 16 * VSTR + blk * 64; const bf16x8_t vf = vtr8(vp, vp + 8 * VSTR);
            o[blk] = __builtin_amdgcn_mfma_f32_32x32x16_bf16(vf, pf[kk], o[blk], 0, 0, 0); }
}
constexpr int A_KSTR = 144, A_VSTR = 192;

__device__ __forceinline__ void xattn_mfma(Frame& F) {
    LAS unsigned char* L = F.lds; constexpr int KOFF = 0, VOFF = 256 * A_KSTR;
    const bf16* kvm = (const bf16*)(KWS() + WS_KVM); const bf16* qx = (const bf16*)(KWS() + WS_QX); bf16* ox = (bf16*)(KWS() + WS_OX);
    const int w = F.wave, lane = F.lane, r32 = lane & 31, hi = lane >> 5;
    for (int u = F.vcu; u < NB * 4 * 32; u += F.G) {
        const int b = u >> 7, h = (u >> 5) & 3, blk = u & 31;
        __syncthreads();
        for (int i = F.tid; i < 2048; i += 512) { const int key = i >> 3, c = i & 7;
            const GAS v4u* src = (const GAS v4u*)(kvm + (size_t)(b * NMEM + key) * 512 + h * 64) + c;
            *(LAS v4u*)(L + KOFF + key * A_KSTR + c * 16) = src[0]; *(LAS v4u*)(L + VOFF + key * A_VSTR + c * 16) = src[32]; }
        const size_t token = (size_t)b * SEQ + blk * 256 + w * 32 + r32;
        bf16x8_t qf[4];
#pragma unroll
        for (int ks = 0; ks < 4; ++ks) qf[ks] = *(const GAS bf16x8_t*)(qx + token * 256 + h * 64 + 16 * ks + 8 * hi);
        __syncthreads();
        f32x16 o[2];
#pragma unroll
        for (int i = 0; i < 2; ++i)
#pragma unroll
            for (int r = 0; r < 16; ++r) o[i][r] = 0.f;
        float m_run = -1e30f, l_run = 0.f;
        const LAS unsigned char* Kb = L + KOFF + r32 * A_KSTR + 16 * hi;
        const LAS unsigned char* Vb = L + VOFF + (4 * hi + ((lane & 15) >> 2)) * A_VSTR + (16 * ((lane >> 4) & 1) + 4 * (lane & 3)) * 2;
#pragma unroll 1
        for (int t = 0; t < 4; ++t) attn_step64<2, A_KSTR, A_VSTR, false>(Kb + t * 64 * A_KSTR, Vb + t * 64 * A_VSTR, qf, nullptr, o, m_run, l_run);
        const float inv = 1.f / (l_run + __shfl_xor(l_run, 32));
        bf16* orow = ox + token * 256 + h * 64 + 4 * hi;
#pragma unroll
        for (int bk = 0; bk < 2; ++bk)
#pragma unroll
            for (int a = 0; a < 4; ++a) { v2u ov; ov.x = pk2(o[bk][4 * a] * inv, o[bk][4 * a + 1] * inv); ov.y = pk2(o[bk][4 * a + 2] * inv, o[bk][4 * a + 3] * inv); *(GAS v2u*)(orow + 32 * bk + 8 * a) = ov; }
    }
}

__device__ __forceinline__ void swa_mfma(Frame& F, int oi) {
    LAS unsigned char* L = F.lds; constexpr int KOFF = 0, VOFF = 192 * A_KSTR, LOFF = VOFF + 192 * A_VSTR;
    LAS float* lut = (LAS float*)(L + LOFF);
    const bf16* z = (const bf16*)(KWS() + WS_Z); bf16* hc = (bf16*)(KWS() + WS_HC);
    const float* tab = KIN(I_TAB); const float* sinks = KIN(I_OSINK) + oi * 16;
    const int w = F.wave, lane = F.lane, r32 = lane & 31, hi = lane >> 5;
    for (int u = F.vcu; u < NB * 128 * 2; u += F.G) {
        const int b = u >> 8, c = (u >> 1) & 127, kvh = u & 1;
        __syncthreads();
        const int jmin = c >= 2 ? 0 : (2 - c) * 64;
        for (int i = F.tid; i < 192 * 8; i += 512) { const int j = i >> 3, cc = i & 7;
            if (j >= jmin) { const size_t kt = (size_t)b * SEQ + (c - 2) * 64 + j;
                *(LAS v4u*)(L + KOFF + j * A_KSTR + cc * 16) = *((const GAS v4u*)(z + kt * ZO + OKK + kvh * 64) + cc);
                *(LAS v4u*)(L + VOFF + j * A_VSTR + cc * 16) = *((const GAS v4u*)(z + kt * ZO + OVV + kvh * 64) + cc); } }
        for (int i = F.tid; i < 8 * 256; i += 512) { const int g = i >> 8, r = i & 255; lut[i] = r < 255 ? ((const GAS float*)tab)[t5_bucket(r - 191) * 28 + 12 + kvh * 8 + g] * LOG2E : 0.f; }
        __syncthreads();
        const int head = kvh * 8 + w;
        const float sk = ((const GAS float*)sinks)[head] * LOG2E;
#pragma unroll 1
        for (int qb2 = 0; qb2 < 2; ++qb2) {
            const int qi = qb2 * 32 + r32; const size_t token = (size_t)b * SEQ + c * 64 + qi;
            bf16x8_t qf[4];
#pragma unroll
            for (int ks = 0; ks < 4; ++ks) qf[ks] = *(const GAS bf16x8_t*)(z + token * ZO + OQ + head * 64 + 16 * ks + 8 * hi);
            f32x16 o[2];
#pragma unroll
            for (int i = 0; i < 2; ++i)
#pragma unroll
                for (int r = 0; r < 16; ++r) o[i][r] = 0.f;
            float m_run = sk, l_run = hi == 0 ? 1.f : 0.f;
            const LAS unsigned char* Kb = L + KOFF + r32 * A_KSTR + 16 * hi;
            const LAS unsigned char* Vb = L + VOFF + (4 * hi + ((lane & 15) >> 2)) * A_VSTR + (16 * ((lane >> 4) & 1) + 4 * (lane & 3)) * 2;
#pragma unroll 1
            for (int t = (c >= 2 ? 0 : 2 - c); t < 3; ++t)
                attn_step64<2, A_KSTR, A_VSTR, true>(Kb + t * 64 * A_KSTR, Vb + t * 64 * A_VSTR, qf, lut + w * 256 + 64 * t + 4 * hi + 63 - qi, o, m_run, l_run);
            const float inv = 1.f / (l_run + __shfl_xor(l_run, 32));
            bf16* orow = hc + token * HCO + head * 64 + 4 * hi;
#pragma unroll
            for (int bk = 0; bk < 2; ++bk)
#pragma unroll
                for (int a = 0; a < 4; ++a) { v2u ov; ov.x = pk2(o[bk][4 * a] * inv, o[bk][4 * a + 1] * inv); ov.y = pk2(o[bk][4 * a + 2] * inv, o[bk][4 * a + 3] * inv); *(GAS v2u*)(orow + 32 * bk + 8 * a) = ov; }
        }
    }
}

constexpr int TOPK = 256, CANDMAX = 512;
constexpr int DL_SEL = 0;
constexpr int DL_CNT = 16384;
constexpr int DL_AFL = DL_SEL;
constexpr int DL_WI2 = 16384 + 256;
constexpr int DL_W = 17408;
constexpr int DL_QI = DL_W;
constexpr int DL_WI = DL_W + 32768;
constexpr int DL_HIST = DL_W;
constexpr int DL_CAND = DL_W + 65536;
constexpr int DL_FB = 0;
constexpr int DL_QL = DL_W;
constexpr int DL_P = DL_W + 32768;
static_assert(DL_CAND + 8 * 704 * 8 <= RING_BYTES && DL_P + 65536 <= RING_BYTES, "DSA LDS map");

__device__ __forceinline__ unsigned fkey(float f) { const unsigned u = __builtin_bit_cast(unsigned, f); return (u & 0x80000000u) ? ~u : (u | 0x80000000u); }

__device__ __forceinline__ void indexer_naive(Frame& F, int b, int t0, int N, float* scr) {
    LAS float* qi = (LAS float*)(F.lds + DL_QI); LAS float* wi = (LAS float*)(F.lds + DL_WI);
    const bf16* z = (const bf16*)(KWS() + WS_Z);
    for (int i = F.tid; i < 16 * 64; i += 512) { const int q = i >> 6, c = i & 63;
        const v4u w = *((const GAS v4u*)(z + ((size_t)b * SEQ + t0 + q) * ZE + ZQI) + c); float v[8]; UNPK8(v, 0, w);
#pragma unroll
        for (int k = 0; k < 8; ++k) qi[q * 512 + c * 8 + k] = v[k]; }
    if (F.tid < 128) { const int q = F.tid >> 3, hh = F.tid & 7; wi[F.tid] = bf2f(((const GAS bf16*)z)[((size_t)b * SEQ + t0 + q) * ZE + ZWI + hh]); }
    __syncthreads();
    for (int s = F.tid; s < N; s += 512) {
        float k[64];
        { const GAS v4u* kp = (const GAS v4u*)(z + ((size_t)b * SEQ + s) * ZE + ZKI);
#pragma unroll
          for (int c = 0; c < 8; ++c) { const v4u w = kp[c]; UNPK8(k, 8 * c, w); } }
        for (int q = 0; q < 16; ++q) {
            float acc = 0.f;
#pragma unroll
            for (int hh = 0; hh < 8; ++hh) {
                const LAS f32x4* qp = (const LAS f32x4*)(qi + q * 512 + hh * 64); float dsum = 0.f;
#pragma unroll
                for (int c = 0; c < 16; ++c) { const f32x4 qq = qp[c]; dsum += (qq.x * k[4 * c] + qq.y * k[4 * c + 1]) + (qq.z * k[4 * c + 2] + qq.w * k[4 * c + 3]); }
                acc = fmaf(wi[q * 8 + hh], fmaxf(dsum, 0.f), acc);
            }
            ((GAS float*)scr)[(size_t)q * SEQ + s] = acc;
        }
    }
}

__device__ __forceinline__ void indexer_mfma(Frame& F, int b, int t0, int N, float* scr, LAS unsigned* hist16) {
    const int w = F.wave, lane = F.lane, n = lane & 31, hi = lane >> 5, g = w & 3, kp = w >> 2;
    const bf16* z = (const bf16*)(KWS() + WS_Z);
    bf16x8_t af[4];
    { const bf16* qrow = z + ((size_t)b * SEQ + t0 + 4 * g + (n >> 3)) * ZE + ZQI + (n & 7) * 64 + 8 * hi;
#pragma unroll
      for (int ks = 0; ks < 4; ++ks) af[ks] = *(const GAS bf16x8_t*)(qrow + 16 * ks); }
    float wv[16];
#pragma unroll
    for (int r = 0; r < 16; ++r) wv[r] = bf2f(((const GAS bf16*)z)[((size_t)b * SEQ + t0 + 4 * g + (r >> 2)) * ZE + ZWI + 4 * hi + (r & 3)]);
    const bf16* kbase = z + ((size_t)b * SEQ + n) * ZE + ZKI + 8 * hi;
    const int nsub = N >> 5;
    bf16x8_t bfr[4], bnx[4];
    int j = kp;
    if (j < nsub) {
#pragma unroll
        for (int ks = 0; ks < 4; ++ks) bfr[ks] = *(const GAS bf16x8_t*)(kbase + (size_t)(32 * j) * ZE + 16 * ks); }
    float* sbase = scr + (size_t)(4 * g + 2 * hi) * SEQ + n;
    LAS unsigned* hq = hist16 + (4 * g + 2 * hi) * 1024;
#pragma unroll 1
    for (; j < nsub; j += 2) {
        const int jn = j + 2;
        if (jn < nsub) {
#pragma unroll
            for (int ks = 0; ks < 4; ++ks) bnx[ks] = *(const GAS bf16x8_t*)(kbase + (size_t)(32 * jn) * ZE + 16 * ks); }
        f32x16 c;
#pragma unroll
        for (int r = 0; r < 16; ++r) c[r] = 0.f;
#pragma unroll
        for (int ks = 0; ks < 4; ++ks) c = __builtin_amdgcn_mfma_f32_32x32x16_bf16(af[ks], bfr[ks], c, 0, 0, 0);
        float tot[4];
#pragma unroll
        for (int qi = 0; qi < 4; ++qi) { float p = 0.f;
#pragma unroll
            for (int i = 0; i < 4; ++i) p = fmaf(wv[4 * qi + i], fmaxf(c[4 * qi + i], 0.f), p);
            tot[qi] = p + __shfl_xor(p, 32); }
        const float sa = hi ? tot[2] : tot[0], sb = hi ? tot[3] : tot[1];
        ((GAS float*)sbase)[32 * j] = sa; ((GAS float*)sbase)[32 * j + SEQ] = sb;
        { const unsigned ba = fkey(sa) >> 21, bb = fkey(sb) >> 21;
          __hip_atomic_fetch_add(hq + (ba >> 1), 1u << (16 * (ba & 1)), __ATOMIC_RELAXED, __HIP_MEMORY_SCOPE_WORKGROUP);
          __hip_atomic_fetch_add(hq + 1024 + (bb >> 1), 1u << (16 * (bb & 1)), __ATOMIC_RELAXED, __HIP_MEMORY_SCOPE_WORKGROUP); }
#pragma unroll
        for (int ks = 0; ks < 4; ++ks) bfr[ks] = bnx[ks];
    }
}

__device__ __forceinline__ float relu_i(float x) { const int b = __builtin_bit_cast(int, x); return __builtin_bit_cast(float, b > 0 ? b : 0); }
#define RELU(x) relu_i(x)
__device__ __forceinline__ void idx_body(const LAS bf16x8_t* afl, const bf16x8_t (&bq)[4], const LAS f32x4* wl, float* scr, unsigned so, LAS unsigned* hq, int j, int hi) {
#pragma unroll
    for (int g = 0; g < 4; ++g) {
        f32x16 c;
#pragma unroll
        for (int rr = 0; rr < 16; ++rr) c[rr] = 0.f;
#pragma unroll
        for (int ks = 0; ks < 4; ++ks) c = __builtin_amdgcn_mfma_f32_32x32x16_bf16(afl[(g * 4 + ks) * 64], bq[ks], c, 0, 0, 0);
        float tot[4];
#pragma unroll
        for (int qi = 0; qi < 4; ++qi) { float p = 0.f; const f32x4 wq4 = wl[(4 * g + qi) * 2];
            p = fmaf(wq4.x, RELU(c[4 * qi]), p); p = fmaf(wq4.y, RELU(c[4 * qi + 1]), p);
            p = fmaf(wq4.z, RELU(c[4 * qi + 2]), p); p = fmaf(wq4.w, RELU(c[4 * qi + 3]), p);
            tot[qi] = p + __shfl_xor(p, 32); }
        const float sa = hi ? tot[2] : tot[0], sb = hi ? tot[3] : tot[1];
        ((GAS float*)scr)[so + (unsigned)((4 * g) * SEQ + 32 * j)] = sa; ((GAS float*)scr)[so + (unsigned)((4 * g + 1) * SEQ + 32 * j)] = sb;
        { const unsigned ba = fkey(sa) >> 21, bb = fkey(sb) >> 21;
          __hip_atomic_fetch_add(hq + (4 * g) * 1024 + (ba >> 1), 1u << (16 * (ba & 1)), __ATOMIC_RELAXED, __HIP_MEMORY_SCOPE_WORKGROUP);
          __hip_atomic_fetch_add(hq + (4 * g + 1) * 1024 + (bb >> 1), 1u << (16 * (bb & 1)), __ATOMIC_RELAXED, __HIP_MEMORY_SCOPE_WORKGROUP); }
        __builtin_amdgcn_sched_barrier(0);
    }
}
__device__ __forceinline__ void indexer_mfma2(Frame& F, int b, int t0, int N, float* scr, LAS unsigned* hist16) {
    const int w = F.wave, lane = F.lane, n = lane & 31, hi = lane >> 5;
    const bf16* z = (const bf16*)(KWS() + WS_Z);
    const LAS f32x4* wl = (const LAS f32x4*)(F.lds + DL_WI2) + hi; const LAS bf16x8_t* afl = (const LAS bf16x8_t*)(F.lds + DL_AFL) + lane;
    const bf16* kbase = z + ((size_t)b * SEQ + n) * ZE + ZKI + 8 * hi;
    const int nsub = N >> 5, last = nsub - 1;
    const unsigned so = (unsigned)((2 * hi) * SEQ + n);
    LAS unsigned* hq = hist16 + (2 * hi) * 1024;
    bf16x8_t fa[4], fb[4];
#define IDX_LD(dst, jj) do { const int jc_ = (jj) < last ? (jj) : last; _Pragma("unroll") for (int ks = 0; ks < 4; ++ks) dst[ks] = *(const GAS bf16x8_t*)(kbase + (size_t)(32 * jc_) * ZE + 16 * ks); } while (0)
    int j = w;
    if (j < nsub) {
        IDX_LD(fa, j);
#pragma unroll 1
        for (; j + 8 < nsub; j += 16) {
            IDX_LD(fb, j + 8);
            idx_body(afl, fa, wl, scr, so, hq, j, hi);
            IDX_LD(fa, j + 16);
            idx_body(afl, fb, wl, scr, so, hq, j + 8, hi);
        }
        if (j < nsub) idx_body(afl, fa, wl, scr, so, hq, j, hi);
    }
#undef IDX_LD
}

__device__ __forceinline__ int find_bin(LAS unsigned* hist, int lane, unsigned target, unsigned& above) {
    unsigned ls = 0;
#pragma unroll 8
    for (int j = 0; j < 32; ++j) ls += hist[32 * lane + j];
    unsigned suf = ls;
#pragma unroll
    for (int o = 1; o < 64; o <<= 1) { const unsigned t = __shfl_down(suf, o); if (lane + o < 64) suf += t; }
    const unsigned long long mk = __ballot(suf >= target);
    const int L = 63 - __builtin_clzll(mk);
    unsigned cum = __shfl(suf, L) - __shfl(ls, L);
    int bsel = 32 * L;
    for (int j = 31; j >= 0; --j) { const unsigned c = hist[32 * L + j]; if (cum + c >= target) { bsel = 32 * L + j; break; } cum += c; }
    above = cum; return bsel;
}

__device__ __forceinline__ int select_topk(const float* row, int N, LAS int* sel, LAS unsigned* hist, LAS unsigned long long* cand, int lane) {
    if (N <= TOPK) { for (int i = lane; i < N; i += 64) sel[i] = i; LDS_WAIT(); return N; }
    const GAS float* r = (const GAS float*)row;
    const unsigned long long lt = (1ull << lane) - 1ull;
    for (int i = lane; i < 2048; i += 64) hist[i] = 0u;
    LDS_WAIT();
    for (int i = lane; i < N; i += 64) { const unsigned u = fkey(r[i]); __hip_atomic_fetch_add(hist + (u >> 21), 1u, __ATOMIC_RELAXED, __HIP_MEMORY_SCOPE_WORKGROUP); }
    LDS_WAIT();
    unsigned above; const unsigned b0 = (unsigned)find_bin(hist, lane, TOPK, above);
    unsigned need = TOPK - above;
    unsigned nsel = 0, nc = 0;
    for (int i0 = 0; i0 < N; i0 += 64) { const int i = i0 + lane; const unsigned u = fkey(r[i]); const unsigned bin = u >> 21;
        const bool ab = bin > b0, eq = bin == b0; const unsigned long long ma = __ballot(ab), me = __ballot(eq);
        { const unsigned pa = nsel + __builtin_popcountll(ma & lt); if (ab && pa < TOPK) sel[pa] = i; }
        const unsigned pe = nc + __builtin_popcountll(me & lt);
        if (eq && pe < CANDMAX) cand[pe] = ((unsigned long long)u << 32) | (unsigned)i;
        nsel += __builtin_popcountll(ma); nc += __builtin_popcountll(me); }
    LDS_WAIT();
    if (nc <= CANDMAX) {
        for (unsigned ci = lane; ci < nc; ci += 64) { const unsigned long long me = cand[ci]; const unsigned ui = (unsigned)(me >> 32), ii = (unsigned)me; unsigned rank = 0;
            for (unsigned j = 0; j < nc; ++j) { const unsigned long long o = cand[j]; const unsigned uj = (unsigned)(o >> 32), ij = (unsigned)o; rank += (uj > ui || (uj == ui && ij < ii)) ? 1u : 0u; }
            if (rank < need && above + rank < TOPK) sel[above + rank] = (int)ii; }
    } else {
        for (int i = lane; i < 2048; i += 64) hist[i] = 0u;
        LDS_WAIT();
        for (int i = lane; i < N; i += 64) { const unsigned u = fkey(r[i]); if ((u >> 21) == b0) __hip_atomic_fetch_add(hist + ((u >> 10) & 0x7ffu), 1u, __ATOMIC_RELAXED, __HIP_MEMORY_SCOPE_WORKGROUP); }
        LDS_WAIT();
        unsigned ab1; const unsigned b1 = (unsigned)find_bin(hist, lane, need, ab1); const unsigned need1 = need - ab1;
        const unsigned pre = (b0 << 11) | b1;
        for (int i = lane; i < 2048; i += 64) hist[i] = 0u;
        LDS_WAIT();
        for (int i = lane; i < N; i += 64) { const unsigned u = fkey(r[i]); if ((u >> 10) == pre) __hip_atomic_fetch_add(hist + (u & 0x3ffu), 1u, __ATOMIC_RELAXED, __HIP_MEMORY_SCOPE_WORKGROUP); }
        LDS_WAIT();
        unsigned ab2; const unsigned b2 = (unsigned)find_bin(hist, lane, need1, ab2); const unsigned need2 = need1 - ab2;
        const unsigned ustar = (pre << 10) | b2;
        unsigned pos = above, neq = 0;
        for (int i0 = 0; i0 < N; i0 += 64) { const int i = i0 + lane; const unsigned u = fkey(r[i]); const bool inb = (u >> 21) == b0;
            const bool gt = inb && u > ustar, eq = inb && u == ustar; const unsigned long long mg = __ballot(gt), me = __ballot(eq);
            const unsigned re = neq + __builtin_popcountll(me & lt);
            const bool take_eq = eq && re < need2; const unsigned long long mt = __ballot(take_eq);
            const unsigned long long mall = mg | mt;
            { const unsigned pp = pos + __builtin_popcountll(mall & lt); if ((gt || take_eq) && pp < TOPK) sel[pp] = i; }
            pos += __builtin_popcountll(mall); neq += __builtin_popcountll(me); }
    }
    LDS_WAIT();
    return TOPK;
}

__device__ __forceinline__ int find_bin16(const LAS unsigned* h16, int lane, unsigned target, unsigned& above) {
    unsigned ls = 0;
#pragma unroll
    for (int j = 0; j < 16; ++j) { const unsigned wv = h16[16 * lane + j]; ls += (wv & 0xffffu) + (wv >> 16); }
    unsigned suf = ls;
#pragma unroll
    for (int o = 1; o < 64; o <<= 1) { const unsigned t = __shfl_down(suf, o); if (lane + o < 64) suf += t; }
    const unsigned long long mk = __ballot(suf >= target);
    const int L = mk ? 63 - __builtin_clzll(mk) : 0;
    unsigned cum = __shfl(suf, L) - __shfl(ls, L);
    int bsel = 32 * L;
    for (int j = 31; j >= 0; --j) { const unsigned wv = h16[16 * L + (j >> 1)]; const unsigned c = (j & 1) ? (wv >> 16) : (wv & 0xffffu); if (cum + c >= target) { bsel = 32 * L + j; break; } cum += c; }
    above = cum; return bsel;
}
__device__ __forceinline__ unsigned lane_prefix(unsigned long long m) { return __builtin_amdgcn_mbcnt_hi((unsigned)(m >> 32), __builtin_amdgcn_mbcnt_lo((unsigned)m, 0u)); }
constexpr int LISTMAX = 704;
__device__ __forceinline__ int select_topk2(const float* row, int N, LAS int* sel, LAS unsigned* h16, LAS unsigned long long* cand, int lane) {
    if (N <= TOPK) { for (int i = lane; i < N; i += 64) sel[i] = i; LDS_WAIT(); return N; }
    const GAS float* r = (const GAS float*)row;
    const unsigned long long lt = (1ull << lane) - 1ull;
    unsigned above; const unsigned b0 = (unsigned)find_bin16(h16, lane, TOPK, above);
    const unsigned need = TOPK - above;
    unsigned nl = 0;
    float v[16], vn[16];
#pragma unroll
    for (int k = 0; k < 16; ++k) { const int i = 64 * k + lane; v[k] = i < N ? r[i] : -INFINITY; }
#pragma unroll 1
    for (int i0 = 0; i0 < N; i0 += 1024) {
        if (i0 + 1024 < N) {
#pragma unroll
            for (int k = 0; k < 16; ++k) { const int i = i0 + 1024 + 64 * k + lane; vn[k] = i < N ? r[i] : -INFINITY; } }
#pragma unroll
        for (int k = 0; k < 16; ++k) { const unsigned u = fkey(v[k]); const bool ge = (u >> 21) >= b0; const unsigned long long mg = __ballot(ge);
            const unsigned pp = nl + lane_prefix(mg);
            if (ge && pp < LISTMAX) cand[pp] = ((unsigned long long)u << 32) | (unsigned)(i0 + 64 * k + lane);
            nl += __builtin_popcountll(mg); }
#pragma unroll
        for (int k = 0; k < 16; ++k) v[k] = vn[k];
    }
    LDS_WAIT();
    if (nl <= LISTMAX) {
        unsigned cu[11], cidx[11];
#pragma unroll
        for (int k = 0; k < 11; ++k) { const unsigned ci = lane + 64 * k; const unsigned long long me = ci < nl ? cand[ci] : 0ull; cu[k] = (unsigned)(me >> 32); cidx[k] = (unsigned)me; }
        unsigned ustar = b0 << 21;
#pragma unroll 1
        for (int bit = 20; bit >= 0; --bit) { const unsigned trial = ustar | (1u << bit); unsigned c = 0;
#pragma unroll
            for (int k = 0; k < 11; ++k) c += __builtin_popcountll(__ballot(cu[k] >= trial));
            if (c >= TOPK) ustar = trial; }
        unsigned cgt = 0;
#pragma unroll
        for (int k = 0; k < 11; ++k) cgt += __builtin_popcountll(__ballot(cu[k] > ustar));
        const unsigned need_eq = TOPK - cgt;
        unsigned pos = 0, neq = 0;
#pragma unroll
        for (int k = 0; k < 11; ++k) { const bool gt = cu[k] > ustar, eq = cu[k] == ustar;
            const unsigned long long me = __ballot(eq); const unsigned re = neq + lane_prefix(me); const bool take = gt || (eq && re < need_eq);
            const unsigned long long mt = __ballot(take); const unsigned pp = pos + lane_prefix(mt);
            if (take && pp < TOPK) sel[pp] = (int)cidx[k];
            pos += __builtin_popcountll(mt); neq += __builtin_popcountll(me); }
    } else {
        { unsigned ns = 0;
          for (int i0 = 0; i0 < N; i0 += 64) { const int i = i0 + lane; const bool ab = (fkey(r[i]) >> 21) > b0; const unsigned long long ma = __ballot(ab);
              const unsigned pa = ns + lane_prefix(ma); if (ab && pa < TOPK) sel[pa] = i; ns += __builtin_popcountll(ma); } }
        for (int i = lane; i < 1024; i += 64) h16[i] = 0u;
        LDS_WAIT();
        for (int i = lane; i < N; i += 64) { const unsigned u = fkey(r[i]); if ((u >> 21) == b0) { const unsigned bb = (u >> 10) & 0x7ffu; __hip_atomic_fetch_add(h16 + (bb >> 1), 1u << (16 * (bb & 1)), __ATOMIC_RELAXED, __HIP_MEMORY_SCOPE_WORKGROUP); } }
        LDS_WAIT();
        unsigned ab1; const unsigned b1 = (unsigned)find_bin16(h16, lane, need, ab1); const unsigned need1 = need - ab1;
        const unsigned pre = (b0 << 11) | b1;
        for (int i = lane; i < 1024; i += 64) h16[i] = 0u;
        LDS_WAIT();
        for (int i = lane; i < N; i += 64) { const unsigned u = fkey(r[i]); if ((u >> 10) == pre) { const unsigned bb = u & 0x3ffu; __hip_atomic_fetch_add(h16 + (bb >> 1), 1u << (16 * (bb & 1)), __ATOMIC_RELAXED, __HIP_MEMORY_SCOPE_WORKGROUP); } }
        LDS_WAIT();
        unsigned ab2; const unsigned b2 = (unsigned)find_bin16(h16, lane, need1, ab2); const unsigned need2 = need1 - ab2;
        const unsigned ustar = (pre << 10) | b2;
        unsigned pos = above, neq = 0;
        for (int i0 = 0; i0 < N; i0 += 64) { const int i = i0 + lane; const unsigned u = fkey(r[i]); const bool inb = (u >> 21) == b0;
            const bool gt = inb && u > ustar, eq = inb && u == ustar; const unsigned long long mg = __ballot(gt), me = __ballot(eq);
            const unsigned re = neq + __builtin_popcountll(me & lt);
            const bool take_eq = eq && re < need2; const unsigned long long mt = __ballot(take_eq);
            const unsigned long long mall = mg | mt;
            { const unsigned pp = pos + __builtin_popcountll(mall & lt); if ((gt || take_eq) && pp < TOPK) sel[pp] = i; }
            pos += __builtin_popcountll(mall); neq += __builtin_popcountll(me); }
    }
    LDS_WAIT();
    return TOPK;
}

__device__ __forceinline__ void sparse_naive(Frame& F, int b, int t, const LAS int* sel, int cnt, LAS float* qlw, LAS float* Pw, int lane) {
    const bf16* z = (const bf16*)(KWS() + WS_Z); const bf16* ck = (const bf16*)(KWS() + WS_CKVN) + (size_t)b * SEQ * 128; bf16* hc = (bf16*)(KWS() + WS_HC);
    const float* tab = KIN(I_TAB);
    const size_t token = (size_t)b * SEQ + t;
    { const GAS v4u* qp = (const GAS v4u*)(z + token * ZE + ZQL) + 2 * lane; const v4u w0 = qp[0], w1 = qp[1]; float v[16]; UNPK8(v, 0, w0); UNPK8(v, 8, w1);
#pragma unroll
      for (int k = 0; k < 16; ++k) qlw[16 * lane + k] = v[k]; }
    LDS_WAIT();
    float s[4][8];
#pragma unroll
    for (int kk = 0; kk < 4; ++kk) {
        const int j = lane + 64 * kk; const bool valid = j < cnt; const int key = valid ? sel[j] : 0;
        float acc[8];
#pragma unroll
        for (int hh = 0; hh < 8; ++hh) acc[hh] = 0.f;
        const GAS v4u* cp = (const GAS v4u*)(ck + (size_t)key * 128);
        for (int ch = 0; ch < 16; ++ch) { const v4u w = cp[ch]; float c8[8]; UNPK8(c8, 0, w);
#pragma unroll
            for (int hh = 0; hh < 8; ++hh) { const LAS f32x4* qq = (const LAS f32x4*)(qlw + hh * 128 + ch * 8); const f32x4 a = qq[0], bq = qq[1];
                acc[hh] += (a.x * c8[0] + a.y * c8[1]) + (a.z * c8[2] + a.w * c8[3]) + (bq.x * c8[4] + bq.y * c8[5]) + (bq.z * c8[6] + bq.w * c8[7]); } }
        const int bk = t5_bucket(key - t);
#pragma unroll
        for (int hh = 0; hh < 8; ++hh) s[kk][hh] = valid ? acc[hh] * 0.125f + ((const GAS float*)tab)[bk * 28 + hh] : -1e30f;
    }
#pragma unroll
    for (int hh = 0; hh < 8; ++hh) {
        const float mx = wave_max(fmaxf(fmaxf(s[0][hh], s[1][hh]), fmaxf(s[2][hh], s[3][hh])));
        float p[4], sum = 0.f;
#pragma unroll
        for (int kk = 0; kk < 4; ++kk) { p[kk] = __expf(s[kk][hh] - mx); sum += p[kk]; }
        const float inv = 1.f / wave_sum(sum);
#pragma unroll
        for (int kk = 0; kk < 4; ++kk) Pw[(lane + 64 * kk) * 8 + hh] = p[kk] * inv;
    }
    LDS_WAIT();
    float o0[8], o1[8];
#pragma unroll
    for (int hh = 0; hh < 8; ++hh) { o0[hh] = 0.f; o1[hh] = 0.f; }
    for (int j = 0; j < cnt; ++j) {
        const int key = sel[j]; const unsigned w = *((const GAS unsigned*)(ck + (size_t)key * 128) + lane); const float c0 = bflo(w), c1 = bfhi(w);
        const LAS f32x4* pp = (const LAS f32x4*)(Pw + j * 8); const f32x4 pa = pp[0], pb = pp[1];
        o0[0] += pa.x * c0; o1[0] += pa.x * c1; o0[1] += pa.y * c0; o1[1] += pa.y * c1; o0[2] += pa.z * c0; o1[2] += pa.z * c1; o0[3] += pa.w * c0; o1[3] += pa.w * c1;
        o0[4] += pb.x * c0; o1[4] += pb.x * c1; o0[5] += pb.y * c0; o1[5] += pb.y * c1; o0[6] += pb.z * c0; o1[6] += pb.z * c1; o0[7] += pb.w * c0; o1[7] += pb.w * c1;
    }
#pragma unroll
    for (int hh = 0; hh < 8; ++hh) *((GAS unsigned*)(hc + token * HCE + hh * 128) + lane) = pk2(o0[hh], o1[hh]);
    LDS_WAIT();
}

constexpr int DL_IMG = DL_W, IMG_STR = 288, IMG_BYTES = 32 * IMG_STR, DL_TABA = DL_W + 8 * IMG_BYTES;
static_assert(DL_TABA + 1024 <= RING_BYTES, "sparse LDS map");
__device__ __forceinline__ void sparse_mfma(Frame& F, int b, int t, LAS int* sel, int cnt, LAS unsigned char* img, const LAS float* tabA, int lane) {
    const bf16* z = (const bf16*)(KWS() + WS_Z); const bf16* ck = (const bf16*)(KWS() + WS_CKVN) + (size_t)b * SEQ * 128; bf16* hc = (bf16*)(KWS() + WS_HC);
    const int hd = lane & 15, g = lane >> 4; const size_t token = (size_t)b * SEQ + t;
    constexpr float C2A = 0.125f * LOG2E;
    bf16x8_t qf[4];
#pragma unroll
    for (int ks = 0; ks < 4; ++ks) { qf[ks] = *(const GAS bf16x8_t*)(z + token * ZE + ZQL + (hd & 7) * 128 + 32 * ks + 8 * g); if (hd >= 8) qf[ks] = (bf16x8_t){0, 0, 0, 0, 0, 0, 0, 0}; }
    f32x4 o[8];
#pragma unroll
    for (int mt = 0; mt < 8; ++mt) o[mt] = (f32x4){0.f, 0.f, 0.f, 0.f};
    float m_run = -1e30f, l_run = 0.f;
    v4u gb[8], gc[8];
    const int nblk = cnt >> 5;
    for (int jj = lane; jj < cnt; jj += 64) { const int key = sel[jj]; sel[jj] = key | (t5_bucket(key - t) << 16); }
    LDS_WAIT();
    const GAS unsigned char* ckb = (const GAS unsigned char*)ck;
#pragma unroll
    for (int k = 0; k < 8; ++k) { const unsigned key = sel[4 * k + g] & 0xffff; gb[k] = *(const GAS v4u*)(ckb + ((key << 8) + (hd << 4))); }
#pragma unroll
    for (int k = 0; k < 8; ++k) { const unsigned key = sel[32 + 4 * k + g] & 0xffff; gc[k] = *(const GAS v4u*)(ckb + ((key << 8) + (hd << 4))); }
#pragma unroll 1
    for (int blk = 0; blk < nblk; ++blk) {
#pragma unroll
        for (int k = 0; k < 8; ++k) *(LAS v4u*)(img + (4 * k + g) * IMG_STR + hd * 16) = gb[k];
#pragma unroll
        for (int k = 0; k < 8; ++k) gb[k] = gc[k];
        if (blk + 2 < nblk) {
#pragma unroll
            for (int k = 0; k < 8; ++k) { const unsigned key = sel[(blk + 2) * 32 + 4 * k + g] & 0xffff; gc[k] = *(const GAS v4u*)(ckb + ((key << 8) + (hd << 4))); } }
        f32x4 s[2];
#pragma unroll
        for (int tau = 0; tau < 2; ++tau) { s[tau] = (f32x4){0.f, 0.f, 0.f, 0.f};
#pragma unroll
            for (int ks = 0; ks < 4; ++ks) { const bf16x8_t a = *(const LAS bf16x8_t*)(img + (16 * tau + hd) * IMG_STR + (32 * ks + 8 * g) * 2);
                s[tau] = __builtin_amdgcn_mfma_f32_16x16x32_bf16(a, qf[ks], s[tau], 0, 0, 0); } }
        float x[8]; float mx = -1e30f;
#pragma unroll
        for (int tau = 0; tau < 2; ++tau)
#pragma unroll
            for (int i = 0; i < 4; ++i) { const int bk = sel[blk * 32 + 16 * tau + 4 * g + i] >> 16;
                x[4 * tau + i] = s[tau][i] * C2A + tabA[bk * 8 + (hd & 7)]; mx = fmaxf(mx, x[4 * tau + i]); }
        mx = fmaxf(mx, __shfl_xor(mx, 16)); mx = fmaxf(mx, __shfl_xor(mx, 32));
        if (__any(mx > m_run)) { const float mn = fmaxf(m_run, mx), al = __builtin_amdgcn_exp2f(m_run - mn); m_run = mn; l_run *= al;
#pragma unroll
            for (int mt = 0; mt < 8; ++mt) o[mt] *= al; }
        float ps = 0.f;
#pragma unroll
        for (int i = 0; i < 8; ++i) { x[i] = __builtin_amdgcn_exp2f(x[i] - m_run); ps += x[i]; }
        l_run += ps;
        v4u pw; pw.x = cvtpk(x[0], x[1]); pw.y = cvtpk(x[2], x[3]); pw.z = cvtpk(x[4], x[5]); pw.w = cvtpk(x[6], x[7]);
        const bf16x8_t pf = __builtin_bit_cast(bf16x8_t, pw);
        const LAS unsigned char* vb = img + (4 * g + (hd >> 2)) * IMG_STR + (4 * (hd & 3)) * 2;
#pragma unroll
        for (int mt = 0; mt < 8; ++mt) { const bf16x8_t vf = vtr8(vb + mt * 32, vb + mt * 32 + 16 * IMG_STR); o[mt] = __builtin_amdgcn_mfma_f32_16x16x32_bf16(vf, pf, o[mt], 0, 0, 0); }
    }
    float l = l_run; l += __shfl_xor(l, 16); l += __shfl_xor(l, 32);
    const float inv = 1.f / l;
    if (hd < 8) {
        bf16* orow = hc + token * HCE + hd * 128 + 4 * g;
#pragma unroll
        for (int mt = 0; mt < 8; ++mt) { v2u ov; ov.x = pk2(o[mt][0] * inv, o[mt][1] * inv); ov.y = pk2(o[mt][2] * inv, o[mt][3] * inv); *(GAS v2u*)(orow + 16 * mt) = ov; }
    }
    LDS_WAIT();
}

__device__ __forceinline__ void dsa_phase(Frame& F) {
    float* scr = (float*)(KWS() + WS_SCR) + (size_t)blockIdx.x * 16 * SEQ;
    LAS int* selA = (LAS int*)(F.lds + DL_SEL); LAS int* cntA = (LAS int*)(F.lds + DL_CNT);
    const int NU = NB * 128 * 4;
    for (int ui = F.vcu; ui < NU; ui += F.G) {
        const int rr = ui / F.G, v = ui % F.G;
        const int b = (v * NB) / F.G, j = v % (F.G / NB);
        const int half = rr >> 2, sub = rr & 3;
        const int c = (F.G / NB == 64) ? (half == 0 ? j : 127 - j) : 0;
        const int t0 = c * 64 + sub * 16, N = 64 * (c + 1);
        __syncthreads();
        int tl = F.tid; asm volatile("" : "+v"(tl));
        for (int i = tl; i < 16 * 1024; i += 512) ((LAS unsigned*)(F.lds + DL_HIST))[i] = 0u;
        for (int e2 = tl; e2 < 1024; e2 += 512) { const int g = e2 >> 8, ks = (e2 >> 6) & 3, ln = e2 & 63, n2 = ln & 31, h2 = ln >> 5;
            ((LAS bf16x8_t*)(F.lds + DL_AFL))[e2] = *(const GAS bf16x8_t*)((const bf16*)(KWS() + WS_Z) + ((size_t)b * SEQ + t0 + 4 * g + (n2 >> 3)) * ZE + ZQI + (n2 & 7) * 64 + 8 * h2 + 16 * ks); }
        if (tl < 128) ((LAS float*)(F.lds + DL_WI2))[tl] = bf2f(((const GAS bf16*)(KWS() + WS_Z))[((size_t)b * SEQ + t0 + (tl >> 3)) * ZE + ZWI + (tl & 7)]);
        __syncthreads();
        indexer_mfma2(F, b, t0, N, scr, (LAS unsigned*)(F.lds + DL_HIST));
        VM_WAIT(); __syncthreads();
#pragma unroll 1
        for (int r2 = 0; r2 < 2; ++r2) { const int q = F.wave + 8 * r2;
            const int cnt = select_topk2(scr + (size_t)q * SEQ, N, selA + q * 256, (LAS unsigned*)(F.lds + DL_HIST) + q * 1024, (LAS unsigned long long*)(F.lds + DL_CAND) + F.wave * LISTMAX, F.lane);
            if (F.lane == 0) cntA[q] = cnt; }
        __syncthreads();
        if (tl < 256) ((LAS float*)(F.lds + DL_TABA))[tl] = ((const GAS float*)KIN(I_TAB))[(tl >> 3) * 28 + (tl & 7)] * LOG2E;
        __syncthreads();
#pragma unroll 1
        for (int r2 = 0; r2 < 2; ++r2) { const int q = F.wave + 8 * r2;
            sparse_mfma(F, b, t0 + q, selA + q * 256, cntA[q], F.lds + DL_IMG + F.wave * IMG_BYTES, (const LAS float*)(F.lds + DL_TABA), F.lane); }
    }
}

#ifndef MK_MULTI
#define MK_MULTI 0
#endif
constexpr int N_PHASES = 1 + 2 * (4 + 8) + 2 * (3 + 8) + 1;
struct Args { const float* in[20]; float* out; unsigned char* ws; int ph_lo, ph_hi; };
static_assert(sizeof(Args) == 22 * 8 + 8, "Args has no padding");

#define XBP ((unsigned char*)KOUT() + XB_OFF)
#define RSP ((const float*)(KWS() + WS_RS))
#define GEMM_CALL(ACTV, Aptr, Bptr, Mv, Nv, Kv, Optr, LDC, CID, RS_) do { \
    pg8::Gemm g_{(const pg8::bf16_t*)(Aptr), (const pg8::bf16_t*)(Bptr), (Mv), (Nv), (Kv)}; pg8::StaticOrder S_; S_.init((Mv), (Nv), F.G, (CID)); \
    pg8::EpiAct<ACTV> E_{(pg8::bf16_t*)(Optr), (LDC), (RS_)}; \
    pg8::gemm_phase<pg8::EpiAct<ACTV>, pg8::StaticOrder, true, true>(F.lds + RING_OFF, g_, S_, E_, F.tid); } while (0)

__global__ void __launch_bounds__(NWAVES * 64, 2) mk_fwd(Args args) {
    extern __shared__ __attribute__((aligned(16))) unsigned char lds[];
    Frame F;
    F.lds = (LAS unsigned char*)lds;
    F.MISC = (volatile LAS unsigned*)(F.lds + MISC_OFF);
    F.tid = threadIdx.x; F.lane = F.tid & 63; F.wave = __builtin_amdgcn_readfirstlane(F.tid >> 6);
    F.G = gridDim.x; { const int bx = blockIdx.x; F.vcu = (F.G % 8 == 0) ? (bx % 8) * (F.G / 8) + bx / 8 : bx; }
    for (int u = F.tid; u < (LDS_BYTES - LDSCTL_OFF) / 4; u += NWAVES * 64) ((LAS unsigned*)(F.lds + LDSCTL_OFF))[u] = 0u;
    __syncthreads();
#if MK_MULTI
    XcdBarrier bar; bar.bar = (unsigned*)(((gu32*)KWS()) + CW_BAR); bar.x = 0; bar.st = nullptr;
#else
    XcdBarrier bar = xcd_barrier_post((unsigned*)(((gu32*)KWS()) + CW_BAR), F.MISC + 8, XLEAD(F));
#endif
    const int lo = args.ph_lo, hi = args.ph_hi;
    int pid = 0;
#define PH_ON (pid >= lo && pid < hi && refresh(F))
#if MK_MULTI
#define PH_END do { ++pid; } while (0)
#else
#define PH_END do { if (pid >= lo && pid + 1 < hi) xcd_barrier(bar, XLEAD(F)); ++pid; } while (0)
#endif

    if (PH_ON) { convert_weights(F, 0); thin_first(F); }
    PH_END;

#pragma unroll 1
    for (int l = 0; l < 4; ++l) {
        const float* g = KIN(I_NG) + (size_t)l * 6 * D;
        if ((l & 1) == 0) {
            const int e = l >> 1;
            if (PH_ON) { REP(0) GEMM_CALL(0, XBP, KWS() + WS_WGT + WO_WIN, M, ZE, D, KWS() + WS_Z, ZE, (int)blockIdx.x, RSP); }
            PH_END;
            if (PH_ON) { REP(5) thin_ckvn(F, KIN(I_EKVN) + e * 128); }
            PH_END;
            if (PH_ON) { REP(1) diff_mfma(F, e); REP(2) dsa_phase(F); }
            PH_END;
            if (PH_ON) { REP(0) GEMM_CALL(0, KWS() + WS_HC, KWS() + WS_WGT + WO_WOUT, M, D, HCE, KWS() + WS_Y, D, (int)blockIdx.x, nullptr); }
            PH_END;
        } else {
            const int o = l >> 1;
            if (PH_ON) { REP(0) GEMM_CALL(0, XBP, KWS() + WS_WGT + WO_WIN, M, ZO, D, KWS() + WS_Z, ZO, (int)blockIdx.x, RSP); }
            PH_END;
            if (PH_ON) { REP(3) swa_mfma(F, o); }
            PH_END;
            if (PH_ON) { REP(0) GEMM_CALL(0, KWS() + WS_HC, KWS() + WS_WGT + WO_WOUT, M, D, HCO, KWS() + WS_Y, D, (int)blockIdx.x, nullptr); }
            PH_END;
        }
        if (PH_ON) { thin_mid<false>(F, g + 1 * D); thin_memn(F, KIN(I_XMN) + (size_t)l * D); }
        PH_END;
        if (PH_ON) { REP(0) GEMM_CALL(0, XBP, KWS() + WS_WGT + WO_WQ, M, 256, D, KWS() + WS_QX, 256, (int)blockIdx.x, RSP); REP(0) GEMM_CALL(0, KWS() + WS_MEMN, KWS() + WS_WGT + WO_WKV, NB * NMEM, 512, D, KWS() + WS_KVM, 512, (int)((blockIdx.x + 128) % F.G), nullptr); }
        PH_END;
        if (PH_ON) { REP(3) xattn_mfma(F); }
        PH_END;
        if (PH_ON) { REP(0) GEMM_CALL(0, KWS() + WS_OX, KWS() + WS_WGT + WO_WO, M, D, 256, KWS() + WS_Y, D, (int)blockIdx.x, nullptr); }
        PH_END;
        if (PH_ON) { thin_mid<false>(F, g + 3 * D); }
        PH_END;
        if (PH_ON) { REP(0) GEMM_CALL(2, XBP, KWS() + WS_WGT + WO_W1, M, FF, D, KWS() + WS_U, FF, (int)blockIdx.x, RSP); }
        PH_END;
        if (PH_ON) { REP(0) GEMM_CALL(0, KWS() + WS_U, KWS() + WS_WGT + WO_W2, M, D, FF, KWS() + WS_Y, D, (int)blockIdx.x, nullptr); }
        PH_END;
        if (PH_ON) { if (l < 3) { thin_mid<false>(F, g + 5 * D); REP(4) convert_weights(F, l + 1); } else thin_mid<true>(F, g + 5 * D); }
        PH_END;
    }
    if (PH_ON) { final_copy(F); }
    PH_END;
}

extern "C" void kernel_launch(void* const* d_in, const int* in_sizes, int n_in, void* d_out, int out_size, void* d_ws, size_t ws_size, hipStream_t stream) {
    static int grid = 0;
    if (grid == 0) {
        if (n_in != 20 || out_size != M * D || ws_size < WS_END) { fprintf(stderr, "kernel_launch: unexpected shapes: n_in %d out %d ws %zu (need %zu)\n", n_in, out_size, ws_size, (size_t)WS_END); grid = -1; return; }
        int dev = 0, cus = 0, per_cu = 0;
        if (hipGetDevice(&dev) != hipSuccess || hipDeviceGetAttribute(&cus, hipDeviceAttributeMultiprocessorCount, dev) != hipSuccess) { grid = -1; return; }
        if (hipFuncSetAttribute((const void*)mk_fwd, hipFuncAttributeMaxDynamicSharedMemorySize, LDS_BYTES) != hipSuccess) { fprintf(stderr, "kernel_launch: hipFuncSetAttribute failed\n"); grid = -1; return; }
        if (hipOccupancyMaxActiveBlocksPerMultiprocessor(&per_cu, (const void*)mk_fwd, NWAVES * 64, LDS_BYTES) != hipSuccess || per_cu < 1)
            fprintf(stderr, "kernel_launch: note: occupancy query reports %d workgroups per CU\n", per_cu);
        (void)hipGetLastError();
        grid = cus;
        if (grid != 256) { fprintf(stderr, "kernel_launch: built for 256 CUs, device has %d\n", cus); grid = -1; return; }
    }
    if (grid < 0) return;
    if (hipMemsetAsync((char*)d_ws + WS_CTL, 0, CTL_ZERO_BYTES, stream) != hipSuccess) return;
    Args a{};
    for (int i = 0; i < 20; ++i) a.in[i] = (const float*)d_in[i];
    a.out = (float*)d_out; a.ws = (unsigned char*)d_ws;
#if MK_MULTI
    for (int p = 0; p < N_PHASES; ++p) { a.ph_lo = p; a.ph_hi = p + 1; hipLaunchKernelGGL(mk_fwd, dim3(grid), dim3(NWAVES * 64), LDS_BYTES, stream, a); }
#else
    a.ph_lo = 0; a.ph_hi = N_PHASES; hipLaunchKernelGGL(mk_fwd, dim3(grid), dim3(NWAVES * 64), LDS_BYTES, stream, a);
#endif
}
```

```cpp
#include <hip/hip_runtime.h>
#include <cstdio>
#include <cstdint>
namespace pg8 {
#define PG8_LAS __attribute__((address_space(3)))
typedef unsigned short bf16_t;
typedef short bf16x8 __attribute__((ext_vector_type(8)));
typedef float f32x4 __attribute__((ext_vector_type(4)));
typedef unsigned u32x4 __attribute__((ext_vector_type(4)));
constexpr int BM = 256, BK = 64, HALF = 128, HTB = HALF * BK * 2  , STAGE_BYTES = 8 * HTB, NXCD = 8, WGM = 8;

__host__ __device__ __forceinline__ int lds_byte(int r, int c) { const int st = (r >> 4) * 2 + (c >> 5), rr = r & 15, cc = c & 31, ob = rr * 64 + cc * 2; return st * 1024 + (ob ^ (((ob >> 9) & 1) << 5)); }
__host__ __device__ __forceinline__ void stage_rc(int b, int& R, int& C) { const int st = b / 1024, sb = b % 1024, swz = sb ^ (((sb >> 9) & 1) << 5); R = (st >> 1) * 16 + swz / 64; C = (st & 1) * 32 + (swz % 64) / 2; }
__host__ __device__ __forceinline__ int perm32(int rho) { const int n = rho >> 4, i = rho & 15; return 8 * (i >> 2) + 4 * n + (i & 3); }

struct Unit { int pm, pn; };
struct Gemm { const bf16_t* A; const bf16_t* Bt; int M, N, K; };

struct StaticOrder {
    int nM, nN, nwg, G, c;
    __host__ __device__ void init(int M, int N, int G_, int c_) { nM = M / BM; nN = N / BM; nwg = nM * nN; G = G_; c = c_; }
    __host__ __device__ bool next(int i, Unit& u) const {
        const long L = (long)i * G + c; if (L >= nwg) return false;
        int wgid = (int)L; { const int q = nwg / NXCD, r = nwg % NXCD, xcd = wgid % NXCD, off = wgid / NXCD; wgid = (xcd < r ? xcd * (q + 1) : r * (q + 1) + (xcd - r) * q) + off; }
        const int nig = WGM * nN, gid = wgid / nig, fm = gid * WGM, gsz = (nM - fm) < WGM ? (nM - fm) : WGM;
        u.pm = fm + ((wgid % nig) % gsz); u.pn = (wgid % nig) / gsz; return true;
    }
    __device__ __forceinline__ void a_ready(const Unit&) const {}
    __device__ __forceinline__ void done(const Unit&) const {}
};


__device__ __forceinline__ unsigned cvt_pk_bf16(float lo, float hi) { unsigned r; asm volatile("v_cvt_pk_bf16_f32 %0, %1, %2" : "=v"(r) : "v"(lo), "v"(hi)); return r; }
template <int ACT  > struct EpiAct {
    static constexpr bool PERM = true, AFTER_DRAIN = false;
    bf16_t* O; int ldc; const float* rs;
    __device__ __forceinline__ void operator()(const f32x4 (&acc)[2][2][4][2], const Unit& u, int wr, int wc, int fr, int fq) const {
        const int row0 = u.pm * BM + wr * 64 + fr; const int col0 = u.pn * BM + wc * 32 + 8 * fq;
#pragma unroll
        for (int ai = 0; ai < 2; ++ai)
#pragma unroll
            for (int m = 0; m < 4; ++m) { bf16_t* rowp = O + (size_t)(row0 + ai * HALF + m * 16) * ldc + col0; const float rsc = rs ? rs[row0 + ai * HALF + m * 16] : 1.f;
#pragma unroll
                for (int bj = 0; bj < 2; ++bj) { f32x4 v0 = acc[ai][bj][m][0] * rsc, v1 = acc[ai][bj][m][1] * rsc;
                    if (ACT == 2) {
#pragma unroll
                        for (int i = 0; i < 4; ++i) { float a = v0[i] > 0.f ? v0[i] : 0.f; v0[i] = a * a; float b = v1[i] > 0.f ? v1[i] : 0.f; v1[i] = b * b; }
                    }
                    u32x4 w; w.x = cvt_pk_bf16(v0[0], v0[1]); w.y = cvt_pk_bf16(v0[2], v0[3]); w.z = cvt_pk_bf16(v1[0], v1[1]); w.w = cvt_pk_bf16(v1[2], v1[3]);
                    *(u32x4*)(rowp + bj * HALF) = w; } }
    }
};
template <class Epi, class Sched, bool ALIGN_EPI = false, bool SP2 = false>
__device__ __forceinline__ void gemm_phase(PG8_LAS unsigned char* lds, const Gemm g, const Sched& S, const Epi& E, int tid_in) {
    int tid_ = tid_in; asm volatile("" : "+v"(tid_)); const int tid = tid_, wid = __builtin_amdgcn_readfirstlane(tid >> 6), lane = tid & 63, wr = wid >> 2, wc = wid & 3, fr = lane & 15, fq = lane >> 4;
    const int K = g.K, nt = K / BK;
    unsigned voffA[2], voffB[2];
#pragma unroll
    for (int i = 0; i < 2; ++i) { int R, C; stage_rc(tid * 16 + i * 8192, R, C); const int Rb = Epi::PERM ? ((R & ~31) + perm32(R & 31)) : R;
        voffA[i] = (unsigned)(R * K + C) * 2u; voffB[i] = (unsigned)(Rb * K + C) * 2u; }
    const size_t kstep = (size_t)(BK * 2);
    const size_t hstep = (size_t)HALF * K * 2;
    const size_t tstep = 2 * hstep;
    const unsigned ldsw = (unsigned)wid * 1024u;
    const int aoff = lds_byte(wr * 64 + fr, fq * 8), boff = lds_byte(wc * 32 + fr, fq * 8);
#define PG8_SA(b, h) (((b) * 2 + (h)) * HTB)
#define PG8_SB(b, h) ((4 + (b) * 2 + (h)) * HTB)
#define PG8_STAGE(bufoff, gbase, voff) do { _Pragma("unroll") for (int _i = 0; _i < 2; ++_i) \
        __builtin_amdgcn_global_load_lds((const unsigned*)((const char*)(gbase) + (voff)[_i]), (PG8_LAS unsigned*)(lds + (bufoff) + ldsw + _i * 8192), 16, 0, 0); } while (0)
#define PG8_LDA(dst, b, h) do { _Pragma("unroll") for (int m = 0; m < 4; ++m) _Pragma("unroll") for (int k = 0; k < 2; ++k) dst[m][k] = *(const PG8_LAS bf16x8*)(lds + PG8_SA(b, h) + aoff + m * 2048 + k * 1024); } while (0)
#define PG8_LDB(dst, b, h) do { _Pragma("unroll") for (int n = 0; n < 2; ++n) _Pragma("unroll") for (int k = 0; k < 2; ++k) dst[n][k] = *(const PG8_LAS bf16x8*)(lds + PG8_SB(b, h) + boff + n * 2048 + k * 1024); } while (0)
#define PG8_MMA(ai, bj, At, Bt) do { __builtin_amdgcn_s_setprio(1); _Pragma("unroll") for (int m = 0; m < 4; ++m) _Pragma("unroll") for (int n = 0; n < 2; ++n) _Pragma("unroll") for (int k = 0; k < 2; ++k) \
        acc[ai][bj][m][n] = __builtin_amdgcn_mfma_f32_16x16x32_bf16(Bt[n][k], At[m][k], acc[ai][bj][m][n], 0, 0, 0); __builtin_amdgcn_s_setprio(0); } while (0)
#define PG8_WAIT_V(n) asm volatile("s_waitcnt vmcnt(" #n ")" ::: "memory")
#define PG8_WAIT_L(n) asm volatile("s_waitcnt lgkmcnt(" #n ")" ::: "memory")
#define PG8_BAR __builtin_amdgcn_s_barrier()
#define PG8_SCHED __builtin_amdgcn_sched_barrier(0)
    Unit cur, nxt; int ui = 0;
    if (!S.next(0, cur)) return;
    f32x4 acc[2][2][4][2];
#pragma unroll
    for (int a = 0; a < 2; ++a)
#pragma unroll
        for (int b = 0; b < 2; ++b)
#pragma unroll
            for (int m = 0; m < 4; ++m)
#pragma unroll
                for (int n = 0; n < 2; ++n) acc[a][b][m][n] = (f32x4){0.f, 0.f, 0.f, 0.f};
    bf16x8 At[4][2], B0[2][2], B1[2][2];
    const char* cA = (const char*)g.A + (size_t)cur.pm * tstep; const char* cB = (const char*)g.Bt + (size_t)cur.pn * tstep;
    S.a_ready(cur);
    if constexpr (SP2) {
        PG8_STAGE(PG8_SB(0, 0), cB, voffB); PG8_STAGE(PG8_SB(0, 1), cB + hstep, voffB); PG8_STAGE(PG8_SA(0, 0), cA, voffA); PG8_STAGE(PG8_SA(0, 1), cA + hstep, voffA);
        if (wr == 1) PG8_BAR;
        PG8_WAIT_V(2); PG8_BAR;
        PG8_STAGE(PG8_SB(1, 0), cB + kstep, voffB); PG8_STAGE(PG8_SA(1, 0), cA + kstep, voffA); PG8_STAGE(PG8_SB(1, 1), cB + hstep + kstep, voffB);
        PG8_WAIT_V(6); PG8_BAR;
    } else {
        PG8_STAGE(PG8_SB(0, 0), cB, voffB); PG8_STAGE(PG8_SA(0, 0), cA, voffA); PG8_STAGE(PG8_SB(0, 1), cB + hstep, voffB); PG8_STAGE(PG8_SA(0, 1), cA + hstep, voffA);
        if (wr == 1) PG8_BAR;
        PG8_WAIT_V(4); PG8_BAR;
        PG8_STAGE(PG8_SB(1, 0), cB + kstep, voffB); PG8_STAGE(PG8_SA(1, 0), cA + kstep, voffA); PG8_STAGE(PG8_SB(1, 1), cB + hstep + kstep, voffB);
        PG8_WAIT_V(6); PG8_BAR;
    }
    for (;;) {
        const bool has_next = S.next(ui + 1, nxt);
        const char* nA = has_next ? (const char*)g.A + (size_t)nxt.pm * tstep : cA; const char* nB = has_next ? (const char*)g.Bt + (size_t)nxt.pn * tstep : cB;
        for (int t = 0; t < nt; t += 2) {
            const bool last = (t == nt - 2);
            const char* a1 = cA + (size_t)(t + 1) * kstep;
            const char* a2 = last ? nA : cA + (size_t)(t + 2) * kstep; const char* b2 = last ? nB : cB + (size_t)(t + 2) * kstep;
            const char* a3 = a2 + kstep; const char* b3 = b2 + kstep;
            if (last && has_next) S.a_ready(nxt);
            if constexpr (SP2) {
            PG8_LDB(B0, 0, 0); PG8_LDB(B1, 0, 1); PG8_SCHED; PG8_LDA(At, 0, 0); PG8_STAGE(PG8_SA(1, 1), a1 + hstep, voffA);
            PG8_WAIT_V(8); PG8_WAIT_L(0); PG8_BAR; PG8_MMA(0, 0, At, B0); PG8_MMA(0, 1, At, B1); PG8_BAR; PG8_SCHED;
            PG8_LDA(At, 0, 1); PG8_STAGE(PG8_SB(0, 0), b2, voffB); PG8_STAGE(PG8_SB(0, 1), b2 + hstep, voffB); PG8_STAGE(PG8_SA(0, 0), a2, voffA);
            PG8_WAIT_V(8); PG8_WAIT_L(0); PG8_BAR; PG8_MMA(1, 0, At, B0); PG8_MMA(1, 1, At, B1); PG8_BAR; PG8_SCHED;
            PG8_LDB(B0, 1, 0); PG8_LDB(B1, 1, 1); PG8_SCHED; PG8_LDA(At, 1, 0); PG8_STAGE(PG8_SA(0, 1), a2 + hstep, voffA);
            PG8_WAIT_V(8); PG8_WAIT_L(0); PG8_BAR; PG8_MMA(0, 0, At, B0); PG8_MMA(0, 1, At, B1); PG8_BAR; PG8_SCHED;
            PG8_LDA(At, 1, 1); PG8_STAGE(PG8_SB(1, 0), b3, voffB); PG8_STAGE(PG8_SB(1, 1), b3 + hstep, voffB); PG8_STAGE(PG8_SA(1, 0), a3, voffA);
            PG8_WAIT_V(8); PG8_WAIT_L(0); PG8_BAR; PG8_MMA(1, 0, At, B0); PG8_MMA(1, 1, At, B1); PG8_BAR; PG8_SCHED;
            } else {
            PG8_LDB(B0, 0, 0); PG8_SCHED; PG8_LDA(At, 0, 0); PG8_STAGE(PG8_SA(1, 1), a1 + hstep, voffA);
            PG8_WAIT_L(8); PG8_BAR; PG8_WAIT_L(0); PG8_MMA(0, 0, At, B0); PG8_BAR; PG8_SCHED;
            PG8_LDB(B1, 0, 1); PG8_STAGE(PG8_SB(0, 0), b2, voffB);
            PG8_BAR; PG8_WAIT_L(0); PG8_MMA(0, 1, At, B1); PG8_BAR;
            PG8_LDA(At, 0, 1); PG8_STAGE(PG8_SA(0, 0), a2, voffA);
            PG8_BAR; PG8_WAIT_L(0); PG8_MMA(1, 0, At, B0); PG8_BAR; PG8_SCHED;
            PG8_STAGE(PG8_SB(0, 1), b2 + hstep, voffB);
            PG8_WAIT_V(6); PG8_BAR; PG8_MMA(1, 1, At, B1); PG8_BAR;
            PG8_LDB(B0, 1, 0); PG8_SCHED; PG8_LDA(At, 1, 0); PG8_STAGE(PG8_SA(0, 1), a2 + hstep, voffA);
            PG8_WAIT_L(8); PG8_BAR; PG8_WAIT_L(0); PG8_MMA(0, 0, At, B0); PG8_BAR; PG8_SCHED;
            PG8_LDB(B1, 1, 1); PG8_STAGE(PG8_SB(1, 0), b3, voffB);
            PG8_BAR; PG8_WAIT_L(0); PG8_MMA(0, 1, At, B1); PG8_BAR;
            PG8_LDA(At, 1, 1); PG8_STAGE(PG8_SA(1, 0), a3, voffA);
            PG8_BAR; PG8_WAIT_L(0); PG8_MMA(1, 0, At, B0); PG8_BAR; PG8_SCHED;
            PG8_STAGE(PG8_SB(1, 1), b3 + hstep, voffB);
            PG8_WAIT_V(6); PG8_BAR; PG8_MMA(1, 1, At, B1); PG8_BAR;
            }
        }
        if constexpr (ALIGN_EPI) { if (wr == 0) PG8_BAR; }
        if constexpr (!Epi::AFTER_DRAIN) { E(acc, cur, wr, wc, fr, fq); S.done(cur); }
        if (!has_next) break;
#pragma unroll
        for (int a = 0; a < 2; ++a)
#pragma unroll
            for (int b = 0; b < 2; ++b)
#pragma unroll
                for (int m = 0; m < 4; ++m)
#pragma unroll
                    for (int n = 0; n < 2; ++n) acc[a][b][m][n] = (f32x4){0.f, 0.f, 0.f, 0.f};
        cur = nxt; cA = nA; cB = nB; ++ui;
        if constexpr (ALIGN_EPI) { if (wr == 1) PG8_BAR; }
    }
    PG8_WAIT_V(0);
    if constexpr (!ALIGN_EPI) { if (wr == 0) PG8_BAR; }
    PG8_BAR;
    if constexpr (Epi::AFTER_DRAIN) { E.fused(acc, cur, wr, wc, fr, fq, lds, wid, lane); S.done(cur); }
#undef PG8_SA
#undef PG8_SB
#undef PG8_STAGE
#undef PG8_LDA
#undef PG8_LDB
#undef PG8_MMA
#undef PG8_WAIT_V
#undef PG8_WAIT_L
#undef PG8_BAR
#undef PG8_SCHED
}
}

constexpr int NWAVES = 8;
constexpr int NB = 4, SEQ = 8192, D = 1024, M = NB * SEQ, FF = 4096, NMEM = 256;
constexpr int ZE = 3328, ZO = 1280;
constexpr int ZQL = 0, ZCKV = 1024, ZQI = 1152, ZKI = 1664, ZWI = 1728, ZQB = 1792, ZKB = 2304, ZVB = 2816;
constexpr int OQ = 0, OKK = 1024, OVV = 1152;
constexpr int EVC = 2760;
constexpr int HCE = 1536, HCO = 1024;
constexpr float EPS = 1e-6f;
constexpr float LOG2E = 1.4426950408889634f;

constexpr size_t MiB = 1u << 20;
constexpr size_t WS_CTL = 0, CTL_ZERO_BYTES = 1 * MiB;
constexpr size_t WS_WGT = 1 * MiB;
constexpr size_t WO_WIN = 0, WO_WOUT = 6 * MiB + MiB / 2, WO_WQ = 9 * MiB + MiB / 2, WO_WKV = 10 * MiB, WO_WO = 11 * MiB, WO_W1 = 11 * MiB + MiB / 2, WO_W2 = 19 * MiB + MiB / 2;
constexpr size_t WS_MEMN = 33 * MiB, WS_KVM = 35 * MiB, WS_CKVN = 36 * MiB, WS_QX = 44 * MiB, WS_OX = 60 * MiB, WS_HC = 76 * MiB, WS_ZS = 172 * MiB;
constexpr size_t WS_Z = WS_ZS, WS_SCR = WS_ZS + 208 * MiB, WS_U = WS_ZS, WS_Y = WS_ZS + 272 * MiB, WS_END = WS_ZS + 336 * MiB;
static_assert(WS_END == 508 * MiB, "ws map");
constexpr size_t WS_RS = 29 * MiB;
constexpr size_t XB_OFF = 64 * MiB;
constexpr size_t WS_FT = WS_ZS;
constexpr int CW_BAR = 4096;

constexpr int RING_OFF = 0, RING_BYTES = 131072;
constexpr int LDSCTL_OFF = RING_BYTES, MISC_OFF = LDSCTL_OFF + 320;
constexpr int LDS_BYTES = 147456;

#define GAS __attribute__((address_space(1)))
#define LAS __attribute__((address_space(3)))
typedef unsigned short bf16;
typedef unsigned v4u __attribute__((ext_vector_type(4)));
typedef unsigned v2u __attribute__((ext_vector_type(2)));
typedef float f32x4 __attribute__((ext_vector_type(4)));
typedef GAS unsigned gu32;
#define RLX_AGENT __ATOMIC_RELAXED, __HIP_MEMORY_SCOPE_AGENT
#define LDS_WAIT() asm volatile("s_waitcnt lgkmcnt(0)" ::: "memory")
#define VM_WAIT() asm volatile("s_waitcnt vmcnt(0)" ::: "memory")
__device__ __forceinline__ unsigned f2bf(float f) { unsigned u = __builtin_bit_cast(unsigned, f); return (u + 0x7fffu + ((u >> 16) & 1u)) >> 16; }
__device__ __forceinline__ unsigned pk2(float lo, float hi) { return f2bf(lo) | (f2bf(hi) << 16); }
__device__ __forceinline__ float bflo(unsigned w) { return __builtin_bit_cast(float, w << 16); }
__device__ __forceinline__ float bfhi(unsigned w) { return __builtin_bit_cast(float, w & 0xffff0000u); }
__device__ __forceinline__ float bf2f(unsigned short u) { return __builtin_bit_cast(float, (unsigned)u << 16); }
__device__ __forceinline__ float wave_sum(float v) {
#pragma unroll
    for (int o = 1; o < 64; o <<= 1) v += __shfl_xor(v, o);
    return v;
}
__device__ __forceinline__ float wave_max(float v) {
#pragma unroll
    for (int o = 1; o < 64; o <<= 1) v = fmaxf(v, __shfl_xor(v, o));
    return v;
}
__device__ __forceinline__ int t5_bucket(int rel) {
    const int n = rel < 0 ? -rel : rel;
    const int b = n < 8 ? n : 8 + (n >= 15) + (n >= 27) + (n >= 50) + (n >= 91) + (n >= 166) + (n >= 305) + (n >= 559);
    return b + (rel > 0 ? 16 : 0);
}
#define XB_TMO      128
#define XB_XCNT(j)  (256  + 64 * (j))
#define XB_XSUB(j)  (1280 + 64 * (j))
#define XB_XGEN(j)  (2304 + 64 * (j))
#define XB_TOP      3328
#define XB_TOPGEN   3392
#define XCD_BAR_WORDS 3456
#define XB_SPIN_CAP (1u << 25)

__device__ __forceinline__ unsigned xb_ld(unsigned* p)              { return __hip_atomic_load(p, __ATOMIC_RELAXED, __HIP_MEMORY_SCOPE_AGENT); }
__device__ __forceinline__ unsigned xb_add(unsigned* p, unsigned v) { return __hip_atomic_fetch_add(p, v, __ATOMIC_RELAXED, __HIP_MEMORY_SCOPE_AGENT); }
__device__ __forceinline__ unsigned xb_xcc_id() { return (unsigned)__builtin_amdgcn_s_getreg((3 << 11) | 20) & 0xFu; }
#define XB_SPIN(cond, bar) do { unsigned _sp = 0; while (cond) { __builtin_amdgcn_s_sleep(1); \
    if ((++_sp & 255u) == 0u) { if (xb_ld(&(bar)[XB_TMO])) break; if (_sp > XB_SPIN_CAP) { atomicAdd(&(bar)[XB_TMO], 1u); break; } } } } while (0)

struct XcdBarrier {
    unsigned* bar; unsigned x;
    volatile LAS unsigned* st;
};

__device__ __forceinline__ XcdBarrier xcd_barrier_post(unsigned* bar, volatile LAS unsigned* st, bool leader) {
    XcdBarrier b; b.bar = bar; b.x = xb_xcc_id(); b.st = st;
    if (leader) (void)xb_add(&bar[XB_XCNT(b.x)], 1u);
    return b;
}
__device__ __forceinline__ void xcd_barrier_complete(unsigned* bar, unsigned x, unsigned& nloc, unsigned& nx) {
    const unsigned G = gridDim.x * gridDim.y * gridDim.z;
    unsigned sum, cnt, mine, sp = 0u;
    for (;;) {
        sum = 0u; cnt = 0u; mine = 0u;
#pragma unroll
        for (unsigned j = 0; j < 16; ++j) { const unsigned c = xb_ld(&bar[XB_XCNT(j)]); sum += c; cnt += (c > 0u) ? 1u : 0u; mine = (j == x) ? c : mine; }
        if (sum == G) break;
        __builtin_amdgcn_s_sleep(1);
        if ((++sp & 255u) == 0u) { if (xb_ld(&bar[XB_TMO])) break; if (sp > XB_SPIN_CAP) { atomicAdd(&bar[XB_TMO], 1u); break; } }
    }
    nloc = mine > 0u ? mine : 1u; nx = cnt > 0u ? cnt : 1u;
}

__device__ __forceinline__ void xcd_barrier(const XcdBarrier& b, bool leader) {
    asm volatile("s_waitcnt vmcnt(0)" ::: "memory");
    __syncthreads();
    if (leader) {
        unsigned* bar = b.bar;
        __builtin_amdgcn_s_waitcnt(0);
        unsigned nloc = b.st[0], nx = b.st[1];
        if (nloc == 0u) { xcd_barrier_complete(bar, b.x, nloc, nx); b.st[0] = nloc; b.st[1] = nx; }
        const unsigned old = xb_add(&bar[XB_XSUB(b.x)], 1u);
        const unsigned gen = old / nloc;
        if (old + 1u == (gen + 1u) * nloc) {
            __builtin_amdgcn_fence(__ATOMIC_RELEASE, "agent");
            asm volatile("s_waitcnt vmcnt(0)" ::: "memory");
            const unsigned og = xb_add(&bar[XB_TOP], 1u);
            const unsigned tg = og / nx;
            if (og + 1u == (tg + 1u) * nx) xb_add(&bar[XB_TOPGEN], 1u);
            else XB_SPIN(xb_ld(&bar[XB_TOPGEN]) == tg, bar);
            __builtin_amdgcn_fence(__ATOMIC_ACQUIRE, "agent");
            xb_add(&bar[XB_XGEN(b.x)], 1u);
            asm volatile("s_waitcnt vmcnt(0)" ::: "memory");
        } else {
            XB_SPIN(xb_ld(&bar[XB_XGEN(b.x)]) == gen, bar);
            __builtin_amdgcn_fence(__ATOMIC_ACQUIRE, "agent");
            asm volatile("s_waitcnt vmcnt(0)" ::: "memory");
        }
    }
    __syncthreads();
}
#ifndef PROBE_MASK
#define PROBE_MASK 0
#endif
#define REP(k) for (int rep_ = 0; rep_ < (((PROBE_MASK) >> (k)) & 1) + 1; ++rep_)

struct Frame {
    LAS unsigned char* lds;
    volatile LAS unsigned* MISC;
    int tid, lane, wave, vcu, G;
};
#define KIN(i) ((const float*)karg64_c<(i) * 8>())
#define KOUT() ((float*)karg64_c<160>())
#define KWS() ((unsigned char*)karg64_c<168>())
template <int OFF> __device__ __forceinline__ unsigned long long karg64_c() { unsigned long long p; asm volatile("s_load_dwordx2 %0, %1, %2\n\ts_waitcnt lgkmcnt(0)" : "=s"(p) : "s"(__builtin_amdgcn_kernarg_segment_ptr()), "n"(OFF)); return p; }
__device__ __forceinline__ int lane_id() { return (int)__builtin_amdgcn_mbcnt_hi(~0u, __builtin_amdgcn_mbcnt_lo(~0u, 0u)); }
__device__ __forceinline__ bool refresh(Frame& F) { int t_ = F.wave * 64 + lane_id(); asm volatile("" : "+v"(t_)); F.tid = t_; F.lane = t_ & 63; return true; }
#define XLEAD(F) ((F).wave == 0 && lane_id() == 0)
enum { I_X = 0, I_MEM, I_TAB, I_NG, I_EWIN, I_EKVN, I_EUK, I_EUV, I_ELAM, I_ESUB, I_EWOUT, I_OWIN, I_OSINK, I_OWOUT, I_XWQ, I_XWKV, I_XWO, I_XMN, I_W1, I_W2 };

__device__ __forceinline__ void tr_item(const float* src, int spitch, int scol0, bf16* dst, int dpitch, int drow0, int dcol0, int nblk, LAS float* scr, int item, int lane, const float* gk = nullptr) {
    const int kb = item / nblk, nb = item % nblk, k0 = 64 * kb, n0 = 32 * nb;
#pragma unroll 8
    for (int i = 0; i < 32; ++i) { const int kk = 2 * i + (lane >> 5); scr[kk * 33 + (lane & 31)] = ((const GAS float*)src)[(size_t)(k0 + kk) * spitch + scol0 + n0 + (lane & 31)] * (gk ? ((const GAS float*)gk)[k0 + kk] : 1.f); }
    LDS_WAIT(); asm volatile("" ::: "memory");
    const int c = lane & 7;
#pragma unroll
    for (int j = 0; j < 4; ++j) { const int n = (lane >> 3) + 8 * j; const LAS float* s = scr + (8 * c) * 33 + n;
        v4u o; o.x = pk2(s[0 * 33], s[1 * 33]); o.y = pk2(s[2 * 33], s[3 * 33]); o.z = pk2(s[4 * 33], s[5 * 33]); o.w = pk2(s[6 * 33], s[7 * 33]);
        *(GAS v4u*)(dst + (size_t)(drow0 + n0 + n) * dpitch + dcol0 + k0 + 8 * c) = o; }
    LDS_WAIT(); asm volatile("" ::: "memory");
}
__device__ __forceinline__ void fuse_qlat_item(const float* win, const float* wuk, bf16* dst, int item, int lane, const float* gk) {
    const int h = item >> 6, k0 = (item & 63) * 16;
    float a0[16], a1[16];
#pragma unroll
    for (int k = 0; k < 16; ++k) { a0[k] = 0.f; a1[k] = 0.f; }
    for (int d = 0; d < 64; ++d) {
        const float u0 = ((const GAS float*)wuk)[(size_t)(h * 64 + d) * 128 + 2 * lane], u1 = ((const GAS float*)wuk)[(size_t)(h * 64 + d) * 128 + 2 * lane + 1];
#pragma unroll
        for (int k = 0; k < 16; ++k) { const float w = ((const GAS float*)win)[(size_t)(k0 + k) * EVC + h * 64 + d]; a0[k] += w * u0; a1[k] += w * u1; }
    }
#pragma unroll
    for (int k = 0; k < 16; ++k) { const float gg = ((const GAS float*)gk)[k0 + k]; a0[k] *= gg; a1[k] *= gg; }
    v4u o0, o1, p0, p1;
    o0.x = pk2(a0[0], a0[1]); o0.y = pk2(a0[2], a0[3]); o0.z = pk2(a0[4], a0[5]); o0.w = pk2(a0[6], a0[7]);
    o1.x = pk2(a0[8], a0[9]); o1.y = pk2(a0[10], a0[11]); o1.z = pk2(a0[12], a0[13]); o1.w = pk2(a0[14], a0[15]);
    p0.x = pk2(a1[0], a1[1]); p0.y = pk2(a1[2], a1[3]); p0.z = pk2(a1[4], a1[5]); p0.w = pk2(a1[6], a1[7]);
    p1.x = pk2(a1[8], a1[9]); p1.y = pk2(a1[10], a1[11]); p1.z = pk2(a1[12], a1[13]); p1.w = pk2(a1[14], a1[15]);
    GAS v4u* r0 = (GAS v4u*)(dst + (size_t)(h * 128 + 2 * lane) * 1024 + k0); GAS v4u* r1 = (GAS v4u*)(dst + (size_t)(h * 128 + 2 * lane + 1) * 1024 + k0);
    r0[0] = o0; r0[1] = o1; r1[0] = p0; r1[1] = p1;
}
__device__ __forceinline__ void fuse_ov_item(const float* wuv, const float* wout, bf16* dst, int item, int lane) {
    const int h = item >> 6, n0 = (item & 63) * 16;
    float a0[16], a1[16];
#pragma unroll
    for (int k = 0; k < 16; ++k) { a0[k] = 0.f; a1[k] = 0.f; }
    for (int d = 0; d < 64; ++d) {
        const float u0 = ((const GAS float*)wuv)[(size_t)(h * 128 + 2 * lane) * 64 + d], u1 = ((const GAS float*)wuv)[(size_t)(h * 128 + 2 * lane + 1) * 64 + d];
#pragma unroll
        for (int k = 0; k < 16; ++k) { const float w = ((const GAS float*)wout)[(size_t)(h * 64 + d) * 1024 + n0 + k]; a0[k] += w * u0; a1[k] += w * u1; }
    }
#pragma unroll
    for (int k = 0; k < 16; ++k) *(GAS unsigned*)(dst + (size_t)(n0 + k) * HCE + h * 128 + 2 * lane) = pk2(a0[k], a1[k]);
}
__device__ __forceinline__ void widx_item(const float* win, bf16* dst, int item, int lane, const float* gk) {
    const int k = item * 64 + lane; const float gg = ((const GAS float*)gk)[k];
    for (int n = 0; n < 64; ++n) { const float v = n < 8 ? ((const GAS float*)win)[(size_t)k * EVC + 1216 + n] * gg : 0.f; ((GAS bf16*)dst)[(size_t)(ZWI + n) * 1024 + k] = (bf16)f2bf(v); }
}

__device__ __forceinline__ void convert_weights(Frame& F, int l) {
    LAS float* scr = (LAS float*)(F.lds + RING_OFF + F.wave * 16384);
    const int gw = F.vcu * NWAVES + F.wave, NGW = F.G * NWAVES;
    bf16* WIN = (bf16*)(KWS() + WS_WGT + WO_WIN); bf16* WOUT = (bf16*)(KWS() + WS_WGT + WO_WOUT); bf16* WQ = (bf16*)(KWS() + WS_WGT + WO_WQ); bf16* WKV = (bf16*)(KWS() + WS_WGT + WO_WKV);
    bf16* WO = (bf16*)(KWS() + WS_WGT + WO_WO); bf16* W1 = (bf16*)(KWS() + WS_WGT + WO_W1); bf16* W2 = (bf16*)(KWS() + WS_WGT + WO_W2);
    const float* wq = KIN(I_XWQ) + (size_t)l * 1024 * 256; const float* wkv = KIN(I_XWKV) + (size_t)l * 1024 * 512; const float* wo = KIN(I_XWO) + (size_t)l * 256 * 1024;
    const float* w1 = KIN(I_W1) + (size_t)l * 1024 * 4096; const float* w2 = KIN(I_W2) + (size_t)l * 4096 * 1024;
    constexpr int N_Q = 16 * 8, N_KV = 16 * 16, N_O = 4 * 32, N_1 = 16 * 128, N_2 = 64 * 32;
    const float* g0 = KIN(I_NG) + (size_t)l * 6 * D; const float* g2 = g0 + 2 * D; const float* g4 = g0 + 4 * D;
    if ((l & 1) == 0) {
        const int e = l >> 1;
        const float* win = KIN(I_EWIN) + (size_t)e * 1024 * EVC; const float* wout = KIN(I_EWOUT) + (size_t)e * 1024 * 1024;
        const float* wuk = KIN(I_EUK) + (size_t)e * 8 * 64 * 128; const float* wuv = KIN(I_EUV) + (size_t)e * 8 * 128 * 64;
        constexpr int A0 = 512, A1 = 16 * 4, A2 = 16 * 16, A3 = 16 * 2, A4 = 16 * 48, A5 = 16, A6 = 512, A7 = 8 * 32;
        constexpr int TOT = A0 + A1 + A2 + A3 + A4 + A5 + A6 + A7 + N_Q + N_KV + N_O + N_1 + N_2;
        for (int it = gw; it < TOT; it += NGW) {
            int r = it;
            if (r < A0) { fuse_qlat_item(win, wuk, WIN, r, F.lane, g0); continue; } r -= A0;
            if (r < A1) { tr_item(win, EVC, 512, WIN, 1024, ZCKV, 0, 4, scr, r, F.lane, g0); continue; } r -= A1;
            if (r < A2) { tr_item(win, EVC, 640, WIN, 1024, ZQI, 0, 16, scr, r, F.lane, g0); continue; } r -= A2;
            if (r < A3) { tr_item(win, EVC, 1152, WIN, 1024, ZKI, 0, 2, scr, r, F.lane, g0); continue; } r -= A3;
            if (r < A4) { tr_item(win, EVC, 1224, WIN, 1024, ZQB, 0, 48, scr, r, F.lane, g0); continue; } r -= A4;
            if (r < A5) { widx_item(win, WIN, r, F.lane, g0); continue; } r -= A5;
            if (r < A6) { fuse_ov_item(wuv, wout, WOUT, r, F.lane); continue; } r -= A6;
            if (r < A7) { tr_item(wout + (size_t)512 * 1024, 1024, 0, WOUT, HCE, 0, 1024, 32, scr, r, F.lane); continue; } r -= A7;
            if (r < N_Q) { tr_item(wq, 256, 0, WQ, 1024, 0, 0, 8, scr, r, F.lane, g2); continue; } r -= N_Q;
            if (r < N_KV) { tr_item(wkv, 512, 0, WKV, 1024, 0, 0, 16, scr, r, F.lane); continue; } r -= N_KV;
            if (r < N_O) { tr_item(wo, 1024, 0, WO, 256, 0, 0, 32, scr, r, F.lane); continue; } r -= N_O;
            if (r < N_1) { tr_item(w1, 4096, 0, W1, 1024, 0, 0, 128, scr, r, F.lane, g4); continue; } r -= N_1;
            tr_item(w2, 1024, 0, W2, 4096, 0, 0, 32, scr, r, F.lane);
        }
    } else {
        const int o = l >> 1;
        const float* win = KIN(I_OWIN) + (size_t)o * 1024 * ZO; const float* wout = KIN(I_OWOUT) + (size_t)o * 1024 * 1024;
        constexpr int B0 = 16 * 40, B1 = 16 * 32;
        constexpr int TOT = B0 + B1 + N_Q + N_KV + N_O + N_1 + N_2;
        for (int it = gw; it < TOT; it += NGW) {
            int r = it;
            if (r < B0) { tr_item(win, ZO, 0, WIN, 1024, 0, 0, 40, scr, r, F.lane, g0); continue; } r -= B0;
            if (r < B1) { tr_item(wout, 1024, 0, WOUT, 1024, 0, 0, 32, scr, r, F.lane); continue; } r -= B1;
            if (r < N_Q) { tr_item(wq, 256, 0, WQ, 1024, 0, 0, 8, scr, r, F.lane, g2); continue; } r -= N_Q;
            if (r < N_KV) { tr_item(wkv, 512, 0, WKV, 1024, 0, 0, 16, scr, r, F.lane); continue; } r -= N_KV;
            if (r < N_O) { tr_item(wo, 1024, 0, WO, 256, 0, 0, 32, scr, r, F.lane); continue; } r -= N_O;
            if (r < N_1) { tr_item(w1, 4096, 0, W1, 1024, 0, 0, 128, scr, r, F.lane, g4); continue; } r -= N_1;
            tr_item(w2, 1024, 0, W2, 4096, 0, 0, 32, scr, r, F.lane);
        }
    }
}

__device__ __forceinline__ void row_first(int lane, const float* xin, float* xout, const float* g, bf16* h) {
    const GAS f32x4* xr = (const GAS f32x4*)xin + lane; f32x4 v[4]; float ss = 0.f;
#pragma unroll
    for (int j = 0; j < 4; ++j) { v[j] = xr[64 * j]; ss += (v[j].x * v[j].x + v[j].y * v[j].y) + (v[j].z * v[j].z + v[j].w * v[j].w); }
    const float r = 1.f / sqrtf(wave_sum(ss) * (1.f / 1024.f) + EPS);
    const GAS f32x4* gr = (const GAS f32x4*)g + lane; GAS v2u* ho = (GAS v2u*)h + lane;
#pragma unroll
    for (int j = 0; j < 4; ++j) {
        if (xout) ((GAS f32x4*)xout + lane)[64 * j] = v[j];
        const f32x4 gg = gr[64 * j]; v2u o; o.x = pk2(v[j].x * r * gg.x, v[j].y * r * gg.y); o.y = pk2(v[j].z * r * gg.z, v[j].w * r * gg.w); ho[64 * j] = o; }
}
__device__ __forceinline__ void row_mid(int lane, const bf16* y, float* x, const float* ga, const float* gb, bf16* h) {
    const GAS v2u* yr = (const GAS v2u*)y + lane; GAS f32x4* xr = (GAS f32x4*)x + lane; f32x4 yv[4], xv[4]; float ss = 0.f;
#pragma unroll
    for (int j = 0; j < 4; ++j) { const v2u w = yr[64 * j]; yv[j] = (f32x4){bflo(w.x), bfhi(w.x), bflo(w.y), bfhi(w.y)}; xv[j] = xr[64 * j];
        ss += (yv[j].x * yv[j].x + yv[j].y * yv[j].y) + (yv[j].z * yv[j].z + yv[j].w * yv[j].w); }
    const float r1 = 1.f / sqrtf(wave_sum(ss) * (1.f / 1024.f) + EPS);
    const GAS f32x4* gar = (const GAS f32x4*)ga + lane; float s2 = 0.f;
#pragma unroll
    for (int j = 0; j < 4; ++j) { const f32x4 gg = gar[64 * j]; xv[j].x += yv[j].x * r1 * gg.x; xv[j].y += yv[j].y * r1 * gg.y; xv[j].z += yv[j].z * r1 * gg.z; xv[j].w += yv[j].w * r1 * gg.w;
        xr[64 * j] = xv[j]; s2 += (xv[j].x * xv[j].x + xv[j].y * xv[j].y) + (xv[j].z * xv[j].z + xv[j].w * xv[j].w); }
    if (gb) {
        const float r2 = 1.f / sqrtf(wave_sum(s2) * (1.f / 1024.f) + EPS);
        const GAS f32x4* gbr = (const GAS f32x4*)gb + lane; GAS v2u* ho = (GAS v2u*)h + lane;
#pragma unroll
        for (int j = 0; j < 4; ++j) { const f32x4 gg = gbr[64 * j]; v2u o; o.x = pk2(xv[j].x * r2 * gg.x, xv[j].y * r2 * gg.y); o.y = pk2(xv[j].z * r2 * gg.z, xv[j].w * r2 * gg.w); ho[64 * j] = o; }
    }
}
__device__ __forceinline__ void thin_first(Frame& F) {
    const int gw = F.vcu * NWAVES + F.wave, NGW = F.G * NWAVES, lane = F.lane; bf16* xb = (bf16*)((unsigned char*)KOUT() + XB_OFF); float* rs = (float*)(KWS() + WS_RS);
    const float* xin = KIN(I_X);
    for (int m = gw; m < M; m += NGW) {
        const GAS f32x4* xr = (const GAS f32x4*)(xin + (size_t)m * D) + lane; f32x4 v[4]; float ss = 0.f;
#pragma unroll
        for (int j = 0; j < 4; ++j) { v[j] = xr[64 * j]; ss += (v[j].x * v[j].x + v[j].y * v[j].y) + (v[j].z * v[j].z + v[j].w * v[j].w); }
        const float r = 1.f / sqrtf(wave_sum(ss) * (1.f / 1024.f) + EPS);
        GAS v2u* xo = (GAS v2u*)(xb + (size_t)m * D) + lane;
#pragma unroll
        for (int j = 0; j < 4; ++j) { v2u o; o.x = pk2(v[j].x, v[j].y); o.y = pk2(v[j].z, v[j].w); xo[64 * j] = o; }
        if (lane == 0) ((GAS float*)rs)[m] = r;
    }
}
template <bool FINAL> __device__ __forceinline__ void thin_mid(Frame& F, const float* ga) {
    const int gw = F.vcu * NWAVES + F.wave, NGW = F.G * NWAVES, lane = F.lane; bf16* xb = (bf16*)((unsigned char*)KOUT() + XB_OFF); float* rs = (float*)(KWS() + WS_RS);
    const bf16* y = (const bf16*)(KWS() + WS_Y); float* outp = KOUT(); float* ft = (float*)(KWS() + WS_FT);
    f32x4 g4[4];
#pragma unroll
    for (int j = 0; j < 4; ++j) g4[j] = ((const GAS f32x4*)ga + lane)[64 * j];
    for (int m0 = gw; m0 < M; m0 += 2 * NGW) {
        v2u yw[2][4], xw[2][4];
#pragma unroll
        for (int a = 0; a < 2; ++a) { const int m = m0 + a * NGW;
#pragma unroll
            for (int j = 0; j < 4; ++j) { yw[a][j] = ((const GAS v2u*)(y + (size_t)m * D) + lane)[64 * j]; xw[a][j] = ((const GAS v2u*)(xb + (size_t)m * D) + lane)[64 * j]; } }
#pragma unroll
        for (int a = 0; a < 2; ++a) { const int m = m0 + a * NGW;
            f32x4 yv[4], xv[4]; float ss = 0.f;
#pragma unroll
            for (int j = 0; j < 4; ++j) { yv[j] = (f32x4){bflo(yw[a][j].x), bfhi(yw[a][j].x), bflo(yw[a][j].y), bfhi(yw[a][j].y)}; xv[j] = (f32x4){bflo(xw[a][j].x), bfhi(xw[a][j].x), bflo(xw[a][j].y), bfhi(xw[a][j].y)};
                ss += (yv[j].x * yv[j].x + yv[j].y * yv[j].y) + (yv[j].z * yv[j].z + yv[j].w * yv[j].w); }
            const float r1 = 1.f / sqrtf(wave_sum(ss) * (1.f / 1024.f) + EPS); float s2 = 0.f;
#pragma unroll
            for (int j = 0; j < 4; ++j) { xv[j].x += yv[j].x * r1 * g4[j].x; xv[j].y += yv[j].y * r1 * g4[j].y; xv[j].z += yv[j].z * r1 * g4[j].z; xv[j].w += yv[j].w * r1 * g4[j].w;
                s2 += (xv[j].x * xv[j].x + xv[j].y * xv[j].y) + (xv[j].z * xv[j].z + xv[j].w * xv[j].w); }
            if (FINAL) { GAS f32x4* fo = (GAS f32x4*)(m < M / 2 ? outp + (size_t)m * D : ft + (size_t)(m - M / 2) * D) + lane;
#pragma unroll
                for (int j = 0; j < 4; ++j) fo[64 * j] = xv[j];
            } else { GAS v2u* xo = (GAS v2u*)(xb + (size_t)m * D) + lane;
#pragma unroll
                for (int j = 0; j < 4; ++j) { v2u o; o.x = pk2(xv[j].x, xv[j].y); o.y = pk2(xv[j].z, xv[j].w); xo[64 * j] = o; }
                const float r2 = 1.f / sqrtf(wave_sum(s2) * (1.f / 1024.f) + EPS);
                if (lane == 0) ((GAS float*)rs)[m] = r2; }
        }
    }
}
__device__ __forceinline__ void final_copy(Frame& F) {
    const GAS f32x4* src = (const GAS f32x4*)(KWS() + WS_FT); GAS f32x4* dst = (GAS f32x4*)(KOUT() + (size_t)(M / 2) * D);
    const size_t n4 = (size_t)(M / 2) * D / 4, stride = (size_t)F.G * NWAVES * 64;
    for (size_t i = (size_t)(F.vcu * NWAVES + F.wave) * 64 + F.lane; i < n4; i += stride) dst[i] = src[i];
}
__device__ __forceinline__ void thin_memn(Frame& F, const float* g) {
    const int gw = F.vcu * NWAVES + F.wave, NGW = F.G * NWAVES; bf16* mn = (bf16*)(KWS() + WS_MEMN);
    for (int m = NGW - 1 - gw; m < NB * NMEM; m += NGW) row_first(F.lane, KIN(I_MEM) + (size_t)m * D, nullptr, g, mn + (size_t)m * D);
}
__device__ __forceinline__ void thin_ckvn(Frame& F, const float* akvn) {
    const int gw = F.vcu * NWAVES + F.wave, NGW = F.G * NWAVES; const bf16* z = (const bf16*)(KWS() + WS_Z); bf16* ck = (bf16*)(KWS() + WS_CKVN);
    const float g0 = ((const GAS float*)akvn)[2 * F.lane], g1 = ((const GAS float*)akvn)[2 * F.lane + 1];
    for (int m = gw; m < M; m += NGW) {
        const unsigned w = *((const GAS unsigned*)(z + (size_t)m * ZE + ZCKV) + F.lane); const float a = bflo(w), b = bfhi(w);
        const float r = 1.f / sqrtf(wave_sum(a * a + b * b) * (1.f / 128.f) + EPS);
        *((GAS unsigned*)(ck + (size_t)m * 128) + F.lane) = pk2(a * r * g0, b * r * g1);
    }
}

#define UNPK8(dst, off, VV) do { dst[(off) + 0] = bflo((VV).x); dst[(off) + 1] = bfhi((VV).x); dst[(off) + 2] = bflo((VV).y); dst[(off) + 3] = bfhi((VV).y); \
    dst[(off) + 4] = bflo((VV).z); dst[(off) + 5] = bfhi((VV).z); dst[(off) + 6] = bflo((VV).w); dst[(off) + 7] = bfhi((VV).w); } while (0)
#define DOT8(q, off, VV) ((q[(off) + 0] * bflo((VV).x) + q[(off) + 1] * bfhi((VV).x)) + (q[(off) + 2] * bflo((VV).y) + q[(off) + 3] * bfhi((VV).y)) + \
    (q[(off) + 4] * bflo((VV).z) + q[(off) + 5] * bfhi((VV).z)) + (q[(off) + 6] * bflo((VV).w) + q[(off) + 7] * bfhi((VV).w)))
#define AXPY8(acc, off, al, p, VV) do { acc[(off) + 0] = acc[(off) + 0] * (al) + (p) * bflo((VV).x); acc[(off) + 1] = acc[(off) + 1] * (al) + (p) * bfhi((VV).x); \
    acc[(off) + 2] = acc[(off) + 2] * (al) + (p) * bflo((VV).y); acc[(off) + 3] = acc[(off) + 3] * (al) + (p) * bfhi((VV).y); \
    acc[(off) + 4] = acc[(off) + 4] * (al) + (p) * bflo((VV).z); acc[(off) + 5] = acc[(off) + 5] * (al) + (p) * bfhi((VV).z); \
    acc[(off) + 6] = acc[(off) + 6] * (al) + (p) * bflo((VV).w); acc[(off) + 7] = acc[(off) + 7] * (al) + (p) * bfhi((VV).w); } while (0)

__device__ __forceinline__ void xattn_naive(Frame& F) {
    LAS v4u* Ks = (LAS v4u*)(F.lds); LAS v4u* Vs = (LAS v4u*)(F.lds + 32768);
    const bf16* kvm = (const bf16*)(KWS() + WS_KVM); const bf16* qx = (const bf16*)(KWS() + WS_QX); bf16* ox = (bf16*)(KWS() + WS_OX);
    for (int u = F.vcu; u < 256; u += F.G) {
        const int b = u >> 6, h = (u >> 4) & 3, blk = u & 15;
        __syncthreads();
        for (int i = F.tid; i < 2048; i += 512) { const int key = i >> 3, c = i & 7;
            const GAS v4u* src = (const GAS v4u*)(kvm + (size_t)(b * NMEM + key) * 512 + h * 64) + c; Ks[i] = src[0]; Vs[i] = src[32]; }
        __syncthreads();
        const size_t token = (size_t)b * SEQ + blk * 512 + F.tid;
        float q[64], acc[64];
        { const GAS v4u* qp = (const GAS v4u*)(qx + token * 256 + h * 64);
#pragma unroll
          for (int c = 0; c < 8; ++c) { const v4u w = qp[c]; UNPK8(q, 8 * c, w); } }
#pragma unroll
        for (int d = 0; d < 64; ++d) acc[d] = 0.f;
        float m = -1e30f, l = 0.f;
        for (int key = 0; key < NMEM; ++key) {
            float s = 0.f;
#pragma unroll
            for (int c = 0; c < 8; ++c) { const v4u w = Ks[key * 8 + c]; s += DOT8(q, 8 * c, w); }
            s *= 0.125f;
            const float mn = fmaxf(m, s), al = __expf(m - mn), p = __expf(s - mn); l = l * al + p; m = mn;
#pragma unroll
            for (int c = 0; c < 8; ++c) { const v4u w = Vs[key * 8 + c]; AXPY8(acc, 8 * c, al, p, w); }
        }
        const float inv = 1.f / l;
        GAS v4u* op = (GAS v4u*)(ox + token * 256 + h * 64);
#pragma unroll
        for (int c = 0; c < 8; ++c) { v4u o; o.x = pk2(acc[8 * c] * inv, acc[8 * c + 1] * inv); o.y = pk2(acc[8 * c + 2] * inv, acc[8 * c + 3] * inv);
            o.z = pk2(acc[8 * c + 4] * inv, acc[8 * c + 5] * inv); o.w = pk2(acc[8 * c + 6] * inv, acc[8 * c + 7] * inv); op[c] = o; }
    }
}

__device__ __forceinline__ void swa_naive(Frame& F, int o) {
    LAS v4u* Ks = (LAS v4u*)(F.lds); LAS v4u* Vs = (LAS v4u*)(F.lds + 24576); LAS float* lut = (LAS float*)(F.lds + 49152);
    const bf16* z = (const bf16*)(KWS() + WS_Z); bf16* hc = (bf16*)(KWS() + WS_HC);
    const float* tab = KIN(I_TAB); const float* sinks = KIN(I_OSINK) + o * 16;
    for (int u = F.vcu; u < NB * 128 * 2; u += F.G) {
        const int b = u >> 8, c = (u >> 1) & 127, kvh = u & 1;
        __syncthreads();
        const int jmin = c >= 2 ? 0 : (2 - c) * 64;
        for (int i = F.tid; i < 192 * 8; i += 512) { const int j = i >> 3, cc = i & 7;
            if (j >= jmin) { const size_t kt = (size_t)b * SEQ + (c - 2) * 64 + j;
                Ks[i] = *((const GAS v4u*)(z + kt * ZO + OKK + kvh * 64) + cc); Vs[i] = *((const GAS v4u*)(z + kt * ZO + OVV + kvh * 64) + cc); } }
        for (int i = F.tid; i < 8 * 256; i += 512) { const int g = i >> 8, r = i & 255; lut[i] = r < 255 ? ((const GAS float*)tab)[t5_bucket(r - 191) * 28 + 12 + kvh * 8 + g] : 0.f; }
        __syncthreads();
        const int g = F.wave, head = kvh * 8 + g, qi = F.lane;
        const size_t token = (size_t)b * SEQ + c * 64 + qi;
        float q[64], acc[64];
        { const GAS v4u* qp = (const GAS v4u*)(z + token * ZO + OQ + head * 64);
#pragma unroll
          for (int cc = 0; cc < 8; ++cc) { const v4u w = qp[cc]; UNPK8(q, 8 * cc, w); } }
#pragma unroll
        for (int d = 0; d < 64; ++d) acc[d] = 0.f;
        float m = ((const GAS float*)sinks)[head], l = 1.f;
        for (int j = jmin; j < 192; ++j) {
            float s = 0.f;
#pragma unroll
            for (int cc = 0; cc < 8; ++cc) { const v4u w = Ks[j * 8 + cc]; s += DOT8(q, 8 * cc, w); }
            s = s * 0.125f + lut[g * 256 + j + 63 - qi];
            const float mn = fmaxf(m, s), al = __expf(m - mn), p = __expf(s - mn); l = l * al + p; m = mn;
#pragma unroll
            for (int cc = 0; cc < 8; ++cc) { const v4u w = Vs[j * 8 + cc]; AXPY8(acc, 8 * cc, al, p, w); }
        }
        const float inv = 1.f / l;
        GAS v4u* op = (GAS v4u*)(hc + token * HCO + head * 64);
#pragma unroll
        for (int cc = 0; cc < 8; ++cc) { v4u ov; ov.x = pk2(acc[8 * cc] * inv, acc[8 * cc + 1] * inv); ov.y = pk2(acc[8 * cc + 2] * inv, acc[8 * cc + 3] * inv);
            ov.z = pk2(acc[8 * cc + 4] * inv, acc[8 * cc + 5] * inv); ov.w = pk2(acc[8 * cc + 6] * inv, acc[8 * cc + 7] * inv); op[cc] = ov; }
    }
}

constexpr int DLUT = 832, DLUT_OFF = 767;
__device__ __forceinline__ void diff_naive(Frame& F, int e, float lam_init) {
    LAS v4u* Ks = (LAS v4u*)(F.lds); LAS v4u* Vs = (LAS v4u*)(F.lds + 16384); LAS float* lut = (LAS float*)(F.lds + 32768); LAS float* xb = (LAS float*)(F.lds + 36864);
    LAS float* xs = (LAS float*)(F.lds + 36864 + 256 * 65 * 4);
    const bf16* z = (const bf16*)(KWS() + WS_Z); bf16* hc = (bf16*)(KWS() + WS_HC);
    const float* tab = KIN(I_TAB); const float* lamv = KIN(I_ELAM) + e * 256; const float* subln = KIN(I_ESUB) + e * 128;
    float lam;
    { const float a = ((const GAS float*)lamv)[F.lane] * ((const GAS float*)lamv)[64 + F.lane], b2 = ((const GAS float*)lamv)[128 + F.lane] * ((const GAS float*)lamv)[192 + F.lane];
      lam = __expf(wave_sum(a)) - __expf(wave_sum(b2)) + lam_init; }
    for (int u = F.vcu; u < NB * 4 * 64; u += F.G) {
        const int b = u >> 8, h = (u >> 6) & 3, qb = u & 63;
        const int mm = F.tid >> 8, half = (F.tid >> 7) & 1, qi = F.tid & 127, t = qb * 128 + qi, ct = t >> 6;
        const size_t token = (size_t)b * SEQ + t;
        __syncthreads();
        for (int i = F.tid; i < DLUT; i += 512) lut[i] = ((const GAS float*)tab)[t5_bucket(i - DLUT_OFF) * 28 + 8 + h];
        float acc[64]; v4u qpk[8];
        { const GAS v4u* qp = (const GAS v4u*)(z + token * ZE + ZQB + h * 128 + mm * 64);
#pragma unroll
          for (int c = 0; c < 8; ++c) qpk[c] = qp[c]; }
#pragma unroll
        for (int d = 0; d < 64; ++d) acc[d] = 0.f;
        float m = -1e30f, l = 0.f;
        const int ntile = 2 * qb + 2;
        for (int tile = 0; tile < ntile; ++tile) {
            __syncthreads();
            for (int i = F.tid; i < 1024; i += 512) { const int key = i >> 4, c = i & 15; const size_t kt = (size_t)b * SEQ + tile * 64 + key;
                Ks[i] = *((const GAS v4u*)(z + kt * ZE + ZKB + h * 128) + c); Vs[i] = *((const GAS v4u*)(z + kt * ZE + ZVB + h * 128) + c); }
            __syncthreads();
            if (tile <= ct) {
                for (int key = 0; key < 64; ++key) {
                    float s = 0.f;
#pragma unroll
                    for (int c = 0; c < 8; ++c) { const v4u w = Ks[key * 16 + mm * 8 + c]; float qq[8]; UNPK8(qq, 0, qpk[c]); s += DOT8(qq, 0, w); }
                    int rel = tile * 64 + key - t; rel = rel < -DLUT_OFF ? -DLUT_OFF : rel;
                    s = s * 0.125f + lut[rel + DLUT_OFF];
                    const float mn = fmaxf(m, s), al = __expf(m - mn), p = __expf(s - mn); l = l * al + p; m = mn;
#pragma unroll
                    for (int c = 0; c < 8; ++c) { const v4u w = Vs[key * 16 + half * 8 + c]; AXPY8(acc, 8 * c, al, p, w); }
                }
            }
        }
        const float inv = 1.f / l;
#pragma unroll
        for (int d = 0; d < 64; ++d) acc[d] *= inv;
        __syncthreads();
        if (mm == 1) {
#pragma unroll
            for (int d = 0; d < 64; ++d) xb[(half * 128 + qi) * 65 + d] = acc[d]; }
        __syncthreads();
        float ss = 0.f;
        if (mm == 0) {
#pragma unroll
            for (int d = 0; d < 64; ++d) { acc[d] -= lam * xb[(half * 128 + qi) * 65 + d]; ss += acc[d] * acc[d]; }
            xs[half * 128 + qi] = ss; }
        __syncthreads();
        if (mm == 0) {
            ss += xs[(half ^ 1) * 128 + qi];
            const float rr = (1.f / sqrtf(ss * (1.f / 128.f) + EPS)) * (1.f - lam_init);
            GAS v4u* op = (GAS v4u*)(hc + token * HCE + 1024 + h * 128 + half * 64);
#pragma unroll
            for (int c = 0; c < 8; ++c) { const GAS f32x4* sg = (const GAS f32x4*)(subln + half * 64 + 8 * c); const f32x4 g0 = sg[0], g1 = sg[1]; v4u ov;
                ov.x = pk2(acc[8 * c] * rr * g0.x, acc[8 * c + 1] * rr * g0.y); ov.y = pk2(acc[8 * c + 2] * rr * g0.z, acc[8 * c + 3] * rr * g0.w);
                ov.z = pk2(acc[8 * c + 4] * rr * g1.x, acc[8 * c + 5] * rr * g1.y); ov.w = pk2(acc[8 * c + 6] * rr * g1.z, acc[8 * c + 7] * rr * g1.w); op[c] = ov; }
        }
    }
}

typedef short bf16x8_t __attribute__((ext_vector_type(8)));
typedef float f32x16 __attribute__((ext_vector_type(16)));
typedef short v4i16_t __attribute__((ext_vector_type(4)));
constexpr int DK_STR = 272, DV_STR = 320, DSTG = 64 * DK_STR + 64 * DV_STR, D_LUTOFF = 2 * DSTG, D_QOFF = D_LUTOFF + 3328;
static_assert(D_QOFF + 32768 <= RING_BYTES, "diff LDS map");
__device__ __forceinline__ unsigned cvtpk(float lo, float hi) { unsigned r; asm("v_cvt_pk_bf16_f32 %0, %1, %2" : "=v"(r) : "v"(lo), "v"(hi)); return r; }
__device__ __forceinline__ bf16x8_t vtr8(const LAS unsigned char* p0, const LAS unsigned char* p1) {
    const v4i16_t a = __builtin_amdgcn_ds_read_tr16_b64_v4i16((LAS v4i16_t*)p0), b = __builtin_amdgcn_ds_read_tr16_b64_v4i16((LAS v4i16_t*)p1);
    return (bf16x8_t){a[0], a[1], a[2], a[3], b[0], b[1], b[2], b[3]};
}
__device__ __forceinline__ void diff_mfma(Frame& F, int e) {
    const float lam_init = __builtin_bit_cast(float, (unsigned)__builtin_amdgcn_readfirstlane(e == 0 ? 0x3e4ccccd : 0x3ef1014c));
    LAS unsigned char* L = F.lds; LAS float* lut = (LAS float*)(L + D_LUTOFF); LAS float* xbuf = (LAS float*)L;
    const bf16* z = (const bf16*)(KWS() + WS_Z); bf16* hc = (bf16*)(KWS() + WS_HC);
    const float* tab = KIN(I_TAB); const float* lamv = KIN(I_ELAM) + e * 256; const float* subln = KIN(I_ESUB) + e * 128;
    const int w = F.wave, lane = F.lane, r32 = lane & 31, hi = lane >> 5, mm = w >> 2, wq = w & 3;
    float lam;
    { const float a = ((const GAS float*)lamv)[lane] * ((const GAS float*)lamv)[64 + lane], b2 = ((const GAS float*)lamv)[128 + lane] * ((const GAS float*)lamv)[192 + lane];
      lam = __expf(wave_sum(a)) - __expf(wave_sum(b2)) + lam_init; }
    constexpr float C2 = 0.125f * LOG2E;
    const int bh = F.vcu >> 4, su = F.vcu & 15, b = bh >> 2, h = bh & 3;
#pragma unroll 1
    for (int rr = 0; rr < 4; ++rr) {
        const int qb = rr == 0 ? su : rr == 1 ? 31 - su : rr == 2 ? 32 + su : 63 - su;
        const int q0 = qb * 128 + wq * 32, cw = q0 >> 6, NT = 2 * qb + 2, tq = q0 + r32;
        __syncthreads();
        for (int i = F.tid; i < DLUT; i += 512) lut[i] = ((const GAS float*)tab)[t5_bucket(i - DLUT_OFF) * 28 + 8 + h] * LOG2E;
        LAS bf16x8_t* qlds = (LAS bf16x8_t*)(L + D_QOFF) + w * 256 + lane;
        { const bf16* qrow = z + ((size_t)b * SEQ + tq) * ZE + ZQB + h * 128 + mm * 64 + 8 * hi;
#pragma unroll
          for (int ks = 0; ks < 4; ++ks) qlds[ks * 64] = *(const GAS bf16x8_t*)(qrow + 16 * ks); }
        const int k0i = F.tid >> 4, c0 = F.tid & 15;
        const bf16* ksrc = z + ((size_t)b * SEQ + k0i) * ZE + ZKB + h * 128 + c0 * 8;
        const bf16* vsrc = z + ((size_t)b * SEQ + k0i) * ZE + ZVB + h * 128 + c0 * 8;
        const int kdst = k0i * DK_STR + c0 * 16, vdst = 64 * DK_STR + k0i * DV_STR + c0 * 16;
        v4u pk0, pk1, pv0, pv1;
        pk0 = *(const GAS v4u*)(ksrc); pk1 = *(const GAS v4u*)(ksrc + (size_t)32 * ZE); pv0 = *(const GAS v4u*)(vsrc); pv1 = *(const GAS v4u*)(vsrc + (size_t)32 * ZE);
        *(LAS v4u*)(L + kdst) = pk0; *(LAS v4u*)(L + kdst + 32 * DK_STR) = pk1; *(LAS v4u*)(L + vdst) = pv0; *(LAS v4u*)(L + vdst + 32 * DV_STR) = pv1;
        __syncthreads();
        f32x16 o[4];
#pragma unroll
        for (int i = 0; i < 4; ++i)
#pragma unroll
            for (int r = 0; r < 16; ++r) o[i][r] = 0.f;
        float m_run = -1e30f, l_run = 0.f;
        const int ka = r32 * DK_STR + (mm * 64 + 8 * hi) * 2;
        const int va = (4 * hi + ((lane & 15) >> 2)) * DV_STR + (16 * ((lane >> 4) & 1) + 4 * (lane & 3)) * 2;
#pragma unroll 1
        for (int t = 0; t < NT; ++t) {
            const int stg = (t & 1) * DSTG;
            if (t + 1 < NT) { const size_t off = (size_t)(t + 1) * 64 * ZE;
                pk0 = *(const GAS v4u*)(ksrc + off); pk1 = *(const GAS v4u*)(ksrc + off + (size_t)32 * ZE); pv0 = *(const GAS v4u*)(vsrc + off); pv1 = *(const GAS v4u*)(vsrc + off + (size_t)32 * ZE); }
            if (t <= cw) {
                const LAS unsigned char* Kb = L + stg + ka; const LAS unsigned char* Vb = L + stg + 64 * DK_STR + va;
                f32x16 s0, s1; bf16x8_t qf[4];
#pragma unroll
                for (int ks = 0; ks < 4; ++ks) qf[ks] = qlds[ks * 64];
#pragma unroll
                for (int r = 0; r < 16; ++r) { s0[r] = 0.f; s1[r] = 0.f; }
                bf16x8_t ka0[4], ka1[4];
#pragma unroll
                for (int ks = 0; ks < 4; ++ks) { ka0[ks] = *(const LAS bf16x8_t*)(Kb + ks * 32); ka1[ks] = *(const LAS bf16x8_t*)(Kb + 32 * DK_STR + ks * 32); }
                __builtin_amdgcn_sched_barrier(0);
#pragma unroll
                for (int ks = 0; ks < 4; ++ks) { s0 = __builtin_amdgcn_mfma_f32_32x32x16_bf16(ka0[ks], qf[ks], s0, 0, 0, 0); s1 = __builtin_amdgcn_mfma_f32_32x32x16_bf16(ka1[ks], qf[ks], s1, 0, 0, 0); }
                if (64 * t + 622 > q0) {
                    const LAS float* lp = lut + (64 * t - tq + DLUT_OFF + 4 * hi);
#pragma unroll
                    for (int r = 0; r < 16; ++r) { const int ko = (r & 3) + 8 * (r >> 2); s0[r] = s0[r] * C2 + lp[ko]; s1[r] = s1[r] * C2 + lp[ko + 32]; }
                } else { const float bf = lut[0];
#pragma unroll
                    for (int r = 0; r < 16; ++r) { s0[r] = s0[r] * C2 + bf; s1[r] = s1[r] * C2 + bf; } }
                float mx = fmaxf(s0[0], s1[0]);
#pragma unroll
                for (int r = 1; r < 16; ++r) mx = fmaxf(mx, fmaxf(s0[r], s1[r]));
                mx = fmaxf(mx, __shfl_xor(mx, 32));
                if (__any(mx > m_run)) { const float mn = fmaxf(m_run, mx), al = __builtin_amdgcn_exp2f(m_run - mn); m_run = mn; l_run *= al;
#pragma unroll
                    for (int i = 0; i < 4; ++i)
#pragma unroll
                        for (int r = 0; r < 16; ++r) o[i][r] *= al; }
                float ps = 0.f;
#pragma unroll
                for (int r = 0; r < 16; ++r) { s0[r] = __builtin_amdgcn_exp2f(s0[r] - m_run); s1[r] = __builtin_amdgcn_exp2f(s1[r] - m_run); ps += s0[r] + s1[r]; }
                l_run += ps;
                bf16x8_t pf[4];
#pragma unroll
                for (int k2 = 0; k2 < 2; ++k2) {
                    v4u a; a.x = cvtpk(s0[8 * k2], s0[8 * k2 + 1]); a.y = cvtpk(s0[8 * k2 + 2], s0[8 * k2 + 3]); a.z = cvtpk(s0[8 * k2 + 4], s0[8 * k2 + 5]); a.w = cvtpk(s0[8 * k2 + 6], s0[8 * k2 + 7]);
                    v4u c; c.x = cvtpk(s1[8 * k2], s1[8 * k2 + 1]); c.y = cvtpk(s1[8 * k2 + 2], s1[8 * k2 + 3]); c.z = cvtpk(s1[8 * k2 + 4], s1[8 * k2 + 5]); c.w = cvtpk(s1[8 * k2 + 6], s1[8 * k2 + 7]);
                    pf[k2] = __builtin_bit_cast(bf16x8_t, a); pf[2 + k2] = __builtin_bit_cast(bf16x8_t, c); }
                bf16x8_t vfa[4], vfb[4];
#define DV_LD(dst, blk) do { _Pragma("unroll") for (int kk = 0; kk < 4; ++kk) { const LAS unsigned char* vp = Vb + kk * 16 * DV_STR + (blk) * 64; dst[kk] = vtr8(vp, vp + 8 * DV_STR); } } while (0)
#define DV_MM(src, blk) do { _Pragma("unroll") for (int kk = 0; kk < 4; ++kk) o[blk] = __builtin_amdgcn_mfma_f32_32x32x16_bf16(src[kk], pf[kk], o[blk], 0, 0, 0); } while (0)
                DV_LD(vfa, 0); DV_LD(vfb, 1); __builtin_amdgcn_sched_barrier(0);
                DV_MM(vfa, 0); __builtin_amdgcn_sched_barrier(0); DV_LD(vfa, 2); __builtin_amdgcn_sched_barrier(0);
                DV_MM(vfb, 1); __builtin_amdgcn_sched_barrier(0); DV_LD(vfb, 3); __builtin_amdgcn_sched_barrier(0);
                DV_MM(vfa, 2); __builtin_amdgcn_sched_barrier(0);
                DV_MM(vfb, 3);
#undef DV_LD
#undef DV_MM
            }
            if (t + 1 < NT) { const int s2 = ((t + 1) & 1) * DSTG;
                *(LAS v4u*)(L + s2 + kdst) = pk0; *(LAS v4u*)(L + s2 + kdst + 32 * DK_STR) = pk1; *(LAS v4u*)(L + s2 + vdst) = pv0; *(LAS v4u*)(L + s2 + vdst + 32 * DV_STR) = pv1; }
            __syncthreads();
        }
        const float linv = 1.f / (l_run + __shfl_xor(l_run, 32));
        if (mm == 1) {
#pragma unroll
            for (int blk = 0; blk < 4; ++blk)
#pragma unroll
                for (int r = 0; r < 16; ++r) xbuf[(wq * 64 + blk * 16 + r) * 64 + lane] = o[blk][r] * linv; }
        __syncthreads();
        if (mm == 0) {
            float ss = 0.f;
#pragma unroll
            for (int blk = 0; blk < 4; ++blk)
#pragma unroll
                for (int r = 0; r < 16; ++r) { const float d = o[blk][r] * linv - lam * xbuf[(wq * 64 + blk * 16 + r) * 64 + lane]; o[blk][r] = d; ss += d * d; }
            ss += __shfl_xor(ss, 32);
            const float rn = (1.f / sqrtf(ss * (1.f / 128.f) + EPS)) * (1.f - lam_init);
            bf16* orow = hc + ((size_t)b * SEQ + tq) * HCE + 1024 + h * 128 + 4 * hi;
#pragma unroll
            for (int blk = 0; blk < 4; ++blk)
#pragma unroll
                for (int a = 0; a < 4; ++a) { const f32x4 g = *(const GAS f32x4*)(subln + 32 * blk + 8 * a + 4 * hi); v2u ov;
                    ov.x = pk2(o[blk][4 * a] * rn * g.x, o[blk][4 * a + 1] * rn * g.y); ov.y = pk2(o[blk][4 * a + 2] * rn * g.z, o[blk][4 * a + 3] * rn * g.w);
                    *(GAS v2u*)(orow + 32 * blk + 8 * a) = ov; }
        }
    }
}

template <int NBLK, int KSTR, int VSTR, bool BIAS>
__device__ __forceinline__ void attn_step64(const LAS unsigned char* Kb, const LAS unsigned char* Vb, const bf16x8_t (&qf)[4], const LAS float* lp, f32x16 (&o)[NBLK], float& m_run, float& l_run) {
    constexpr float C2 = 0.125f * LOG2E;
    f32x16 s0, s1;
#pragma unroll
    for (int r = 0; r < 16; ++r) { s0[r] = 0.f; s1[r] = 0.f; }
#pragma unroll
    for (int ks = 0; ks < 4; ++ks) { const bf16x8_t a0 = *(const LAS bf16x8_t*)(Kb + ks * 32), a1 = *(const LAS bf16x8_t*)(Kb + 32 * KSTR + ks * 32);
        s0 = __builtin_amdgcn_mfma_f32_32x32x16_bf16(a0, qf[ks], s0, 0, 0, 0); s1 = __builtin_amdgcn_mfma_f32_32x32x16_bf16(a1, qf[ks], s1, 0, 0, 0); }
    if (BIAS) {
#pragma unroll
        for (int r = 0; r < 16; ++r) { const int ko = (r & 3) + 8 * (r >> 2); s0[r] = s0[r] * C2 + lp[ko]; s1[r] = s1[r] * C2 + lp[ko + 32]; }
    } else {
#pragma unroll
        for (int r = 0; r < 16; ++r) { s0[r] *= C2; s1[r] *= C2; } }
    float mx = fmaxf(s0[0], s1[0]);
#pragma unroll
    for (int r = 1; r < 16; ++r) mx = fmaxf(mx, fmaxf(s0[r], s1[r]));
    mx = fmaxf(mx, __shfl_xor(mx, 32));
    if (__any(mx > m_run)) { const float mn = fmaxf(m_run, mx), al = __builtin_amdgcn_exp2f(m_run - mn); m_run = mn; l_run *= al;
#pragma unroll
        for (int i = 0; i < NBLK; ++i)
#pragma unroll
            for (int r = 0; r < 16; ++r) o[i][r] *= al; }
    float ps = 0.f;
#pragma unroll
    for (int r = 0; r < 16; ++r) { s0[r] = __builtin_amdgcn_exp2f(s0[r] - m_run); s1[r] = __builtin_amdgcn_exp2f(s1[r] - m_run); ps += s0[r] + s1[r]; }
    l_run += ps;
    bf16x8_t pf[4];
#pragma unroll
    for (int k2 = 0; k2 < 2; ++k2) {
        v4u a; a.x = cvtpk(s0[8 * k2], s0[8 * k2 + 1]); a.y = cvtpk(s0[8 * k2 + 2], s0[8 * k2 + 3]); a.z = cvtpk(s0[8 * k2 + 4], s0[8 * k2 + 5]); a.w = cvtpk(s0[8 * k2 + 6], s0[8 * k2 + 7]);
        v4u c; c.x = cvtpk(s1[8 * k2], s1[8 * k2 + 1]); c.y = cvtpk(s1[8 * k2 + 2], s1[8 * k2 + 3]); c.z = cvtpk(s1[8 * k2 + 4], s1[8 * k2 + 5]); c.w = cvtpk(s1[8 * k2 + 6], s1[8 * k2 + 7]);
        pf[k2] = __builtin_bit_cast(bf16x8_t, a); pf[2 + k2] = __builtin_bit_cast(bf16x8_t, c); }
#pragma unroll
    for (int blk = 0; blk < NBLK; ++blk)
#pragma unroll
        for (int kk = 0; kk < 4; ++kk) { const LAS unsigned char* vp = Vb + kk * 16 * VSTR + blk * 64; const bf16x8_t vf = vtr8(vp, vp + 8 * VSTR);
            o[blk] = __builtin_amdgcn_mfma_f32_32x32x16_bf16(vf, pf[kk], o[blk], 0, 0, 0); }
}
constexpr int A_KSTR = 144, A_VSTR = 192;

__device__ __forceinline__ void xattn_mfma(Frame& F) {
    LAS unsigned char* L = F.lds; constexpr int KOFF = 0, VOFF = 256 * A_KSTR;
    const bf16* kvm = (const bf16*)(KWS() + WS_KVM); const bf16* qx = (const bf16*)(KWS() + WS_QX); bf16* ox = (bf16*)(KWS() + WS_OX);
    const int w = F.wave, lane = F.lane, r32 = lane & 31, hi = lane >> 5;
    for (int u = F.vcu; u < NB * 4 * 32; u += F.G) {
        const int b = u >> 7, h = (u >> 5) & 3, blk = u & 31;
        __syncthreads();
        for (int i = F.tid; i < 2048; i += 512) { const int key = i >> 3, c = i & 7;
            const GAS v4u* src = (const GAS v4u*)(kvm + (size_t)(b * NMEM + key) * 512 + h * 64) + c;
            *(LAS v4u*)(L + KOFF + key * A_KSTR + c * 16) = src[0]; *(LAS v4u*)(L + VOFF + key * A_VSTR + c * 16) = src[32]; }
        const size_t token = (size_t)b * SEQ + blk * 256 + w * 32 + r32;
        bf16x8_t qf[4];
#pragma unroll
        for (int ks = 0; ks < 4; ++ks) qf[ks] = *(const GAS bf16x8_t*)(qx + token * 256 + h * 64 + 16 * ks + 8 * hi);
        __syncthreads();
        f32x16 o[2];
#pragma unroll
        for (int i = 0; i < 2; ++i)
#pragma unroll
            for (int r = 0; r < 16; ++r) o[i][r] = 0.f;
        float m_run = -1e30f, l_run = 0.f;
        const LAS unsigned char* Kb = L + KOFF + r32 * A_KSTR + 16 * hi;
        const LAS unsigned char* Vb = L + VOFF + (4 * hi + ((lane & 15) >> 2)) * A_VSTR + (16 * ((lane >> 4) & 1) + 4 * (lane & 3)) * 2;
#pragma unroll 1
        for (int t = 0; t < 4; ++t) attn_step64<2, A_KSTR, A_VSTR, false>(Kb + t * 64 * A_KSTR, Vb + t * 64 * A_VSTR, qf, nullptr, o, m_run, l_run);
        const float inv = 1.f / (l_run + __shfl_xor(l_run, 32));
        bf16* orow = ox + token * 256 + h * 64 + 4 * hi;
#pragma unroll
        for (int bk = 0; bk < 2; ++bk)
#pragma unroll
            for (int a = 0; a < 4; ++a) { v2u ov; ov.x = pk2(o[bk][4 * a] * inv, o[bk][4 * a + 1] * inv); ov.y = pk2(o[bk][4 * a + 2] * inv, o[bk][4 * a + 3] * inv); *(GAS v2u*)(orow + 32 * bk + 8 * a) = ov; }
    }
}

__device__ __forceinline__ void swa_mfma(Frame& F, int oi) {
    LAS unsigned char* L = F.lds; constexpr int KOFF = 0, VOFF = 192 * A_KSTR, LOFF = VOFF + 192 * A_VSTR;
    LAS float* lut = (LAS float*)(L + LOFF);
    const bf16* z = (const bf16*)(KWS() + WS_Z); bf16* hc = (bf16*)(KWS() + WS_HC);
    const float* tab = KIN(I_TAB); const float* sinks = KIN(I_OSINK) + oi * 16;
    const int w = F.wave, lane = F.lane, r32 = lane & 31, hi = lane >> 5;
    for (int u = F.vcu; u < NB * 128 * 2; u += F.G) {
        const int b = u >> 8, c = (u >> 1) & 127, kvh = u & 1;
        __syncthreads();
        const int jmin = c >= 2 ? 0 : (2 - c) * 64;
        for (int i = F.tid; i < 192 * 8; i += 512) { const int j = i >> 3, cc = i & 7;
            if (j >= jmin) { const size_t kt = (size_t)b * SEQ + (c - 2) * 64 + j;
                *(LAS v4u*)(L + KOFF + j * A_KSTR + cc * 16) = *((const GAS v4u*)(z + kt * ZO + OKK + kvh * 64) + cc);
                *(LAS v4u*)(L + VOFF + j * A_VSTR + cc * 16) = *((const GAS v4u*)(z + kt * ZO + OVV + kvh * 64) + cc); } }
        for (int i = F.tid; i < 8 * 256; i += 512) { const int g = i >> 8, r = i & 255; lut[i] = r < 255 ? ((const GAS float*)tab)[t5_bucket(r - 191) * 28 + 12 + kvh * 8 + g] * LOG2E : 0.f; }
        __syncthreads();
        const int head = kvh * 8 + w;
        const float sk = ((const GAS float*)sinks)[head] * LOG2E;
#pragma unroll 1
        for (int qb2 = 0; qb2 < 2; ++qb2) {
            const int qi = qb2 * 32 + r32; const size_t token = (size_t)b * SEQ + c * 64 + qi;
            bf16x8_t qf[4];
#pragma unroll
            for (int ks = 0; ks < 4; ++ks) qf[ks] = *(const GAS bf16x8_t*)(z + token * ZO + OQ + head * 64 + 16 * ks + 8 * hi);
            f32x16 o[2];
#pragma unroll
            for (int i = 0; i < 2; ++i)
#pragma unroll
                for (int r = 0; r < 16; ++r) o[i][r] = 0.f;
            float m_run = sk, l_run = hi == 0 ? 1.f : 0.f;
            const LAS unsigned char* Kb = L + KOFF + r32 * A_KSTR + 16 * hi;
            const LAS unsigned char* Vb = L + VOFF + (4 * hi + ((lane & 15) >> 2)) * A_VSTR + (16 * ((lane >> 4) & 1) + 4 * (lane & 3)) * 2;
#pragma unroll 1
            for (int t = (c >= 2 ? 0 : 2 - c); t < 3; ++t)
                attn_step64<2, A_KSTR, A_VSTR, true>(Kb + t * 64 * A_KSTR, Vb + t * 64 * A_VSTR, qf, lut + w * 256 + 64 * t + 4 * hi + 63 - qi, o, m_run, l_run);
            const float inv = 1.f / (l_run + __shfl_xor(l_run, 32));
            bf16* orow = hc + token * HCO + head * 64 + 4 * hi;
#pragma unroll
            for (int bk = 0; bk < 2; ++bk)
#pragma unroll
                for (int a = 0; a < 4; ++a) { v2u ov; ov.x = pk2(o[bk][4 * a] * inv, o[bk][4 * a + 1] * inv); ov.y = pk2(o[bk][4 * a + 2] * inv, o[bk][4 * a + 3] * inv); *(GAS v2u*)(orow + 32 * bk + 8 * a) = ov; }
        }
    }
}

constexpr int TOPK = 256, CANDMAX = 512;
constexpr int DL_SEL = 0;
constexpr int DL_CNT = 16384;
constexpr int DL_AFL = DL_SEL;
constexpr int DL_WI2 = 16384 + 256;
constexpr int DL_W = 17408;
constexpr int DL_QI = DL_W;
constexpr int DL_WI = DL_W + 32768;
constexpr int DL_HIST = DL_W;
constexpr int DL_CAND = DL_W + 65536;
constexpr int DL_FB = 0;
constexpr int DL_QL = DL_W;
constexpr int DL_P = DL_W + 32768;
static_assert(DL_CAND + 8 * 704 * 8 <= RING_BYTES && DL_P + 65536 <= RING_BYTES, "DSA LDS map");

__device__ __forceinline__ unsigned fkey(float f) { const unsigned u = __builtin_bit_cast(unsigned, f); return (u & 0x80000000u) ? ~u : (u | 0x80000000u); }

__device__ __forceinline__ void indexer_naive(Frame& F, int b, int t0, int N, float* scr) {
    LAS float* qi = (LAS float*)(F.lds + DL_QI); LAS float* wi = (LAS float*)(F.lds + DL_WI);
    const bf16* z = (const bf16*)(KWS() + WS_Z);
    for (int i = F.tid; i < 16 * 64; i += 512) { const int q = i >> 6, c = i & 63;
        const v4u w = *((const GAS v4u*)(z + ((size_t)b * SEQ + t0 + q) * ZE + ZQI) + c); float v[8]; UNPK8(v, 0, w);
#pragma unroll
        for (int k = 0; k < 8; ++k) qi[q * 512 + c * 8 + k] = v[k]; }
    if (F.tid < 128) { const int q = F.tid >> 3, hh = F.tid & 7; wi[F.tid] = bf2f(((const GAS bf16*)z)[((size_t)b * SEQ + t0 + q) * ZE + ZWI + hh]); }
    __syncthreads();
    for (int s = F.tid; s < N; s += 512) {
        float k[64];
        { const GAS v4u* kp = (const GAS v4u*)(z + ((size_t)b * SEQ + s) * ZE + ZKI);
#pragma unroll
          for (int c = 0; c < 8; ++c) { const v4u w = kp[c]; UNPK8(k, 8 * c, w); } }
        for (int q = 0; q < 16; ++q) {
            float acc = 0.f;
#pragma unroll
            for (int hh = 0; hh < 8; ++hh) {
                const LAS f32x4* qp = (const LAS f32x4*)(qi + q * 512 + hh * 64); float dsum = 0.f;
#pragma unroll
                for (int c = 0; c < 16; ++c) { const f32x4 qq = qp[c]; dsum += (qq.x * k[4 * c] + qq.y * k[4 * c + 1]) + (qq.z * k[4 * c + 2] + qq.w * k[4 * c + 3]); }
                acc = fmaf(wi[q * 8 + hh], fmaxf(dsum, 0.f), acc);
            }
            ((GAS float*)scr)[(size_t)q * SEQ + s] = acc;
        }
    }
}

__device__ __forceinline__ void indexer_mfma(Frame& F, int b, int t0, int N, float* scr, LAS unsigned* hist16) {
    const int w = F.wave, lane = F.lane, n = lane & 31, hi = lane >> 5, g = w & 3, kp = w >> 2;
    const bf16* z = (const bf16*)(KWS() + WS_Z);
    bf16x8_t af[4];
    { const bf16* qrow = z + ((size_t)b * SEQ + t0 + 4 * g + (n >> 3)) * ZE + ZQI + (n & 7) * 64 + 8 * hi;
#pragma unroll
      for (int ks = 0; ks < 4; ++ks) af[ks] = *(const GAS bf16x8_t*)(qrow + 16 * ks); }
    float wv[16];
#pragma unroll
    for (int r = 0; r < 16; ++r) wv[r] = bf2f(((const GAS bf16*)z)[((size_t)b * SEQ + t0 + 4 * g + (r >> 2)) * ZE + ZWI + 4 * hi + (r & 3)]);
    const bf16* kbase = z + ((size_t)b * SEQ + n) * ZE + ZKI + 8 * hi;
    const int nsub = N >> 5;
    bf16x8_t bfr[4], bnx[4];
    int j = kp;
    if (j < nsub) {
#pragma unroll
        for (int ks = 0; ks < 4; ++ks) bfr[ks] = *(const GAS bf16x8_t*)(kbase + (size_t)(32 * j) * ZE + 16 * ks); }
    float* sbase = scr + (size_t)(4 * g + 2 * hi) * SEQ + n;
    LAS unsigned* hq = hist16 + (4 * g + 2 * hi) * 1024;
#pragma unroll 1
    for (; j < nsub; j += 2) {
        const int jn = j + 2;
        if (jn < nsub) {
#pragma unroll
            for (int ks = 0; ks < 4; ++ks) bnx[ks] = *(const GAS bf16x8_t*)(kbase + (size_t)(32 * jn) * ZE + 16 * ks); }
        f32x16 c;
#pragma unroll
        for (int r = 0; r < 16; ++r) c[r] = 0.f;
#pragma unroll
        for (int ks = 0; ks < 4; ++ks) c = __builtin_amdgcn_mfma_f32_32x32x16_bf16(af[ks], bfr[ks], c, 0, 0, 0);
        float tot[4];
#pragma unroll
        for (int qi = 0; qi < 4; ++qi) { float p = 0.f;
#pragma unroll
            for (int i = 0; i < 4; ++i) p = fmaf(wv[4 * qi + i], fmaxf(c[4 * qi + i], 0.f), p);
            tot[qi] = p + __shfl_xor(p, 32); }
        const float sa = hi ? tot[2] : tot[0], sb = hi ? tot[3] : tot[1];
        ((GAS float*)sbase)[32 * j] = sa; ((GAS float*)sbase)[32 * j + SEQ] = sb;
        { const unsigned ba = fkey(sa) >> 21, bb = fkey(sb) >> 21;
          __hip_atomic_fetch_add(hq + (ba >> 1), 1u << (16 * (ba & 1)), __ATOMIC_RELAXED, __HIP_MEMORY_SCOPE_WORKGROUP);
          __hip_atomic_fetch_add(hq + 1024 + (bb >> 1), 1u << (16 * (bb & 1)), __ATOMIC_RELAXED, __HIP_MEMORY_SCOPE_WORKGROUP); }
#pragma unroll
        for (int ks = 0; ks < 4; ++ks) bfr[ks] = bnx[ks];
    }
}

__device__ __forceinline__ float relu_i(float x) { const int b = __builtin_bit_cast(int, x); return __builtin_bit_cast(float, b > 0 ? b : 0); }
#define RELU(x) relu_i(x)
__device__ __forceinline__ void idx_body(const LAS bf16x8_t* afl, const bf16x8_t (&bq)[4], const LAS f32x4* wl, float* scr, unsigned so, LAS unsigned* hq, int j, int hi) {
#pragma unroll
    for (int gp = 0; gp < 2; ++gp) {
        f32x16 c[2];
#pragma unroll
        for (int u = 0; u < 2; ++u)
#pragma unroll
            for (int rr = 0; rr < 16; ++rr) c[u][rr] = 0.f;
#pragma unroll
        for (int ks = 0; ks < 4; ++ks)
#pragma unroll
            for (int u = 0; u < 2; ++u) c[u] = __builtin_amdgcn_mfma_f32_32x32x16_bf16(afl[((2 * gp + u) * 4 + ks) * 64], bq[ks], c[u], 0, 0, 0);
#pragma unroll
        for (int u = 0; u < 2; ++u) { const int g = 2 * gp + u;
            float p[4];
#pragma unroll
            for (int qi = 0; qi < 4; ++qi) { const f32x4 wq4 = wl[(4 * g + qi) * 2]; float a = 0.f;
                a = fmaf(wq4.x, RELU(c[u][4 * qi]), a); a = fmaf(wq4.y, RELU(c[u][4 * qi + 1]), a);
                a = fmaf(wq4.z, RELU(c[u][4 * qi + 2]), a); a = fmaf(wq4.w, RELU(c[u][4 * qi + 3]), a); p[qi] = a; }
            const float give0 = hi ? p[0] : p[2], give1 = hi ? p[1] : p[3], keep0 = hi ? p[2] : p[0], keep1 = hi ? p[3] : p[1];
            const float sa = keep0 + __shfl_xor(give0, 32), sb = keep1 + __shfl_xor(give1, 32);
            ((GAS float*)scr)[so + (unsigned)((4 * g) * SEQ + 32 * j)] = sa; ((GAS float*)scr)[so + (unsigned)((4 * g + 1) * SEQ + 32 * j)] = sb;
            const unsigned ba = fkey(sa) >> 21, bb = fkey(sb) >> 21;
            __hip_atomic_fetch_add(hq + (4 * g) * 1024 + (ba >> 1), 1u << (16 * (ba & 1)), __ATOMIC_RELAXED, __HIP_MEMORY_SCOPE_WORKGROUP);
            __hip_atomic_fetch_add(hq + (4 * g + 1) * 1024 + (bb >> 1), 1u << (16 * (bb & 1)), __ATOMIC_RELAXED, __HIP_MEMORY_SCOPE_WORKGROUP);
        }
        __builtin_amdgcn_sched_barrier(0);
    }
}
__device__ __forceinline__ void indexer_mfma2(Frame& F, int b, int t0, int N, float* scr, LAS unsigned* hist16) {
    const int w = F.wave, lane = F.lane, n = lane & 31, hi = lane >> 5;
    const bf16* z = (const bf16*)(KWS() + WS_Z);
    const LAS f32x4* wl = (const LAS f32x4*)(F.lds + DL_WI2) + hi; const LAS bf16x8_t* afl = (const LAS bf16x8_t*)(F.lds + DL_AFL) + lane;
    const bf16* kbase = z + ((size_t)b * SEQ + n) * ZE + ZKI + 8 * hi;
    const int nsub = N >> 5, last = nsub - 1;
    const unsigned so = (unsigned)((2 * hi) * SEQ + n);
    LAS unsigned* hq = hist16 + (2 * hi) * 1024;
    bf16x8_t fa[4], fb[4];
#define IDX_LD(dst, jj) do { const int jc_ = (jj) < last ? (jj) : last; _Pragma("unroll") for (int ks = 0; ks < 4; ++ks) dst[ks] = *(const GAS bf16x8_t*)(kbase + (size_t)(32 * jc_) * ZE + 16 * ks); } while (0)
    int j = w;
    if (j < nsub) {
        IDX_LD(fa, j);
#pragma unroll 1
        for (; j + 8 < nsub; j += 16) {
            IDX_LD(fb, j + 8);
            idx_body(afl, fa, wl, scr, so, hq, j, hi);
            IDX_LD(fa, j + 16);
            idx_body(afl, fb, wl, scr, so, hq, j + 8, hi);
        }
        if (j < nsub) idx_body(afl, fa, wl, scr, so, hq, j, hi);
    }
#undef IDX_LD
}

__device__ __forceinline__ int find_bin(LAS unsigned* hist, int lane, unsigned target, unsigned& above) {
    unsigned ls = 0;
#pragma unroll 8
    for (int j = 0; j < 32; ++j) ls += hist[32 * lane + j];
    unsigned suf = ls;
#pragma unroll
    for (int o = 1; o < 64; o <<= 1) { const unsigned t = __shfl_down(suf, o); if (lane + o < 64) suf += t; }
    const unsigned long long mk = __ballot(suf >= target);
    const int L = 63 - __builtin_clzll(mk);
    unsigned cum = __shfl(suf, L) - __shfl(ls, L);
    int bsel = 32 * L;
    for (int j = 31; j >= 0; --j) { const unsigned c = hist[32 * L + j]; if (cum + c >= target) { bsel = 32 * L + j; break; } cum += c; }
    above = cum; return bsel;
}

__device__ __forceinline__ int select_topk(const float* row, int N, LAS int* sel, LAS unsigned* hist, LAS unsigned long long* cand, int lane) {
    if (N <= TOPK) { for (int i = lane; i < N; i += 64) sel[i] = i; LDS_WAIT(); return N; }
    const GAS float* r = (const GAS float*)row;
    const unsigned long long lt = (1ull << lane) - 1ull;
    for (int i = lane; i < 2048; i += 64) hist[i] = 0u;
    LDS_WAIT();
    for (int i = lane; i < N; i += 64) { const unsigned u = fkey(r[i]); __hip_atomic_fetch_add(hist + (u >> 21), 1u, __ATOMIC_RELAXED, __HIP_MEMORY_SCOPE_WORKGROUP); }
    LDS_WAIT();
    unsigned above; const unsigned b0 = (unsigned)find_bin(hist, lane, TOPK, above);
    unsigned need = TOPK - above;
    unsigned nsel = 0, nc = 0;
    for (int i0 = 0; i0 < N; i0 += 64) { const int i = i0 + lane; const unsigned u = fkey(r[i]); const unsigned bin = u >> 21;
        const bool ab = bin > b0, eq = bin == b0; const unsigned long long ma = __ballot(ab), me = __ballot(eq);
        { const unsigned pa = nsel + __builtin_popcountll(ma & lt); if (ab && pa < TOPK) sel[pa] = i; }
        const unsigned pe = nc + __builtin_popcountll(me & lt);
        if (eq && pe < CANDMAX) cand[pe] = ((unsigned long long)u << 32) | (unsigned)i;
        nsel += __builtin_popcountll(ma); nc += __builtin_popcountll(me); }
    LDS_WAIT();
    if (nc <= CANDMAX) {
        for (unsigned ci = lane; ci < nc; ci += 64) { const unsigned long long me = cand[ci]; const unsigned ui = (unsigned)(me >> 32), ii = (unsigned)me; unsigned rank = 0;
            for (unsigned j = 0; j < nc; ++j) { const unsigned long long o = cand[j]; const unsigned uj = (unsigned)(o >> 32), ij = (unsigned)o; rank += (uj > ui || (uj == ui && ij < ii)) ? 1u : 0u; }
            if (rank < need && above + rank < TOPK) sel[above + rank] = (int)ii; }
    } else {
        for (int i = lane; i < 2048; i += 64) hist[i] = 0u;
        LDS_WAIT();
        for (int i = lane; i < N; i += 64) { const unsigned u = fkey(r[i]); if ((u >> 21) == b0) __hip_atomic_fetch_add(hist + ((u >> 10) & 0x7ffu), 1u, __ATOMIC_RELAXED, __HIP_MEMORY_SCOPE_WORKGROUP); }
        LDS_WAIT();
        unsigned ab1; const unsigned b1 = (unsigned)find_bin(hist, lane, need, ab1); const unsigned need1 = need - ab1;
        const unsigned pre = (b0 << 11) | b1;
        for (int i = lane; i < 2048; i += 64) hist[i] = 0u;
        LDS_WAIT();
        for (int i = lane; i < N; i += 64) { const unsigned u = fkey(r[i]); if ((u >> 10) == pre) __hip_atomic_fetch_add(hist + (u & 0x3ffu), 1u, __ATOMIC_RELAXED, __HIP_MEMORY_SCOPE_WORKGROUP); }
        LDS_WAIT();
        unsigned ab2; const unsigned b2 = (unsigned)find_bin(hist, lane, need1, ab2); const unsigned need2 = need1 - ab2;
        const unsigned ustar = (pre << 10) | b2;
        unsigned pos = above, neq = 0;
        for (int i0 = 0; i0 < N; i0 += 64) { const int i = i0 + lane; const unsigned u = fkey(r[i]); const bool inb = (u >> 21) == b0;
            const bool gt = inb && u > ustar, eq = inb && u == ustar; const unsigned long long mg = __ballot(gt), me = __ballot(eq);
            const unsigned re = neq + __builtin_popcountll(me & lt);
            const bool take_eq = eq && re < need2; const unsigned long long mt = __ballot(take_eq);
            const unsigned long long mall = mg | mt;
            { const unsigned pp = pos + __builtin_popcountll(mall & lt); if ((gt || take_eq) && pp < TOPK) sel[pp] = i; }
            pos += __builtin_popcountll(mall); neq += __builtin_popcountll(me); }
    }
    LDS_WAIT();
    return TOPK;
}

__device__ __forceinline__ int find_bin16(const LAS unsigned* h16, int lane, unsigned target, unsigned& above) {
    unsigned ls = 0;
#pragma unroll
    for (int j = 0; j < 16; ++j) { const unsigned wv = h16[16 * lane + j]; ls += (wv & 0xffffu) + (wv >> 16); }
    unsigned suf = ls;
#pragma unroll
    for (int o = 1; o < 64; o <<= 1) { const unsigned t = __shfl_down(suf, o); if (lane + o < 64) suf += t; }
    const unsigned long long mk = __ballot(suf >= target);
    const int L = mk ? 63 - __builtin_clzll(mk) : 0;
    unsigned cum = __shfl(suf, L) - __shfl(ls, L);
    int bsel = 32 * L;
    for (int j = 31; j >= 0; --j) { const unsigned wv = h16[16 * L + (j >> 1)]; const unsigned c = (j & 1) ? (wv >> 16) : (wv & 0xffffu); if (cum + c >= target) { bsel = 32 * L + j; break; } cum += c; }
    above = cum; return bsel;
}
__device__ __forceinline__ unsigned lane_prefix(unsigned long long m) { return __builtin_amdgcn_mbcnt_hi((unsigned)(m >> 32), __builtin_amdgcn_mbcnt_lo((unsigned)m, 0u)); }
constexpr int LISTMAX = 704;
__device__ __forceinline__ int select_topk2(const float* row, int N, LAS int* sel, LAS unsigned* h16, LAS unsigned long long* cand, int lane) {
    if (N <= TOPK) { for (int i = lane; i < N; i += 64) sel[i] = i; LDS_WAIT(); return N; }
    const GAS float* r = (const GAS float*)row;
    const unsigned long long lt = (1ull << lane) - 1ull;
    unsigned above; const unsigned b0 = (unsigned)find_bin16(h16, lane, TOPK, above);
    const unsigned need = TOPK - above;
    unsigned nl = 0;
    const unsigned kb = b0 << 21; const float thr = __builtin_bit_cast(float, (kb & 0x80000000u) ? (kb & 0x7fffffffu) : ~kb);
    float v[16], vn[16];
#pragma unroll
    for (int k = 0; k < 16; ++k) { const int i = 64 * k + lane; v[k] = i < N ? r[i] : -INFINITY; }
#pragma unroll 1
    for (int i0 = 0; i0 < N; i0 += 1024) {
        if (i0 + 1024 < N) {
#pragma unroll
            for (int k = 0; k < 16; ++k) { const int i = i0 + 1024 + 64 * k + lane; vn[k] = i < N ? r[i] : -INFINITY; } }
#pragma unroll
        for (int k = 0; k < 16; ++k) { const bool ge = v[k] >= thr; const unsigned long long mg = __ballot(ge);
            const unsigned pp = nl + lane_prefix(mg);
            if (ge && pp < LISTMAX) cand[pp] = ((unsigned long long)fkey(v[k]) << 32) | (unsigned)(i0 + 64 * k + lane);
            nl += __builtin_popcountll(mg); }
#pragma unroll
        for (int k = 0; k < 16; ++k) v[k] = vn[k];
    }
    LDS_WAIT();
    if (nl <= LISTMAX) {
        unsigned cu[11], cidx[11];
#pragma unroll
        for (int k = 0; k < 11; ++k) { const unsigned ci = lane + 64 * k; const unsigned long long me = ci < nl ? cand[ci] : 0ull; cu[k] = (unsigned)(me >> 32); cidx[k] = (unsigned)me; }
        unsigned ustar = b0 << 21;
#pragma unroll 1
        for (int bit = 20; bit >= 0; --bit) { const unsigned trial = ustar | (1u << bit); unsigned c = 0;
#pragma unroll
            for (int k = 0; k < 11; ++k) c += __builtin_popcountll(__ballot(cu[k] >= trial));
            if (c >= TOPK) ustar = trial; }
        unsigned cgt = 0;
#pragma unroll
        for (int k = 0; k < 11; ++k) cgt += __builtin_popcountll(__ballot(cu[k] > ustar));
        const unsigned need_eq = TOPK - cgt;
        unsigned pos = 0, neq = 0;
#pragma unroll
        for (int k = 0; k < 11; ++k) { const bool gt = cu[k] > ustar, eq = cu[k] == ustar;
            const unsigned long long me = __ballot(eq); const unsigned re = neq + lane_prefix(me); const bool take = gt || (eq && re < need_eq);
            const unsigned long long mt = __ballot(take); const unsigned pp = pos + lane_prefix(mt);
            if (take && pp < TOPK) sel[pp] = (int)cidx[k];
            pos += __builtin_popcountll(mt); neq += __builtin_popcountll(me); }
    } else {
        { unsigned ns = 0;
          for (int i0 = 0; i0 < N; i0 += 64) { const int i = i0 + lane; const bool ab = (fkey(r[i]) >> 21) > b0; const unsigned long long ma = __ballot(ab);
              const unsigned pa = ns + lane_prefix(ma); if (ab && pa < TOPK) sel[pa] = i; ns += __builtin_popcountll(ma); } }
        for (int i = lane; i < 1024; i += 64) h16[i] = 0u;
        LDS_WAIT();
        for (int i = lane; i < N; i += 64) { const unsigned u = fkey(r[i]); if ((u >> 21) == b0) { const unsigned bb = (u >> 10) & 0x7ffu; __hip_atomic_fetch_add(h16 + (bb >> 1), 1u << (16 * (bb & 1)), __ATOMIC_RELAXED, __HIP_MEMORY_SCOPE_WORKGROUP); } }
        LDS_WAIT();
        unsigned ab1; const unsigned b1 = (unsigned)find_bin16(h16, lane, need, ab1); const unsigned need1 = need - ab1;
        const unsigned pre = (b0 << 11) | b1;
        for (int i = lane; i < 1024; i += 64) h16[i] = 0u;
        LDS_WAIT();
        for (int i = lane; i < N; i += 64) { const unsigned u = fkey(r[i]); if ((u >> 10) == pre) { const unsigned bb = u & 0x3ffu; __hip_atomic_fetch_add(h16 + (bb >> 1), 1u << (16 * (bb & 1)), __ATOMIC_RELAXED, __HIP_MEMORY_SCOPE_WORKGROUP); } }
        LDS_WAIT();
        unsigned ab2; const unsigned b2 = (unsigned)find_bin16(h16, lane, need1, ab2); const unsigned need2 = need1 - ab2;
        const unsigned ustar = (pre << 10) | b2;
        unsigned pos = above, neq = 0;
        for (int i0 = 0; i0 < N; i0 += 64) { const int i = i0 + lane; const unsigned u = fkey(r[i]); const bool inb = (u >> 21) == b0;
            const bool gt = inb && u > ustar, eq = inb && u == ustar; const unsigned long long mg = __ballot(gt), me = __ballot(eq);
            const unsigned re = neq + __builtin_popcountll(me & lt);
            const bool take_eq = eq && re < need2; const unsigned long long mt = __ballot(take_eq);
            const unsigned long long mall = mg | mt;
            { const unsigned pp = pos + __builtin_popcountll(mall & lt); if ((gt || take_eq) && pp < TOPK) sel[pp] = i; }
            pos += __builtin_popcountll(mall); neq += __builtin_popcountll(me); }
    }
    LDS_WAIT();
    return TOPK;
}

__device__ __forceinline__ void sparse_naive(Frame& F, int b, int t, const LAS int* sel, int cnt, LAS float* qlw, LAS float* Pw, int lane) {
    const bf16* z = (const bf16*)(KWS() + WS_Z); const bf16* ck = (const bf16*)(KWS() + WS_CKVN) + (size_t)b * SEQ * 128; bf16* hc = (bf16*)(KWS() + WS_HC);
    const float* tab = KIN(I_TAB);
    const size_t token = (size_t)b * SEQ + t;
    { const GAS v4u* qp = (const GAS v4u*)(z + token * ZE + ZQL) + 2 * lane; const v4u w0 = qp[0], w1 = qp[1]; float v[16]; UNPK8(v, 0, w0); UNPK8(v, 8, w1);
#pragma unroll
      for (int k = 0; k < 16; ++k) qlw[16 * lane + k] = v[k]; }
    LDS_WAIT();
    float s[4][8];
#pragma unroll
    for (int kk = 0; kk < 4; ++kk) {
        const int j = lane + 64 * kk; const bool valid = j < cnt; const int key = valid ? sel[j] : 0;
        float acc[8];
#pragma unroll
        for (int hh = 0; hh < 8; ++hh) acc[hh] = 0.f;
        const GAS v4u* cp = (const GAS v4u*)(ck + (size_t)key * 128);
        for (int ch = 0; ch < 16; ++ch) { const v4u w = cp[ch]; float c8[8]; UNPK8(c8, 0, w);
#pragma unroll
            for (int hh = 0; hh < 8; ++hh) { const LAS f32x4* qq = (const LAS f32x4*)(qlw + hh * 128 + ch * 8); const f32x4 a = qq[0], bq = qq[1];
                acc[hh] += (a.x * c8[0] + a.y * c8[1]) + (a.z * c8[2] + a.w * c8[3]) + (bq.x * c8[4] + bq.y * c8[5]) + (bq.z * c8[6] + bq.w * c8[7]); } }
        const int bk = t5_bucket(key - t);
#pragma unroll
        for (int hh = 0; hh < 8; ++hh) s[kk][hh] = valid ? acc[hh] * 0.125f + ((const GAS float*)tab)[bk * 28 + hh] : -1e30f;
    }
#pragma unroll
    for (int hh = 0; hh < 8; ++hh) {
        const float mx = wave_max(fmaxf(fmaxf(s[0][hh], s[1][hh]), fmaxf(s[2][hh], s[3][hh])));
        float p[4], sum = 0.f;
#pragma unroll
        for (int kk = 0; kk < 4; ++kk) { p[kk] = __expf(s[kk][hh] - mx); sum += p[kk]; }
        const float inv = 1.f / wave_sum(sum);
#pragma unroll
        for (int kk = 0; kk < 4; ++kk) Pw[(lane + 64 * kk) * 8 + hh] = p[kk] * inv;
    }
    LDS_WAIT();
    float o0[8], o1[8];
#pragma unroll
    for (int hh = 0; hh < 8; ++hh) { o0[hh] = 0.f; o1[hh] = 0.f; }
    for (int j = 0; j < cnt; ++j) {
        const int key = sel[j]; const unsigned w = *((const GAS unsigned*)(ck + (size_t)key * 128) + lane); const float c0 = bflo(w), c1 = bfhi(w);
        const LAS f32x4* pp = (const LAS f32x4*)(Pw + j * 8); const f32x4 pa = pp[0], pb = pp[1];
        o0[0] += pa.x * c0; o1[0] += pa.x * c1; o0[1] += pa.y * c0; o1[1] += pa.y * c1; o0[2] += pa.z * c0; o1[2] += pa.z * c1; o0[3] += pa.w * c0; o1[3] += pa.w * c1;
        o0[4] += pb.x * c0; o1[4] += pb.x * c1; o0[5] += pb.y * c0; o1[5] += pb.y * c1; o0[6] += pb.z * c0; o1[6] += pb.z * c1; o0[7] += pb.w * c0; o1[7] += pb.w * c1;
    }
#pragma unroll
    for (int hh = 0; hh < 8; ++hh) *((GAS unsigned*)(hc + token * HCE + hh * 128) + lane) = pk2(o0[hh], o1[hh]);
    LDS_WAIT();
}

constexpr int DL_IMG = DL_W, IMG_STR = 288, IMG_BYTES = 32 * IMG_STR, DL_TABA = DL_W + 8 * IMG_BYTES;
static_assert(DL_TABA + 1024 <= RING_BYTES, "sparse LDS map");
__device__ __forceinline__ void sparse_mfma(Frame& F, int b, int t, LAS int* sel, int cnt, LAS unsigned char* img, const LAS float* tabA, int lane) {
    const bf16* z = (const bf16*)(KWS() + WS_Z); const bf16* ck = (const bf16*)(KWS() + WS_CKVN) + (size_t)b * SEQ * 128; bf16* hc = (bf16*)(KWS() + WS_HC);
    const int hd = lane & 15, g = lane >> 4; const size_t token = (size_t)b * SEQ + t;
    constexpr float C2A = 0.125f * LOG2E;
    bf16x8_t qf[4];
#pragma unroll
    for (int ks = 0; ks < 4; ++ks) { qf[ks] = *(const GAS bf16x8_t*)(z + token * ZE + ZQL + (hd & 7) * 128 + 32 * ks + 8 * g); if (hd >= 8) qf[ks] = (bf16x8_t){0, 0, 0, 0, 0, 0, 0, 0}; }
    f32x4 o[8];
#pragma unroll
    for (int mt = 0; mt < 8; ++mt) o[mt] = (f32x4){0.f, 0.f, 0.f, 0.f};
    float m_run = -1e30f, l_run = 0.f;
    v4u gb[8], gc[8];
    const int nblk = cnt >> 5;
    for (int jj = lane; jj < cnt; jj += 64) { const int key = sel[jj]; sel[jj] = key | (t5_bucket(key - t) << 16); }
    LDS_WAIT();
    const GAS unsigned char* ckb = (const GAS unsigned char*)ck;
#pragma unroll
    for (int k = 0; k < 8; ++k) { const unsigned key = sel[4 * k + g] & 0xffff; gb[k] = *(const GAS v4u*)(ckb + ((key << 8) + (hd << 4))); }
#pragma unroll
    for (int k = 0; k < 8; ++k) { const unsigned key = sel[32 + 4 * k + g] & 0xffff; gc[k] = *(const GAS v4u*)(ckb + ((key << 8) + (hd << 4))); }
#pragma unroll 1
    for (int blk = 0; blk < nblk; ++blk) {
#pragma unroll
        for (int k = 0; k < 8; ++k) *(LAS v4u*)(img + (4 * k + g) * IMG_STR + hd * 16) = gb[k];
#pragma unroll
        for (int k = 0; k < 8; ++k) gb[k] = gc[k];
        if (blk + 2 < nblk) {
#pragma unroll
            for (int k = 0; k < 8; ++k) { const unsigned key = sel[(blk + 2) * 32 + 4 * k + g] & 0xffff; gc[k] = *(const GAS v4u*)(ckb + ((key << 8) + (hd << 4))); } }
        f32x4 s[2];
#pragma unroll
        for (int tau = 0; tau < 2; ++tau) { s[tau] = (f32x4){0.f, 0.f, 0.f, 0.f};
#pragma unroll
            for (int ks = 0; ks < 4; ++ks) { const bf16x8_t a = *(const LAS bf16x8_t*)(img + (16 * tau + hd) * IMG_STR + (32 * ks + 8 * g) * 2);
                s[tau] = __builtin_amdgcn_mfma_f32_16x16x32_bf16(a, qf[ks], s[tau], 0, 0, 0); } }
        float x[8]; float mx = -1e30f;
#pragma unroll
        for (int tau = 0; tau < 2; ++tau)
#pragma unroll
            for (int i = 0; i < 4; ++i) { const int bk = sel[blk * 32 + 16 * tau + 4 * g + i] >> 16;
                x[4 * tau + i] = s[tau][i] * C2A + tabA[bk * 8 + (hd & 7)]; mx = fmaxf(mx, x[4 * tau + i]); }
        mx = fmaxf(mx, __shfl_xor(mx, 16)); mx = fmaxf(mx, __shfl_xor(mx, 32));
        if (__any(mx > m_run)) { const float mn = fmaxf(m_run, mx), al = __builtin_amdgcn_exp2f(m_run - mn); m_run = mn; l_run *= al;
#pragma unroll
            for (int mt = 0; mt < 8; ++mt) o[mt] *= al; }
        float ps = 0.f;
#pragma unroll
        for (int i = 0; i < 8; ++i) { x[i] = __builtin_amdgcn_exp2f(x[i] - m_run); ps += x[i]; }
        l_run += ps;
        v4u pw; pw.x = cvtpk(x[0], x[1]); pw.y = cvtpk(x[2], x[3]); pw.z = cvtpk(x[4], x[5]); pw.w = cvtpk(x[6], x[7]);
        const bf16x8_t pf = __builtin_bit_cast(bf16x8_t, pw);
        const LAS unsigned char* vb = img + (4 * g + (hd >> 2)) * IMG_STR + (4 * (hd & 3)) * 2;
#pragma unroll
        for (int mt = 0; mt < 8; ++mt) { const bf16x8_t vf = vtr8(vb + mt * 32, vb + mt * 32 + 16 * IMG_STR); o[mt] = __builtin_amdgcn_mfma_f32_16x16x32_bf16(vf, pf, o[mt], 0, 0, 0); }
    }
    float l = l_run; l += __shfl_xor(l, 16); l += __shfl_xor(l, 32);
    const float inv = 1.f / l;
    if (hd < 8) {
        bf16* orow = hc + token * HCE + hd * 128 + 4 * g;
#pragma unroll
        for (int mt = 0; mt < 8; ++mt) { v2u ov; ov.x = pk2(o[mt][0] * inv, o[mt][1] * inv); ov.y = pk2(o[mt][2] * inv, o[mt][3] * inv); *(GAS v2u*)(orow + 16 * mt) = ov; }
    }
    LDS_WAIT();
}

__device__ __forceinline__ void dsa_phase(Frame& F) {
    float* scr = (float*)(KWS() + WS_SCR) + (size_t)blockIdx.x * 16 * SEQ;
    LAS int* selA = (LAS int*)(F.lds + DL_SEL); LAS int* cntA = (LAS int*)(F.lds + DL_CNT);
    const int NU = NB * 128 * 4;
    for (int ui = F.vcu; ui < NU; ui += F.G) {
        const int rr = ui / F.G, v = ui % F.G;
        const int b = (v * NB) / F.G, j = v % (F.G / NB);
        const int half = rr >> 2, sub = rr & 3;
        const int c = (F.G / NB == 64) ? (half == 0 ? j : 127 - j) : 0;
        const int t0 = c * 64 + sub * 16, N = 64 * (c + 1);
        __syncthreads();
        int tl = F.tid; asm volatile("" : "+v"(tl));
        for (int i = tl; i < 16 * 1024; i += 512) ((LAS unsigned*)(F.lds + DL_HIST))[i] = 0u;
        for (int e2 = tl; e2 < 1024; e2 += 512) { const int g = e2 >> 8, ks = (e2 >> 6) & 3, ln = e2 & 63, n2 = ln & 31, h2 = ln >> 5;
            ((LAS bf16x8_t*)(F.lds + DL_AFL))[e2] = *(const GAS bf16x8_t*)((const bf16*)(KWS() + WS_Z) + ((size_t)b * SEQ + t0 + 4 * g + (n2 >> 3)) * ZE + ZQI + (n2 & 7) * 64 + 8 * h2 + 16 * ks); }
        if (tl < 128) ((LAS float*)(F.lds + DL_WI2))[tl] = bf2f(((const GAS bf16*)(KWS() + WS_Z))[((size_t)b * SEQ + t0 + (tl >> 3)) * ZE + ZWI + (tl & 7)]);
        __syncthreads();
        indexer_mfma2(F, b, t0, N, scr, (LAS unsigned*)(F.lds + DL_HIST));
        VM_WAIT(); __syncthreads();
#pragma unroll 1
        for (int r2 = 0; r2 < 2; ++r2) { const int q = F.wave + 8 * r2;
            const int cnt = select_topk2(scr + (size_t)q * SEQ, N, selA + q * 256, (LAS unsigned*)(F.lds + DL_HIST) + q * 1024, (LAS unsigned long long*)(F.lds + DL_CAND) + F.wave * LISTMAX, F.lane);
            if (F.lane == 0) cntA[q] = cnt; }
        __syncthreads();
        if (tl < 256) ((LAS float*)(F.lds + DL_TABA))[tl] = ((const GAS float*)KIN(I_TAB))[(tl >> 3) * 28 + (tl & 7)] * LOG2E;
        __syncthreads();
#pragma unroll 1
        for (int r2 = 0; r2 < 2; ++r2) { const int q = F.wave + 8 * r2;
            sparse_mfma(F, b, t0 + q, selA + q * 256, cntA[q], F.lds + DL_IMG + F.wave * IMG_BYTES, (const LAS float*)(F.lds + DL_TABA), F.lane); }
    }
}

#ifndef MK_MULTI
#define MK_MULTI 0
#endif
constexpr int N_PHASES = 1 + 2 * (4 + 8) + 2 * (3 + 8) + 1;
struct Args { const float* in[20]; float* out; unsigned char* ws; int ph_lo, ph_hi; };
static_assert(sizeof(Args) == 22 * 8 + 8, "Args has no padding");

#define XBP ((unsigned char*)KOUT() + XB_OFF)
#define RSP ((const float*)(KWS() + WS_RS))
#define GEMM_CALL(ACTV, Aptr, Bptr, Mv, Nv, Kv, Optr, LDC, CID, RS_) do { \
    pg8::Gemm g_{(const pg8::bf16_t*)(Aptr), (const pg8::bf16_t*)(Bptr), (Mv), (Nv), (Kv)}; pg8::StaticOrder S_; S_.init((Mv), (Nv), F.G, (CID)); \
    pg8::EpiAct<ACTV> E_{(pg8::bf16_t*)(Optr), (LDC), (RS_)}; \
    pg8::gemm_phase<pg8::EpiAct<ACTV>, pg8::StaticOrder, true, true>(F.lds + RING_OFF, g_, S_, E_, F.tid); } while (0)

__global__ void __launch_bounds__(NWAVES * 64, 2) mk_fwd(Args args) {
    extern __shared__ __attribute__((aligned(16))) unsigned char lds[];
    Frame F;
    F.lds = (LAS unsigned char*)lds;
    F.MISC = (volatile LAS unsigned*)(F.lds + MISC_OFF);
    F.tid = threadIdx.x; F.lane = F.tid & 63; F.wave = __builtin_amdgcn_readfirstlane(F.tid >> 6);
    F.G = gridDim.x; { const int bx = blockIdx.x; F.vcu = (F.G % 8 == 0) ? (bx % 8) * (F.G / 8) + bx / 8 : bx; }
    for (int u = F.tid; u < (LDS_BYTES - LDSCTL_OFF) / 4; u += NWAVES * 64) ((LAS unsigned*)(F.lds + LDSCTL_OFF))[u] = 0u;
    __syncthreads();
#if MK_MULTI
    XcdBarrier bar; bar.bar = (unsigned*)(((gu32*)KWS()) + CW_BAR); bar.x = 0; bar.st = nullptr;
#else
    XcdBarrier bar = xcd_barrier_post((unsigned*)(((gu32*)KWS()) + CW_BAR), F.MISC + 8, XLEAD(F));
#endif
    const int lo = args.ph_lo, hi = args.ph_hi;
    int pid = 0;
#define PH_ON (pid >= lo && pid < hi && refresh(F))
#if MK_MULTI
#define PH_END do { ++pid; } while (0)
#else
#define PH_END do { if (pid >= lo && pid + 1 < hi) xcd_barrier(bar, XLEAD(F)); ++pid; } while (0)
#endif

    if (PH_ON) { convert_weights(F, 0); thin_first(F); }
    PH_END;

#pragma unroll
    for (int l = 0; l < 4; ++l) {
        const float* g = KIN(I_NG) + (size_t)l * 6 * D;
        if ((l & 1) == 0) {
            const int e = l >> 1;
            if (PH_ON) { REP(0) GEMM_CALL(0, XBP, KWS() + WS_WGT + WO_WIN, M, ZE, D, KWS() + WS_Z, ZE, (int)blockIdx.x, RSP); }
            PH_END;
            if (PH_ON) { REP(5) thin_ckvn(F, KIN(I_EKVN) + e * 128); }
            PH_END;
            if (PH_ON) { REP(1) diff_mfma(F, e); REP(2) dsa_phase(F); }
            PH_END;
            if (PH_ON) { REP(0) GEMM_CALL(0, KWS() + WS_HC, KWS() + WS_WGT + WO_WOUT, M, D, HCE, KWS() + WS_Y, D, (int)blockIdx.x, nullptr); }
            PH_END;
        } else {
            const int o = l >> 1;
            if (PH_ON) { REP(0) GEMM_CALL(0, XBP, KWS() + WS_WGT + WO_WIN, M, ZO, D, KWS() + WS_Z, ZO, (int)blockIdx.x, RSP); }
            PH_END;
            if (PH_ON) { REP(3) swa_mfma(F, o); }
            PH_END;
            if (PH_ON) { REP(0) GEMM_CALL(0, KWS() + WS_HC, KWS() + WS_WGT + WO_WOUT, M, D, HCO, KWS() + WS_Y, D, (int)blockIdx.x, nullptr); }
            PH_END;
        }
        if (PH_ON) { thin_mid<false>(F, g + 1 * D); thin_memn(F, KIN(I_XMN) + (size_t)l * D); }
        PH_END;
        if (PH_ON) { REP(0) GEMM_CALL(0, XBP, KWS() + WS_WGT + WO_WQ, M, 256, D, KWS() + WS_QX, 256, (int)blockIdx.x, RSP); REP(0) GEMM_CALL(0, KWS() + WS_MEMN, KWS() + WS_WGT + WO_WKV, NB * NMEM, 512, D, KWS() + WS_KVM, 512, (int)((blockIdx.x + 128) % F.G), nullptr); }
        PH_END;
        if (PH_ON) { REP(3) xattn_mfma(F); }
        PH_END;
        if (PH_ON) { REP(0) GEMM_CALL(0, KWS() + WS_OX, KWS() + WS_WGT + WO_WO, M, D, 256, KWS() + WS_Y, D, (int)blockIdx.x, nullptr); }
        PH_END;
        if (PH_ON) { thin_mid<false>(F, g + 3 * D); }
        PH_END;
        if (PH_ON) { REP(0) GEMM_CALL(2, XBP, KWS() + WS_WGT + WO_W1, M, FF, D, KWS() + WS_U, FF, (int)blockIdx.x, RSP); }
        PH_END;
        if (PH_ON) { REP(0) GEMM_CALL(0, KWS() + WS_U, KWS() + WS_WGT + WO_W2, M, D, FF, KWS() + WS_Y, D, (int)blockIdx.x, nullptr); }
        PH_END;
        if (PH_ON) { if (l < 3) { thin_mid<false>(F, g + 5 * D); REP(4) convert_weights(F, l + 1); } else thin_mid<true>(F, g + 5 * D); }
        PH_END;
    }
    if (PH_ON) { final_copy(F); }
    PH_END;
}

extern "C" void kernel_launch(void* const* d_in, const int* in_sizes, int n_in, void* d_out, int out_size, void* d_ws, size_t ws_size, hipStream_t stream) {
    static int grid = 0;
    if (grid == 0) {
        if (n_in != 20 || out_size != M * D || ws_size < WS_END) { fprintf(stderr, "kernel_launch: unexpected shapes: n_in %d out %d ws %zu (need %zu)\n", n_in, out_size, ws_size, (size_t)WS_END); grid = -1; return; }
        int dev = 0, cus = 0, per_cu = 0;
        if (hipGetDevice(&dev) != hipSuccess || hipDeviceGetAttribute(&cus, hipDeviceAttributeMultiprocessorCount, dev) != hipSuccess) { grid = -1; return; }
        if (hipFuncSetAttribute((const void*)mk_fwd, hipFuncAttributeMaxDynamicSharedMemorySize, LDS_BYTES) != hipSuccess) { fprintf(stderr, "kernel_launch: hipFuncSetAttribute failed\n"); grid = -1; return; }
        if (hipOccupancyMaxActiveBlocksPerMultiprocessor(&per_cu, (const void*)mk_fwd, NWAVES * 64, LDS_BYTES) != hipSuccess || per_cu < 1)
            fprintf(stderr, "kernel_launch: note: occupancy query reports %d workgroups per CU\n", per_cu);
        (void)hipGetLastError();
        grid = cus;
        if (grid != 256) { fprintf(stderr, "kernel_launch: built for 256 CUs, device has %d\n", cus); grid = -1; return; }
    }
    if (grid < 0) return;
    if (hipMemsetAsync((char*)d_ws + WS_CTL, 0, CTL_ZERO_BYTES, stream) != hipSuccess) return;
    Args a{};
    for (int i = 0; i < 20; ++i) a.in[i] = (const float*)d_in[i];
    a.out = (float*)d_out; a.ws = (unsigned char*)d_ws;
#if MK_MULTI
    for (int p = 0; p < N_PHASES; ++p) { a.ph_lo = p; a.ph_hi = p + 1; hipLaunchKernelGGL(mk_fwd, dim3(grid), dim3(NWAVES * 64), LDS_BYTES, stream, a); }
#else
    a.ph_lo = 0; a.ph_hi = N_PHASES; hipLaunchKernelGGL(mk_fwd, dim3(grid), dim3(NWAVES * 64), LDS_BYTES, stream, a);
#endif
}
```
